# Optimizing an MI355X kernel written in HIP

```python
import math
import jax
import jax.numpy as jnp
from jax import lax
import numpy as np

D_MODEL = 1024
BATCH = 8
SEQ = 8192
DEPTH = 1

HEAD_DIM = 64
MEM_LEN = 256
GRID_W = 64
NA_HEADS = D_MODEL // (2 * HEAD_DIM)
NA_WIN_ROWS = 8
NA_WIN_COLS = 16
DIL_PAIRS = ((128, 1), (512, 4), (2048, 16))
DIL_GROUPS = len(DIL_PAIRS)
DIL_HEADS_PER_GROUP = D_MODEL // (4 * HEAD_DIM)
DIL_HEADS = DIL_GROUPS * DIL_HEADS_PER_GROUP
DIL_BLOCK = 128
MEM_HEADS = 4
T5_BUCKETS = 32
T5_MAX_DIST = 1024
N_GROUPS = 4
EXPERTS_PER_GROUP = 8
N_EXPERTS = N_GROUPS * EXPERTS_PER_GROUP
TOP_K = 2
D_EXPERT = D_MODEL // 2
MOE_BLOCK = 256
EPS = 1e-6
NEG_INF = -1e30

NA_W = NA_HEADS * HEAD_DIM
DIL_W = DIL_HEADS * HEAD_DIM
DIL_OUT_W = DIL_HEADS_PER_GROUP * HEAD_DIM
MEM_W = MEM_HEADS * HEAD_DIM
IN_COLS = 3 * NA_W + 3 * DIL_W + MEM_W
MIX_W = NA_W + DIL_OUT_W + MEM_W
IN_SPLITS = (NA_W, 2 * NA_W, 3 * NA_W, 3 * NA_W + DIL_W, 3 * NA_W + 2 * DIL_W, 3 * NA_W + 3 * DIL_W)

kernel_name = 'hybrid_natten_dilated_memory_hmoe_encoder'


def rms_norm(x, g):
    xf = x.astype(jnp.float32)
    y = xf * lax.rsqrt(jnp.mean(xf * xf, axis=-1, keepdims=True) + EPS)
    return (y * g.astype(jnp.float32)).astype(x.dtype)


def t5_bucket(rel):
    nb = T5_BUCKETS // 2
    max_exact = nb // 2
    n = jnp.abs(rel)
    upper = (rel > 0).astype(jnp.int32) * nb
    nf = jnp.maximum(n, 1).astype(jnp.float32)
    large = max_exact + (jnp.log(nf / max_exact) / math.log(T5_MAX_DIST / max_exact) * (nb - max_exact)).astype(jnp.int32)
    large = jnp.minimum(large, nb - 1)
    return upper + jnp.where(n < max_exact, n, large)


def neighborhood_attention(q, k, v, rpb):
    b, s, h, dh = q.shape
    rows = s // GRID_W
    kh = min(NA_WIN_ROWS, rows)
    kw = NA_WIN_COLS
    kg = k.reshape(b, rows, GRID_W, h, dh).transpose(0, 3, 1, 2, 4)
    vg = v.reshape(b, rows, GRID_W, h, dh).transpose(0, 3, 1, 2, 4)
    qg = q.reshape(b, rows, GRID_W, h, dh).transpose(1, 0, 3, 2, 4)
    cols = jnp.arange(GRID_W)
    c0 = jnp.clip(cols - kw // 2, 0, GRID_W - kw)
    col_idx = c0[:, None] + jnp.arange(kw)[None, :]
    dc = col_idx - cols[:, None] + (NA_WIN_COLS - 1)
    scale = HEAD_DIM ** -0.5

    def row_fn(args):
        q_r, r = args
        r0 = jnp.clip(r - kh // 2, 0, rows - kh)
        k_rows = lax.dynamic_slice_in_dim(kg, r0, kh, axis=2)
        v_rows = lax.dynamic_slice_in_dim(vg, r0, kh, axis=2)
        k_win = k_rows[:, :, :, col_idx]
        v_win = v_rows[:, :, :, col_idx]
        dr = r0 + jnp.arange(kh) - r + (NA_WIN_ROWS - 1)
        bias = rpb[:, dr[:, None, None], dc[None]].transpose(0, 2, 1, 3)
        logits = jnp.einsum('bhcd,bhacjd->bhcaj', q_r, k_win).astype(jnp.float32) * scale + bias.astype(jnp.float32)[None]
        p = jax.nn.softmax(logits, axis=(-2, -1)).astype(v.dtype)
        return jnp.einsum('bhcaj,bhacjd->bhcd', p, v_win)

    out = lax.map(row_fn, (qg, jnp.arange(rows)))
    return out.transpose(1, 0, 3, 2, 4).reshape(b, s, h * dh)


def dilated_window_attention(q, k, v, offs, bias, half):
    b, s, h, dh = q.shape
    scale = HEAD_DIM ** -0.5
    kp = jnp.pad(k, ((0, 0), (half, half), (0, 0), (0, 0)))
    vp = jnp.pad(v, ((0, 0), (half, half), (0, 0), (0, 0)))
    local = jnp.arange(DIL_BLOCK)[:, None] + offs[None, :] + half
    bias32 = bias.astype(jnp.float32)
    n_blk = s // DIL_BLOCK

    def block_fn(i):
        s0 = i * DIL_BLOCK
        qb = lax.dynamic_slice_in_dim(q, s0, DIL_BLOCK, axis=1)
        kb = lax.dynamic_slice_in_dim(kp, s0, DIL_BLOCK + 2 * half, axis=1)
        vb = lax.dynamic_slice_in_dim(vp, s0, DIL_BLOCK + 2 * half, axis=1)
        kgat = kb[:, local]
        vgat = vb[:, local]
        key_pos = s0 + local - half
        valid = (key_pos >= 0) & (key_pos < s)
        logits = jnp.einsum('bqhd,bqjhd->bqhj', qb, kgat).astype(jnp.float32) * scale + bias32[None, None]
        logits = jnp.where(valid[None, :, None, :], logits, NEG_INF)
        m = jnp.max(logits, axis=-1)
        e = jnp.exp(logits - m[..., None])
        den = jnp.sum(e, axis=-1)
        o = jnp.einsum('bqhj,bqjhd->bqhd', e, vgat.astype(jnp.float32)) / den[..., None]
        return o, m, den

    o, m, den = lax.map(block_fn, jnp.arange(n_blk))
    o = o.transpose(1, 0, 2, 3, 4).reshape(b, s, h, dh)
    m = m.transpose(1, 0, 2, 3).reshape(b, s, h)
    den = den.transpose(1, 0, 2, 3).reshape(b, s, h)
    return o, m, den


def hierarchical_moe(h, w_r1, b_r1, w_r2, b_r2, w1, w3, w2):
    b, s, d = h.shape
    n = b * s
    t = h.reshape(n, d)
    grp_logits = (t @ w_r1).astype(jnp.float32) + b_r1.astype(jnp.float32)
    grp_prob = jax.nn.softmax(grp_logits, axis=-1)
    grp_idx = jnp.argmax(grp_logits, axis=-1)
    grp_gate = jnp.take_along_axis(grp_prob, grp_idx[:, None], axis=-1)
    fine_logits = ((t @ w_r2).astype(jnp.float32) + b_r2.astype(jnp.float32)).reshape(n, N_GROUPS, EXPERTS_PER_GROUP)
    fine_sel = jnp.take_along_axis(fine_logits, grp_idx[:, None, None], axis=1)[:, 0]
    top_val, top_idx = lax.top_k(fine_sel, TOP_K)
    gate = grp_gate * jax.nn.softmax(top_val, axis=-1)
    exp_idx = grp_idx[:, None] * EXPERTS_PER_GROUP + top_idx
    n_rows = n * TOP_K
    e_flat = exp_idx.reshape(-1)
    g_flat = gate.reshape(-1)
    tok_flat = jnp.repeat(jnp.arange(n), TOP_K)
    order = jnp.argsort(e_flat)
    e_sorted = e_flat[order]
    counts = jnp.bincount(e_flat, length=N_EXPERTS)
    cnt_start = jnp.cumsum(counts) - counts
    padded = (counts + MOE_BLOCK - 1) // MOE_BLOCK * MOE_BLOCK
    pad_end = jnp.cumsum(padded)
    pad_start = pad_end - padded
    dest = pad_start[e_sorted] + jnp.arange(n_rows) - cnt_start[e_sorted]
    cap = n_rows + N_EXPERTS * MOE_BLOCK
    row_tok = jnp.full((cap,), n, jnp.int32).at[dest].set(tok_flat[order])
    row_gate = jnp.zeros((cap,), jnp.float32).at[dest].set(g_flat[order])
    n_blk = cap // MOE_BLOCK
    blk_exp = jnp.minimum(jnp.searchsorted(pad_end, jnp.arange(n_blk) * MOE_BLOCK, side='right'), N_EXPERTS - 1)
    t_pad = jnp.concatenate([t, jnp.zeros((1, d), t.dtype)], axis=0)
    xs = t_pad[row_tok].reshape(n_blk, MOE_BLOCK, d)

    def expert_block(args):
        xb, e = args
        a = jax.nn.silu(xb @ w1[e]) * (xb @ w3[e])
        return a @ w2[e]

    yb = lax.map(expert_block, (xs, blk_exp)).reshape(cap, d)
    y = jnp.zeros((n + 1, d), h.dtype).at[row_tok].add(yb * row_gate[:, None].astype(h.dtype))
    return y[:n].reshape(b, s, d)


def setup_inputs(seed: int = 0) -> dict:
    key = jax.random.key(seed)
    ks = jax.random.split(key, 18)
    f32 = jnp.float32

    def nrm(k, shape, sc):
        return jax.random.normal(k, shape, f32) * sc

    L = DEPTH
    return {
        'x': nrm(ks[0], (BATCH, SEQ, D_MODEL), 1.0),
        'mem': nrm(ks[1], (BATCH, MEM_LEN, D_MODEL), 1.0),
        'g_mix': 1.0 + nrm(ks[2], (L, D_MODEL), 0.02),
        'w_in': nrm(ks[3], (L, D_MODEL, IN_COLS), D_MODEL ** -0.5),
        'qk_gain': 1.0 + nrm(ks[4], (L, 3, 2, HEAD_DIM), 0.02),
        'na_rpb': nrm(ks[5], (L, NA_HEADS, 2 * NA_WIN_ROWS - 1, 2 * NA_WIN_COLS - 1), 0.1),
        't5_table': nrm(ks[6], (T5_BUCKETS, DIL_HEADS), 0.1),
        'g_mem': 1.0 + nrm(ks[7], (L, D_MODEL), 0.02),
        'w_mem_kv': nrm(ks[8], (L, D_MODEL, 2 * MEM_W), D_MODEL ** -0.5),
        'w_out': nrm(ks[9], (L, MIX_W, D_MODEL), MIX_W ** -0.5),
        'g_ffn': 1.0 + nrm(ks[10], (L, D_MODEL), 0.02),
        'w_r1': nrm(ks[11], (L, D_MODEL, N_GROUPS), D_MODEL ** -0.5),
        'b_r1': nrm(ks[12], (L, N_GROUPS), 0.01),
        'w_r2': nrm(ks[13], (L, D_MODEL, N_EXPERTS), D_MODEL ** -0.5),
        'b_r2': nrm(ks[14], (L, N_EXPERTS), 0.01),
        'w1': nrm(ks[15], (L, N_EXPERTS, D_MODEL, D_EXPERT), D_MODEL ** -0.5),
        'w3': nrm(ks[16], (L, N_EXPERTS, D_MODEL, D_EXPERT), D_MODEL ** -0.5),
        'w2': nrm(ks[17], (L, N_EXPERTS, D_EXPERT, D_MODEL), D_EXPERT ** -0.5),
    }


def reference(x, mem, g_mix, w_in, qk_gain, na_rpb, t5_table, g_mem, w_mem_kv, w_out, g_ffn, w_r1, b_r1, w_r2, b_r2, w1, w3, w2):
    b, s, _ = x.shape
    hd = HEAD_DIM
    scale = HEAD_DIM ** -0.5
    t5 = t5_table.reshape(T5_BUCKETS, DIL_GROUPS, DIL_HEADS_PER_GROUP)
    for l in range(DEPTH):
        h = rms_norm(x, g_mix[l])
        qa, ka, va, qd, kd, vd, qm = jnp.split(h @ w_in[l], IN_SPLITS, axis=-1)

        qa = rms_norm(qa.reshape(b, s, NA_HEADS, hd), qk_gain[l, 0, 0])
        ka = rms_norm(ka.reshape(b, s, NA_HEADS, hd), qk_gain[l, 0, 1])
        va = va.reshape(b, s, NA_HEADS, hd)
        out_na = neighborhood_attention(qa, ka, va, na_rpb[l])

        dshape = (b, s, DIL_GROUPS, DIL_HEADS_PER_GROUP, hd)
        qd = rms_norm(qd.reshape(dshape), qk_gain[l, 1, 0])
        kd = rms_norm(kd.reshape(dshape), qk_gain[l, 1, 1])
        vd = vd.reshape(dshape)
        o_list, m_list, d_list = [], [], []
        for g, (win, dil) in enumerate(DIL_PAIRS):
            half = win // 2
            n_side = half // dil
            offs = jnp.arange(-n_side, n_side + 1) * dil
            bias = t5[t5_bucket(offs), g].T
            o, m, den = dilated_window_attention(qd[:, :, g], kd[:, :, g], vd[:, :, g], offs, bias, half)
            o_list.append(o)
            m_list.append(m)
            d_list.append(den)
        m_all = jnp.stack(m_list)
        wts = jnp.stack(d_list) * jnp.exp(m_all - jnp.max(m_all, axis=0, keepdims=True))
        out_dil = jnp.sum(wts[..., None] * jnp.stack(o_list), axis=0) / jnp.sum(wts, axis=0)[..., None]
        out_dil = out_dil.astype(x.dtype).reshape(b, s, DIL_OUT_W)

        kvm = rms_norm(mem, g_mem[l]) @ w_mem_kv[l]
        km, vm = jnp.split(kvm, 2, axis=-1)
        km = rms_norm(km.reshape(b, -1, MEM_HEADS, hd), qk_gain[l, 2, 1])
        vm = vm.reshape(b, -1, MEM_HEADS, hd)
        qm = rms_norm(qm.reshape(b, s, MEM_HEADS, hd), qk_gain[l, 2, 0])
        logits_m = jnp.einsum('bshd,bmhd->bhsm', qm, km).astype(jnp.float32) * scale
        p_m = jax.nn.softmax(logits_m, axis=-1).astype(vm.dtype)
        out_mem = jnp.einsum('bhsm,bmhd->bshd', p_m, vm).reshape(b, s, MEM_W)

        x = x + jnp.concatenate([out_na, out_dil, out_mem], axis=-1) @ w_out[l]
        x = x + hierarchical_moe(rms_norm(x, g_ffn[l]), w_r1[l], b_r1[l], w_r2[l], b_r2[l], w1[l], w3[l], w2[l])
    return x
```

```cpp
#include <hip/hip_runtime.h>
#include <hip/hip_cooperative_groups.h>
#include <cstdio>
#include <cstdint>
#include <cstring>

constexpr int DM = 1024, BATCH = 8, SEQ = 8192, NTOK = BATCH * SEQ;
constexpr int HD = 64, MEM_LEN = 256, GRID_W = 64, GRID_R = SEQ / GRID_W;
constexpr int NA_HEADS = 8, DIL_HEADS = 12, MEM_HEADS = 4;
constexpr int NA_W = 512, DIL_W = 768, MEM_W = 256, IN_COLS = 4096;
constexpr int C_QA = 0, C_KA = 512, C_VA = 1024, C_QD = 1536, C_KD = 2304, C_VD = 3072, C_QM = 3840;
constexpr int NEXP = 32, DEXP = 512;
constexpr int NPAIR = 112;
constexpr int MROWS = NTOK + MEM_LEN * BATCH;
constexpr float EPS = 1e-6f;
constexpr float LOG2E = 1.4426950408889634f;
constexpr float QSCALE = 0.125f * LOG2E;

typedef unsigned short bf16_t;
namespace cg = cooperative_groups;
#ifndef MK_ONE_LAUNCH
#define MK_ONE_LAUNCH 1
#endif
#ifndef MK_REP_PHASE
#define MK_REP_PHASE -1
#endif

constexpr size_t MiB = 1u << 20;
constexpr size_t WS_CTL = 0;
constexpr size_t WS_BIASD = 1 * MiB;
constexpr size_t WS_RPB = 1 * MiB + 64 * 1024;
constexpr size_t WS_WRF = 1 * MiB + 128 * 1024;
constexpr size_t WS_TOKG = 2 * MiB;
constexpr size_t WS_RSTD = 2 * MiB + 512 * 1024;
constexpr size_t WS_LIST = 4 * MiB;
constexpr size_t WS_KVM = 32 * MiB;
constexpr size_t WS_ELIST = 36 * MiB;
constexpr size_t WS_TOKP = 2 * MiB + 768 * 1024;
constexpr size_t WS_WT = 48 * MiB;
constexpr size_t WS_XN = 160 * MiB;
constexpr size_t WS_QKV = 304 * MiB;
constexpr size_t WS_H = WS_QKV;
constexpr size_t WS_ACT = WS_QKV + 128 * MiB;
constexpr size_t WS_X1B = 640 * MiB;
constexpr size_t WS_MIX = 816 * MiB;
constexpr size_t WS_RSTDX = 3 * MiB;
constexpr size_t WS_END = 944 * MiB;
constexpr int MAXTILES = NTOK / 256 + NPAIR;
constexpr int CW_COUNT = 64;
constexpr int CW_ECOUNT = 256;
constexpr int MAXETILES = 2 * NTOK / 256 + 32;

__device__ __forceinline__ float bf2f(bf16_t v) { return __uint_as_float((unsigned)v << 16); }
__device__ __forceinline__ bf16_t f2bf(float f) { unsigned u = __float_as_uint(f); return (bf16_t)((u + 0x7fffu + ((u >> 16) & 1u)) >> 16); }
__device__ __forceinline__ float wave_sum(float v) {
#pragma unroll
    for (int o = 1; o < 64; o <<= 1) v += __shfl_xor(v, o);
    return v;
}

__device__ __forceinline__ int t5_bucket(int rel) {
    const int n = rel < 0 ? -rel : rel;
    const int upper = rel > 0 ? 16 : 0;
    const float nf = (float)(n < 1 ? 1 : n);
    int large = 8 + (int)(logf(nf / 8.f) / logf(128.f) * 8.f);
    large = large < 15 ? large : 15;
    return upper + (n < 8 ? n : large);
}
__device__ __forceinline__ void pair_experts(int L, int& ea, int& eb) {
    const int grp = L / 28; int idx = L % 28; int a = 0;
    while (idx >= 7 - a) { idx -= 7 - a; ++a; }
    ea = grp * 8 + a; eb = grp * 8 + a + 1 + idx;
}

#define LAS __attribute__((address_space(3)))
typedef short bf16x8 __attribute__((ext_vector_type(8)));
typedef float f32x4 __attribute__((ext_vector_type(4)));
typedef float f32x16 __attribute__((ext_vector_type(16)));
typedef unsigned u32x4 __attribute__((ext_vector_type(4)));
typedef unsigned u32x2 __attribute__((ext_vector_type(2)));

constexpr int NWAVES = 8, NTHREADS = 512;
constexpr int LDS_BYTES = 163840;
constexpr int RING_BYTES = 131072;

constexpr size_t WS_WINT = WS_WT;
constexpr size_t WS_WOT = WS_WINT + (size_t)4608 * 1024 * 2;
constexpr size_t WS_W13T = WS_WOT + (size_t)1024 * 1024 * 2;
constexpr size_t WS_W2T = WS_W13T + (size_t)32 * 1024 * 1024 * 2;
static_assert(WS_W2T + (size_t)32 * 1024 * 512 * 2 <= WS_XN, "weight copies fit");
static_assert(WS_ACT + (size_t)MAXTILES * 256 * 1024 * 2 <= WS_X1B && WS_X1B + (size_t)NTOK * 1024 * 2 <= WS_MIX, "ACT | X1B | MIX do not overlap");

__device__ __forceinline__ unsigned cvt_pk_bf16(float lo, float hi) { unsigned r; asm volatile("v_cvt_pk_bf16_f32 %0, %1, %2" : "=v"(r) : "v"(lo), "v"(hi)); return r; }
__device__ __forceinline__ unsigned pk2(float lo, float hi) { return (unsigned)f2bf(lo) | ((unsigned)f2bf(hi) << 16); }

namespace pg8 {
constexpr int BM = 256, BK = 64, HALF = 128, HTB = HALF * BK * 2, NXCD = 8, WGM = 8;
__device__ __forceinline__ int lds_byte(int r, int c) { const int st = (r >> 4) * 2 + (c >> 5), rr = r & 15, cc = c & 31, ob = rr * 64 + cc * 2; return st * 1024 + (ob ^ (((ob >> 9) & 1) << 5)); }
__device__ __forceinline__ void stage_rc(int b, int& R, int& C) { const int st = b / 1024, sb = b % 1024, swz = sb ^ (((sb >> 9) & 1) << 5); R = (st >> 1) * 16 + swz / 64; C = (st & 1) * 32 + (swz % 64) / 2; }
__device__ __forceinline__ int perm32(int rho) { const int n = rho >> 4, i = rho & 15; return 8 * (i >> 2) + 4 * n + (i & 3); }

struct Unit { const char* A; const char* B0; const char* B1; int ksplit; int e0, e1, e2, e3; };

__device__ __forceinline__ int xcd_remap(int L, int nwg) { const int q = nwg / NXCD, r = nwg % NXCD, xcd = L % NXCD, off = L / NXCD; return (xcd < r ? xcd * (q + 1) : r * (q + 1) + (xcd - r) * q) + off; }

template <class Epi, class Sched, bool GATHER, bool ALIGN_EPI>
__device__ __forceinline__ void gemm_phase(LAS unsigned char* lds, const int nt, const int lda, const int ldb, const Sched& S, const Epi& E) {
    const int tid = threadIdx.x, wid = __builtin_amdgcn_readfirstlane(tid >> 6), lane = tid & 63, wr = wid >> 2, wc = wid & 3, fr = lane & 15, fq = lane >> 4;
    int sR[2], sC[2]; unsigned voffB[2];
#pragma unroll
    for (int i = 0; i < 2; ++i) { int R, C; stage_rc(tid * 16 + i * 8192, R, C); sR[i] = R; sC[i] = C; const int Rb = Epi::PERM ? ((R & ~31) + perm32(R & 31)) : R; voffB[i] = (unsigned)(Rb * ldb + C) * 2u; }
    const size_t kstep = (size_t)(BK * 2);
    const size_t hstepB = (size_t)HALF * ldb * 2;
    const unsigned ldsw = (unsigned)wid * 1024u;
    const int aoff = lds_byte(wr * 64 + fr, fq * 8), boff = lds_byte(wc * 32 + fr, fq * 8);
#define PG8_SA(b, h) (((b) * 2 + (h)) * HTB)
#define PG8_SB(b, h) ((4 + (b) * 2 + (h)) * HTB)
#define PG8_STAGE(bufoff, gbase, voff) do { _Pragma("unroll") for (int _i = 0; _i < 2; ++_i) \
        __builtin_amdgcn_global_load_lds((const unsigned*)((const char*)(gbase) + (voff)[_i]), (LAS unsigned*)(lds + (bufoff) + ldsw + _i * 8192), 16, 0, 0); } while (0)
#define PG8_LDA(dst, b, h) do { _Pragma("unroll") for (int m = 0; m < 4; ++m) _Pragma("unroll") for (int k = 0; k < 2; ++k) dst[m][k] = *(const LAS bf16x8*)(lds + PG8_SA(b, h) + aoff + m * 2048 + k * 1024); } while (0)
#define PG8_LDB(dst, b, h) do { _Pragma("unroll") for (int n = 0; n < 2; ++n) _Pragma("unroll") for (int k = 0; k < 2; ++k) dst[n][k] = *(const LAS bf16x8*)(lds + PG8_SB(b, h) + boff + n * 2048 + k * 1024); } while (0)
#define PG8_MMA(ai, bj, At, Bt) do { __builtin_amdgcn_s_setprio(1); _Pragma("unroll") for (int m = 0; m < 4; ++m) _Pragma("unroll") for (int n = 0; n < 2; ++n) _Pragma("unroll") for (int k = 0; k < 2; ++k) \
        acc[ai][bj][m][n] = __builtin_amdgcn_mfma_f32_16x16x32_bf16(Bt[n][k], At[m][k], acc[ai][bj][m][n], 0, 0, 0); __builtin_amdgcn_s_setprio(0); } while (0)
#define PG8_WAIT_V(n) asm volatile("s_waitcnt vmcnt(" #n ")" ::: "memory")
#define PG8_WAIT_L(n) asm volatile("s_waitcnt lgkmcnt(" #n ")" ::: "memory")
#define PG8_BAR __builtin_amdgcn_s_barrier()
#define PG8_SCHED __builtin_amdgcn_sched_barrier(0)
#define PG8_BP(u, t) (((t) < (u).ksplit ? (u).B0 : (u).B1) + (size_t)(t) * kstep)
    Unit cur, nxt; int ui = 0;
    if (!S.next(0, cur)) return;
    f32x4 acc[2][2][4][2];
#pragma unroll
    for (int a = 0; a < 2; ++a)
#pragma unroll
        for (int b = 0; b < 2; ++b)
#pragma unroll
            for (int m = 0; m < 4; ++m)
#pragma unroll
                for (int n = 0; n < 2; ++n) acc[a][b][m][n] = (f32x4){0.f, 0.f, 0.f, 0.f};
    bf16x8 At[4][2], B0[2][2], B1[2][2];
    unsigned vA[2][2], nvA[2][2];
    S.template aoffs<GATHER>(cur, sR, sC, lda, vA);
    const char* cA = cur.A; const char* cB0 = PG8_BP(cur, 0); const char* cB1 = PG8_BP(cur, 1);
    PG8_STAGE(PG8_SB(0, 0), cB0, voffB); PG8_STAGE(PG8_SB(0, 1), cB0 + hstepB, voffB); PG8_STAGE(PG8_SA(0, 0), cA, vA[0]); PG8_STAGE(PG8_SA(0, 1), cA, vA[1]);
    if (wr == 1) PG8_BAR;
    PG8_WAIT_V(2); PG8_BAR;
    PG8_STAGE(PG8_SB(1, 0), cB1, voffB); PG8_STAGE(PG8_SA(1, 0), cA + kstep, vA[0]); PG8_STAGE(PG8_SB(1, 1), cB1 + hstepB, voffB);
    PG8_WAIT_V(6); PG8_BAR;
    for (;;) {
        const bool has_next = S.next(ui + 1, nxt);
        if (!has_next) nxt = cur;
        if constexpr (GATHER) {
            if (has_next) S.template aoffs<GATHER>(nxt, sR, sC, lda, nvA);
            else {
#pragma unroll
                for (int h = 0; h < 2; ++h)
#pragma unroll
                    for (int i = 0; i < 2; ++i) nvA[h][i] = vA[h][i];
            }
        }
        const char* nA = nxt.A;
        for (int t = 0; t < nt; t += 2) {
            const bool last = (t == nt - 2);
            const char* a1 = cA + (size_t)(t + 1) * kstep;
            const char* a2 = last ? nA : cA + (size_t)(t + 2) * kstep; const char* a3 = a2 + kstep;
            const char* b2 = last ? PG8_BP(nxt, 0) : PG8_BP(cur, t + 2); const char* b3 = last ? PG8_BP(nxt, 1) : PG8_BP(cur, t + 3);
            unsigned wA[2][2];
#pragma unroll
            for (int h = 0; h < 2; ++h)
#pragma unroll
                for (int i = 0; i < 2; ++i) { if constexpr (GATHER) { const unsigned msk = last ? 0xffffffffu : 0u; wA[h][i] = vA[h][i] ^ ((vA[h][i] ^ nvA[h][i]) & msk); } else wA[h][i] = vA[h][i]; }
            PG8_LDB(B0, 0, 0); PG8_LDB(B1, 0, 1); PG8_SCHED; PG8_LDA(At, 0, 0); PG8_STAGE(PG8_SA(1, 1), a1, vA[1]);
            PG8_WAIT_V(8); PG8_WAIT_L(0); PG8_BAR; PG8_MMA(0, 0, At, B0); PG8_MMA(0, 1, At, B1); PG8_BAR; PG8_SCHED;
            PG8_LDA(At, 0, 1); PG8_STAGE(PG8_SB(0, 0), b2, voffB); PG8_STAGE(PG8_SB(0, 1), b2 + hstepB, voffB); PG8_STAGE(PG8_SA(0, 0), a2, wA[0]);
            PG8_WAIT_V(8); PG8_WAIT_L(0); PG8_BAR; PG8_MMA(1, 0, At, B0); PG8_MMA(1, 1, At, B1); PG8_BAR; PG8_SCHED;
            PG8_LDB(B0, 1, 0); PG8_LDB(B1, 1, 1); PG8_SCHED; PG8_LDA(At, 1, 0); PG8_STAGE(PG8_SA(0, 1), a2, wA[1]);
            PG8_WAIT_V(8); PG8_WAIT_L(0); PG8_BAR; PG8_MMA(0, 0, At, B0); PG8_MMA(0, 1, At, B1); PG8_BAR; PG8_SCHED;
            PG8_LDA(At, 1, 1); PG8_STAGE(PG8_SB(1, 0), b3, voffB); PG8_STAGE(PG8_SB(1, 1), b3 + hstepB, voffB); PG8_STAGE(PG8_SA(1, 0), a3, wA[0]);
            PG8_WAIT_V(8); PG8_WAIT_L(0); PG8_BAR; PG8_MMA(1, 0, At, B0); PG8_MMA(1, 1, At, B1); PG8_BAR; PG8_SCHED;
        }
        if constexpr (ALIGN_EPI) { if (wr == 0) PG8_BAR; }
        E(acc, cur, wr, wc, fr, fq);
        if (!has_next) break;
#pragma unroll
        for (int a = 0; a < 2; ++a)
#pragma unroll
            for (int b = 0; b < 2; ++b)
#pragma unroll
                for (int m = 0; m < 4; ++m)
#pragma unroll
                    for (int n = 0; n < 2; ++n) acc[a][b][m][n] = (f32x4){0.f, 0.f, 0.f, 0.f};
        cur = nxt; cA = nA; ++ui;
        if constexpr (GATHER) {
#pragma unroll
            for (int h = 0; h < 2; ++h)
#pragma unroll
                for (int i = 0; i < 2; ++i) vA[h][i] = nvA[h][i];
        }
        if constexpr (ALIGN_EPI) { if (wr == 1) PG8_BAR; }
    }
    PG8_WAIT_V(0);
    if constexpr (!ALIGN_EPI) { if (wr == 0) PG8_BAR; }
    PG8_BAR;
#undef PG8_SA
#undef PG8_SB
#undef PG8_STAGE
#undef PG8_LDA
#undef PG8_LDB
#undef PG8_MMA
#undef PG8_WAIT_V
#undef PG8_WAIT_L
#undef PG8_BAR
#undef PG8_SCHED
#undef PG8_BP
}
}

struct MArgs {
    const float* in[18]; float* out; unsigned char* ws; int ph_lo, ph_hi;
};

__device__ __forceinline__ void p0_transpose_item(const float* W, int N, int k0, int n0, bf16_t* WT, int dst_row0, int ldk, LAS float* scr, int lane, const float* kscale = nullptr) {
    { const int kr = lane >> 3, g = lane & 7;
      const float* src = W + (size_t)(k0 + kr) * N + n0 + 4 * g;
      f32x4 v[8];
#pragma unroll
      for (int i = 0; i < 8; ++i) v[i] = *(const f32x4*)(src + (size_t)(8 * i) * N);
#pragma unroll
      for (int i = 0; i < 8; ++i) { const int kk = kr + 8 * i; *(LAS f32x4*)(scr + kk * 36 + ((g ^ i) << 2)) = v[i]; } }
    const int c = lane & 7;
    float ks[8];
    if (kscale) { const f32x4 s0 = *(const f32x4*)(kscale + k0 + 8 * c), s1 = *(const f32x4*)(kscale + k0 + 8 * c + 4); ks[0] = s0[0]; ks[1] = s0[1]; ks[2] = s0[2]; ks[3] = s0[3]; ks[4] = s1[0]; ks[5] = s1[1]; ks[6] = s1[2]; ks[7] = s1[3]; }
    else {
#pragma unroll
        for (int j = 0; j < 8; ++j) ks[j] = 1.f; }
    asm volatile("s_waitcnt lgkmcnt(0)" ::: "memory");
#pragma unroll
    for (int j = 0; j < 4; ++j) { const int n = (lane >> 3) + 8 * j; const LAS float* sp = scr + (8 * c) * 36 + ((((n >> 2) ^ c) << 2) | (n & 3));
        u32x4 o; o.x = pk2(sp[0 * 36] * ks[0], sp[1 * 36] * ks[1]); o.y = pk2(sp[2 * 36] * ks[2], sp[3 * 36] * ks[3]); o.z = pk2(sp[4 * 36] * ks[4], sp[5 * 36] * ks[5]); o.w = pk2(sp[6 * 36] * ks[6], sp[7 * 36] * ks[7]);
        *(u32x4*)(WT + (size_t)(dst_row0 + n) * ldk + k0 + 8 * c) = o; }
    asm volatile("s_waitcnt lgkmcnt(0)" ::: "memory");
}
__device__ __forceinline__ int inproj_pos(int n) { const int l = n & 255; return (n & ~255) + 128 * ((l >> 5) & 1) + 32 * (l >> 6) + (l & 31); }

__device__ __forceinline__ void phase0(const MArgs& a, LAS unsigned char* lds, int vcu, int G) {
    const int tid = threadIdx.x, lane = tid & 63, wave = __builtin_amdgcn_readfirstlane(tid >> 6);
    unsigned char* ws = a.ws;
    LAS float* scr = (LAS float*)(lds + wave * 16384);
    const int gw = vcu * NWAVES + wave, NGW = G * NWAVES;
    constexpr int I_IN = 16 * 128, I_MK = 16 * 16, I_O = 16 * 32, I_W1 = 32 * 16 * 16, I_W2 = 32 * 8 * 32;
    constexpr int NITEMS = I_IN + I_MK + I_O + 2 * I_W1 + I_W2;
    bf16_t* WinT = (bf16_t*)(ws + WS_WINT); bf16_t* WoT = (bf16_t*)(ws + WS_WOT); bf16_t* W13T = (bf16_t*)(ws + WS_W13T); bf16_t* W2T = (bf16_t*)(ws + WS_W2T);
    for (int it = gw; it < NITEMS; it += NGW) {
        int r = it;
        if (r < I_IN) { const int kb = r / 128, nb = r % 128; p0_transpose_item(a.in[3], IN_COLS, kb * 64, nb * 32, WinT, inproj_pos(nb * 32), DM, scr, lane, a.in[2]); continue; } r -= I_IN;
        if (r < I_MK) { const int kb = r / 16, nb = r % 16; p0_transpose_item(a.in[8], 512, kb * 64, nb * 32, WinT, 4096 + inproj_pos(nb * 32), DM, scr, lane); continue; } r -= I_MK;
        if (r < I_O) { const int kb = r / 32, nb = r % 32; p0_transpose_item(a.in[9], DM, kb * 64, nb * 32, WoT, nb * 32, DM, scr, lane); continue; } r -= I_O;
        if (r < 2 * I_W1) { const int which = r / I_W1; r %= I_W1; const int e = r / 256, kb = (r % 256) / 16, nb = r % 16; const int n0 = nb * 32;
            p0_transpose_item(a.in[15 + which] + (size_t)e * DM * DEXP, DEXP, kb * 64, n0, W13T, e * 1024 + 256 * (n0 >> 7) + 128 * which + (n0 & 127), DM, scr, lane, a.in[10]); continue; } r -= 2 * I_W1;
        { const int e = r / 256, kb = (r % 256) / 32, nb = r % 32; p0_transpose_item(a.in[17] + (size_t)e * DEXP * DM, DM, kb * 64, nb * 32, W2T, e * 1024 + nb * 32, DEXP, scr, lane); }
    }
    bf16_t* XN = (bf16_t*)(ws + WS_XN); float* rstdx = (float*)(ws + WS_RSTDX);
    for (int r = gw; r < MROWS; r += NGW) {
        const bool isx = r < NTOK;
        const float* src = isx ? a.in[0] + (size_t)r * DM : a.in[1] + (size_t)(r - NTOK) * DM;
        const float4* xr = (const float4*)src;
        float4 v[4]; float s = 0.f;
#pragma unroll
        for (int j = 0; j < 4; ++j) { v[j] = xr[lane + 64 * j]; s += v[j].x * v[j].x + v[j].y * v[j].y + v[j].z * v[j].z + v[j].w * v[j].w; }
        s = wave_sum(s);
        const float rstd = rsqrtf(s * (1.f / DM) + EPS);
        if (isx) { if (lane == 0) rstdx[r] = rstd; }
        const float sc = isx ? 1.f : rstd;
#pragma unroll
        for (int j = 0; j < 4; ++j) {
            float4 gg = (float4){1.f, 1.f, 1.f, 1.f}; if (!isx) gg = ((const float4*)a.in[7])[lane + 64 * j];
            u32x2 o; o.x = pk2(v[j].x * sc * gg.x, v[j].y * sc * gg.y); o.y = pk2(v[j].z * sc * gg.z, v[j].w * sc * gg.w);
            ((u32x2*)(XN + (size_t)r * DM))[lane + 64 * j] = o;
        }
    }
    { bf16_t* WfH = (bf16_t*)(ws + WS_WRF); bf16_t* WfL = WfH + 32 * 3 * 64 * 8; float* b48 = (float*)(ws + WS_WRF + 2 * 32 * 3 * 64 * 8 * 2);
      for (int t = vcu * NTHREADS + tid; t < 32 * 3 * 64 * 8 + 48; t += G * NTHREADS) {
          if (t < 32 * 3 * 64 * 8) { const int j = t & 7, ln = (t >> 3) & 63, sc = t >> 9, ct = sc % 3, st = sc / 3; const int k = 32 * st + 8 * (ln >> 4) + j, col = 16 * ct + (ln & 15);
              const float w = (col < 4 ? a.in[11][k * 4 + col] : (col < 36 ? a.in[13][k * 32 + col - 4] : 0.f)) * a.in[10][k];
              const bf16_t hi = f2bf(w); WfH[t] = hi; WfL[t] = f2bf(w - bf2f(hi)); }
          else { const int col = t - 32 * 3 * 64 * 8; b48[col] = col < 4 ? a.in[12][col] : (col < 36 ? a.in[14][col - 4] : 0.f); }
      } }
    float* biasD = (float*)(ws + WS_BIASD); float* rpb = (float*)(ws + WS_RPB);
    for (int t = vcu * NTHREADS + tid; t < 8 * 15 * 31; t += G * NTHREADS) {
        if (t < 3 * 4 * 129) { const int j = t % 129, hh = (t / 129) % 4, g = t / (129 * 4); const int dil = g == 0 ? 1 : (g == 1 ? 4 : 16);
            biasD[t] = a.in[6][t5_bucket((j - 64) * dil) * 12 + g * 4 + hh] * LOG2E; }
        rpb[t] = a.in[5][t] * LOG2E;
    }
}

struct SchedInProj {
    const char* A; const char* B; int G, c;
    __device__ __forceinline__ bool next(int i, pg8::Unit& u) const {
        const int L = i * G + c; constexpr int NW = 256 * 16;
        int pm, pn;
        if (L < NW) { const int wgid = pg8::xcd_remap(L, NW); const int nig = pg8::WGM * 16, gid = wgid / nig, fm = gid * pg8::WGM; pm = fm + ((wgid % nig) % pg8::WGM); pn = (wgid % nig) / pg8::WGM; }
        else return false;
        u.A = A + (size_t)pm * 256 * DM * 2; u.B0 = B + (size_t)pn * 256 * DM * 2; u.B1 = u.B0; u.ksplit = 1 << 30; u.e0 = pm; u.e1 = pn; u.e2 = 0; u.e3 = 0;
        return true;
    }
    template <bool GATHER> __device__ __forceinline__ void aoffs(const pg8::Unit&, const int (&sR)[2], const int (&sC)[2], int lda, unsigned (&v)[2][2]) const {
#pragma unroll
        for (int h = 0; h < 2; ++h)
#pragma unroll
            for (int i = 0; i < 2; ++i) v[h][i] = (unsigned)((sR[i] + 128 * h) * lda + sC[i]) * 2u;
    }
};
struct EpiInProj {
    static constexpr bool PERM = true;
    bf16_t* QKV; bf16_t* KVM; const float* gain; const float* rstdx;
    __device__ __forceinline__ void operator()(const f32x4 (&acc)[2][2][4][2], const pg8::Unit& u, int wr, int wc, int fr, int fq) const {
        const int pm = u.e0, pn = u.e1;
        int gi = -1; float sc = 1.f; bf16_t* base; int hplane, nrows, rowt;
        if (pn < 16) { base = QKV; hplane = 4 * pn; nrows = NTOK; rowt = pm * 256;
            if (pn < 2) { gi = 0; sc = QSCALE; } else if (pn < 4) gi = 1; else if (pn < 6) gi = -1; else if (pn < 9) { gi = 2; sc = QSCALE; } else if (pn < 12) gi = 3; else if (pn < 15) gi = -1; else { gi = 4; sc = QSCALE; } }
        else { base = KVM; hplane = 4 * (pn - 16); nrows = BATCH * MEM_LEN; rowt = (pm - 256) * 256; gi = pn == 16 ? 5 : -1; }
        float gv[2][2][4];
#pragma unroll
        for (int bj = 0; bj < 2; ++bj)
#pragma unroll
            for (int n = 0; n < 2; ++n)
#pragma unroll
                for (int j = 0; j < 4; ++j) gv[bj][n][j] = gi >= 0 ? gain[gi * 64 + 32 * bj + 8 * fq + 4 * n + j] * sc : 1.f;
        float rxs[2][4];
#pragma unroll
        for (int ai = 0; ai < 2; ++ai)
#pragma unroll
            for (int m = 0; m < 4; ++m) rxs[ai][m] = pn < 16 ? rstdx[rowt + ai * 128 + wr * 64 + m * 16 + fr] : 1.f;
        float rr[2][4];
#pragma unroll
        for (int ai = 0; ai < 2; ++ai)
#pragma unroll
            for (int m = 0; m < 4; ++m) {
                float ss = 0.f;
#pragma unroll
                for (int bj = 0; bj < 2; ++bj)
#pragma unroll
                    for (int n = 0; n < 2; ++n) { const f32x4 x = acc[ai][bj][m][n]; ss += (x[0] * x[0] + x[1] * x[1]) + (x[2] * x[2] + x[3] * x[3]); }
                rr[ai][m] = ss;
            }
#pragma unroll
        for (int ai = 0; ai < 2; ++ai)
#pragma unroll
            for (int m = 0; m < 4; ++m) {
                { auto r = __builtin_amdgcn_permlane16_swap(__float_as_uint(rr[ai][m]), __float_as_uint(rr[ai][m]), false, false); rr[ai][m] = __uint_as_float(r[0]) + __uint_as_float(r[1]); }
                { auto r = __builtin_amdgcn_permlane32_swap(__float_as_uint(rr[ai][m]), __float_as_uint(rr[ai][m]), false, false); rr[ai][m] = __uint_as_float(r[0]) + __uint_as_float(r[1]); }
            }
#pragma unroll
        for (int ai = 0; ai < 2; ++ai)
#pragma unroll
            for (int m = 0; m < 4; ++m) {
                const float rx = rxs[ai][m];
                const float ss = rr[ai][m];
                const float r = (gi >= 0 ? rsqrtf(ss * (rx * rx) * (1.f / 64.f) + EPS) : 1.f) * rx;
                bf16_t* rowp = base + ((size_t)(hplane + wc) * nrows + (rowt + ai * 128 + wr * 64 + m * 16 + fr)) * 64 + 8 * fq;
#pragma unroll
                for (int bj = 0; bj < 2; ++bj) {
                    const f32x4 v0 = acc[ai][bj][m][0], v1 = acc[ai][bj][m][1];
                    u32x4 w;
                    w.x = cvt_pk_bf16(v0[0] * r * gv[bj][0][0], v0[1] * r * gv[bj][0][1]); w.y = cvt_pk_bf16(v0[2] * r * gv[bj][0][2], v0[3] * r * gv[bj][0][3]);
                    w.z = cvt_pk_bf16(v1[0] * r * gv[bj][1][0], v1[1] * r * gv[bj][1][1]); w.w = cvt_pk_bf16(v1[2] * r * gv[bj][1][2], v1[3] * r * gv[bj][1][3]);
                    *(u32x4*)(rowp + 32 * bj) = w;
                }
            }
    }
};


struct SchedOutProj {
    const char* A; const char* B; int G, c;
    __device__ __forceinline__ bool next(int i, pg8::Unit& u) const {
        const int L = i * G + c; constexpr int NW = 256 * 4;
        if (L >= NW) return false;
        const int wgid = pg8::xcd_remap(L, NW); const int nig = pg8::WGM * 4, gid = wgid / nig, fm = gid * pg8::WGM; const int pm = fm + ((wgid % nig) % pg8::WGM), pn = (wgid % nig) / pg8::WGM;
        u.A = A + (size_t)pm * 256 * DM * 2; u.B0 = B + (size_t)pn * 256 * DM * 2; u.B1 = u.B0; u.ksplit = 1 << 30; u.e0 = pm; u.e1 = pn; u.e2 = 0; u.e3 = 0;
        return true;
    }
    template <bool GATHER> __device__ __forceinline__ void aoffs(const pg8::Unit&, const int (&sR)[2], const int (&sC)[2], int lda, unsigned (&v)[2][2]) const {
#pragma unroll
        for (int h = 0; h < 2; ++h)
#pragma unroll
            for (int i = 0; i < 2; ++i) v[h][i] = (unsigned)((sR[i] + 128 * h) * lda + sC[i]) * 2u;
    }
};
struct EpiOutProj {
    static constexpr bool PERM = true;
    const bf16_t* X; bf16_t* O;
    __device__ __forceinline__ void operator()(const f32x4 (&acc)[2][2][4][2], const pg8::Unit& u, int wr, int wc, int fr, int fq) const {
        const int row0 = u.e0 * 256 + wr * 64 + fr, col0 = u.e1 * 256 + wc * 32 + 8 * fq;
        u32x4 xv[2][4][2];
#pragma unroll
        for (int ai = 0; ai < 2; ++ai)
#pragma unroll
            for (int m = 0; m < 4; ++m) { const size_t off = (size_t)(row0 + ai * 128 + m * 16) * DM + col0;
#pragma unroll
                for (int bj = 0; bj < 2; ++bj) xv[ai][m][bj] = *(const u32x4*)(X + off + bj * 128); }
#pragma unroll
        for (int ai = 0; ai < 2; ++ai)
#pragma unroll
            for (int m = 0; m < 4; ++m) { const size_t off = (size_t)(row0 + ai * 128 + m * 16) * DM + col0;
#pragma unroll
                for (int bj = 0; bj < 2; ++bj) { const u32x4 w0 = xv[ai][m][bj];
                    const f32x4 x0 = (f32x4){__uint_as_float(w0.x << 16), __uint_as_float(w0.x & 0xffff0000u), __uint_as_float(w0.y << 16), __uint_as_float(w0.y & 0xffff0000u)};
                    const f32x4 x1v = (f32x4){__uint_as_float(w0.z << 16), __uint_as_float(w0.z & 0xffff0000u), __uint_as_float(w0.w << 16), __uint_as_float(w0.w & 0xffff0000u)};
                    const f32x4 v0 = x0 + acc[ai][bj][m][0], v1 = x1v + acc[ai][bj][m][1];
                    u32x4 w; w.x = cvt_pk_bf16(v0[0], v0[1]); w.y = cvt_pk_bf16(v0[2], v0[3]); w.z = cvt_pk_bf16(v1[0], v1[1]); w.w = cvt_pk_bf16(v1[2], v1[3]);
                    *(u32x4*)(O + off + bj * 128) = w; } }
    }
};

constexpr int TT_OFF = RING_BYTES;
constexpr int TT_PBASE = 1 + 2 * MAXTILES, TT_E = TT_PBASE + NPAIR;
static_assert((TT_E + 1 + 2 * MAXETILES) * 4 <= 16384, "tile tables fit the spare LDS");
__device__ __forceinline__ int moe_build_tiles(LAS unsigned char* lds, const unsigned* count, const unsigned* ecount) {
    LAS int* tt = (LAS int*)(lds + TT_OFF);
    __syncthreads();
    if (threadIdx.x == 0) {
        int nt = 0;
        for (int L = 0; L < NPAIR; ++L) { tt[TT_PBASE + L] = nt; const int c = (int)__hip_atomic_load(count + L, __ATOMIC_RELAXED, __HIP_MEMORY_SCOPE_AGENT); for (int r = 0; r < c; r += 256) { tt[1 + nt] = L; tt[1 + MAXTILES + nt] = r; ++nt; } }
        tt[0] = nt;
    }
    if (threadIdx.x == 64) {
        int ne = 0;
        for (int e = 0; e < NEXP; ++e) { const int c = (int)__hip_atomic_load(ecount + e, __ATOMIC_RELAXED, __HIP_MEMORY_SCOPE_AGENT); for (int r = 0; r < c; r += 256) { tt[TT_E + 1 + ne] = e; tt[TT_E + 1 + MAXETILES + ne] = r; ++ne; } }
        tt[TT_E] = ne;
    }
    __syncthreads();
    return tt[0];
}
struct SchedMoe1 {
    const char* Hb; const char* W13T; const int* elists; const unsigned* ecount; const LAS int* tt; int netiles, G, c;
    __device__ __forceinline__ bool next(int i, pg8::Unit& u) const {
        const int L = i * G + c, nwg = netiles * 4;
        if (L >= nwg) return false;
        const int U = pg8::xcd_remap(L, nwg), T = U >> 2, pn = U & 3;
        const int e = tt[TT_E + 1 + T], row0 = tt[TT_E + 1 + MAXETILES + T];
        u.A = Hb; u.B0 = W13T + ((size_t)e * 1024 + pn * 256) * DM * 2; u.B1 = u.B0; u.ksplit = 1 << 30; u.e0 = T; u.e1 = pn; u.e2 = e; u.e3 = row0;
        return true;
    }
    template <bool GATHER> __device__ __forceinline__ void aoffs(const pg8::Unit& u, const int (&sR)[2], const int (&sC)[2], int lda, unsigned (&v)[2][2]) const {
        const int cnt = (int)ecount[u.e2]; const int* lp = elists + (size_t)u.e2 * NTOK;
#pragma unroll
        for (int h = 0; h < 2; ++h)
#pragma unroll
            for (int i = 0; i < 2; ++i) { int p = u.e3 + 128 * h + sR[i]; p = p < cnt ? p : cnt - 1; const int tok = lp[p] >> 1; v[h][i] = (unsigned)(tok * lda + sC[i]) * 2u; }
    }
};
struct EpiMoe1 {
    static constexpr bool PERM = true;
    bf16_t* ACT; const int* elists; const unsigned* ecount; const float* tokg; const float* trstd; const int* tokP; const LAS int* tt;
    __device__ __forceinline__ void operator()(const f32x4 (&acc)[2][2][4][2], const pg8::Unit& u, int wr, int wc, int fr, int fq) const {
        const int pn = u.e1, e = u.e2, row0 = u.e3;
        const int cnt = (int)ecount[e]; const int* lp = elists + (size_t)e * NTOK;
#pragma unroll
        for (int ai = 0; ai < 2; ++ai)
#pragma unroll
            for (int m = 0; m < 4; ++m) {
                const int p = row0 + ai * 128 + wr * 64 + m * 16 + fr;
                if (p < cnt) {
                    const int ent = lp[p], tok = ent >> 1, role = ent & 1;
                    const float g = tokg[tok * 2 + role]; const float rs = trstd[tok]; const int tp = tokP[tok];
                    const int drow = tt[TT_PBASE + (tp >> 16)] * 256 + (tp & 0xffff);
                    const f32x4 a0 = acc[ai][0][m][0], a1 = acc[ai][0][m][1], b0 = acc[ai][1][m][0], b1 = acc[ai][1][m][1];
                    float o[8];
#pragma unroll
                    for (int j = 0; j < 4; ++j) { const float x0 = a0[j] * rs, x1v = a1[j] * rs; o[j] = x0 / (1.f + __expf(-x0)) * (b0[j] * rs) * g; o[4 + j] = x1v / (1.f + __expf(-x1v)) * (b1[j] * rs) * g; }
                    u32x4 w; w.x = cvt_pk_bf16(o[0], o[1]); w.y = cvt_pk_bf16(o[2], o[3]); w.z = cvt_pk_bf16(o[4], o[5]); w.w = cvt_pk_bf16(o[6], o[7]);
                    *(u32x4*)(ACT + (size_t)drow * DM + 512 * role + 128 * pn + 32 * wc + 8 * fq) = w;
                }
            }
    }
};
struct SchedMoe2 {
    const char* ACTb; const char* W2T; const LAS int* tt; int ntiles, G, c;
    __device__ __forceinline__ bool next(int i, pg8::Unit& u) const {
        const int L = i * G + c, nwg = ntiles * 4;
        if (L >= nwg) return false;
        const int U = pg8::xcd_remap(L, nwg), T = U >> 2, pn = U & 3;
        const int list = tt[1 + T], row0 = tt[1 + MAXTILES + T];
        int ea, eb; pair_experts(list, ea, eb);
        u.A = ACTb + (size_t)T * 256 * DM * 2; u.B0 = W2T + ((size_t)ea * 1024 + pn * 256) * DEXP * 2; u.B1 = W2T + ((size_t)eb * 1024 + pn * 256) * DEXP * 2 - 8 * 128; u.ksplit = 8;
        u.e0 = T; u.e1 = pn; u.e2 = list; u.e3 = row0;
        return true;
    }
    template <bool GATHER> __device__ __forceinline__ void aoffs(const pg8::Unit&, const int (&sR)[2], const int (&sC)[2], int lda, unsigned (&v)[2][2]) const {
#pragma unroll
        for (int h = 0; h < 2; ++h)
#pragma unroll
            for (int i = 0; i < 2; ++i) v[h][i] = (unsigned)((sR[i] + 128 * h) * lda + sC[i]) * 2u;
    }
};
struct EpiMoe2 {
    static constexpr bool PERM = true;
    float* O; const bf16_t* X1; const int* lists; const unsigned* count; float scale;
    __device__ __forceinline__ void operator()(const f32x4 (&acc)[2][2][4][2], const pg8::Unit& u, int wr, int wc, int fr, int fq) const {
        const int pn = u.e1, list = u.e2, row0 = u.e3;
        const int cnt = (int)count[list]; const int* lp = lists + (size_t)list * NTOK;
        const int col0 = pn * 256 + wc * 32 + 8 * fq;
        int tok[2][4];
#pragma unroll
        for (int ai = 0; ai < 2; ++ai)
#pragma unroll
            for (int m = 0; m < 4; ++m) { const int p = row0 + ai * 128 + wr * 64 + m * 16 + fr; tok[ai][m] = p < cnt ? lp[p] : -1; }
#pragma unroll
        for (int ai = 0; ai < 2; ++ai) {
            u32x4 xv[4][2];
#pragma unroll
            for (int m = 0; m < 4; ++m) { const bf16_t* rowp = X1 + (size_t)(tok[ai][m] < 0 ? 0 : tok[ai][m]) * DM + col0;
#pragma unroll
                for (int bj = 0; bj < 2; ++bj) xv[m][bj] = *(const u32x4*)(rowp + bj * 128); }
#pragma unroll
            for (int m = 0; m < 4; ++m) if (tok[ai][m] >= 0) { float* rowp = O + (size_t)tok[ai][m] * DM + col0;
#pragma unroll
                for (int bj = 0; bj < 2; ++bj) { const u32x4 w = xv[m][bj];
                    const f32x4 x0 = (f32x4){__uint_as_float(w.x << 16), __uint_as_float(w.x & 0xffff0000u), __uint_as_float(w.y << 16), __uint_as_float(w.y & 0xffff0000u)};
                    const f32x4 x1v = (f32x4){__uint_as_float(w.z << 16), __uint_as_float(w.z & 0xffff0000u), __uint_as_float(w.w << 16), __uint_as_float(w.w & 0xffff0000u)};
                    *(f32x4*)(rowp + bj * 128) = x0 + acc[ai][bj][m][0] * scale; *(f32x4*)(rowp + bj * 128 + 4) = x1v + acc[ai][bj][m][1] * scale; } }
            asm volatile("" ::: "memory");
        }
    }
};


namespace att {
typedef short v4i16_t __attribute__((ext_vector_type(4)));
typedef short s16x4 __attribute__((ext_vector_type(4)));
typedef float f32x2_t __attribute__((ext_vector_type(2)));
typedef __bf16 bf16x2_t __attribute__((ext_vector_type(2)));
__device__ __forceinline__ unsigned cvtpk(float lo, float hi) { f32x2_t v = {lo, hi}; bf16x2_t b = __builtin_convertvector(v, bf16x2_t); return __builtin_bit_cast(unsigned, b); }
__device__ __forceinline__ s16x4 vtr(const LAS unsigned char* p) { return __builtin_bit_cast(s16x4, __builtin_amdgcn_ds_read_tr16_b64_v4i16((LAS v4i16_t*)p)); }
__device__ __forceinline__ constexpr int crow0(int r) { return (r & 3) + 8 * (r >> 2); }
constexpr float NEG_INF = -__builtin_huge_valf();

constexpr int L_V = 0;
constexpr int L_SO = 65536, SO_PITCH = 136;
constexpr int L_SM = L_SO + 512 * SO_PITCH;
constexpr int L_SL = L_SM + 2048;
constexpr int L_BIAS = L_SL + 2048;
static_assert(L_BIAS + 4096 <= LDS_BYTES - 256, "attention LDS map");

struct Ctx {
    int lane, q, h;
    LAS unsigned char* vl;
    unsigned vw, vr0, vr1;
    unsigned kw, kr;
};
__device__ __forceinline__ Ctx make_ctx(LAS unsigned char* lds, int wave, int lane) {
    Ctx c; c.lane = lane; c.q = lane & 31; c.h = lane >> 5; c.vl = lds + L_V + wave * 8192;
    { const int key = lane >> 3, ch = lane & 7, swz = ((key >> 1) & 1) << 2; c.vw = (unsigned)(key * 128 + ((ch ^ swz) << 4)); }
    { const int qp = (lane & 15) >> 2, p = lane & 3, sub = (lane >> 4) & 1, swz = ((qp >> 1) & 1) << 2, x = 2 * sub + (p >> 1);
      c.vr0 = (unsigned)((4 * c.h + qp) * 128 + (((0 ^ swz) + x) << 4) + (p & 1) * 8);
      c.vr1 = (unsigned)((4 * c.h + qp) * 128 + (((4 ^ swz) + x) << 4) + (p & 1) * 8); }
    c.kw = (unsigned)((lane >> 3) * 128);
    c.kr = (unsigned)((lane & 31) * 128);
    return c;
}

template <class Spec>
__device__ __forceinline__ void tile_core(const Spec& sp, const Ctx& c, int t, const LAS unsigned char* vt, const LAS unsigned char* kt, const bf16x8 (&qf)[4], float& m, float& l, f32x16& o0, f32x16& o1);
template <bool LOAD, class Spec>
__device__ __forceinline__ void tile_step(const Spec& sp, const Ctx& c, int t, int tnext, u32x4 (&kreg)[4], u32x4 (&vreg)[4], const bf16x8 (&qf)[4], float& m, float& l, f32x16& o0, f32x16& o1) {
    const int key_lo = c.lane >> 3, chn = c.lane & 7;
#pragma unroll
    for (int i = 0; i < 4; ++i) {
        *(LAS u32x4*)(c.vl + c.vw + i * 1024) = vreg[i];
        const int ksw = ((key_lo >> 1) + 4 * i) & 7;
        *(LAS u32x4*)(c.vl + 4096 + c.kw + i * 1024 + ((chn ^ ksw) << 4)) = kreg[i];
    }
    if constexpr (LOAD) { sp.loadKV(tnext, kreg, vreg); __builtin_amdgcn_sched_barrier(0); }
    tile_core(sp, c, t, c.vl, c.vl + 4096, qf, m, l, o0, o1);
}
template <class Spec>
__device__ __forceinline__ void tile_core(const Spec& sp, const Ctx& c, int t, const LAS unsigned char* vt, const LAS unsigned char* kt, const bf16x8 (&qf)[4], float& m, float& l, f32x16& o0, f32x16& o1) {
    bf16x8 kf[4];
    { const int ksw = ((c.lane & 31) >> 1) & 7;
#pragma unroll
      for (int ks = 0; ks < 4; ++ks) kf[ks] = *(const LAS bf16x8*)(kt + c.kr + (((2 * ks + c.h) ^ ksw) << 4)); }
    f32x16 s;
#pragma unroll
    for (int r = 0; r < 16; ++r) s[r] = 0.f;
#pragma unroll
    for (int ks = 0; ks < 4; ++ks) s = __builtin_amdgcn_mfma_f32_32x32x16_bf16(kf[ks], qf[ks], s, 0, 0, 0);
    sp.bias(t, s);
    float mx = s[0];
#pragma unroll
    for (int r = 1; r < 16; ++r) mx = fmaxf(mx, s[r]);
    { auto rr = __builtin_amdgcn_permlane32_swap(__float_as_uint(mx), __float_as_uint(mx), false, false); mx = fmaxf(__uint_as_float(rr[0]), __uint_as_float(rr[1])); }
    const float mn = fmaxf(m, mx);
    if (__any(mn > m)) {
        const float al = __builtin_amdgcn_exp2f(m - mn);
        l *= al;
#pragma unroll
        for (int r = 0; r < 16; ++r) { o0[r] *= al; o1[r] *= al; }
        m = mn;
    }
    float ps = 0.f;
#pragma unroll
    for (int r = 0; r < 16; ++r) { s[r] = __builtin_amdgcn_exp2f(s[r] - m); ps += s[r]; }
    l += ps;
    bf16x8 pf[2];
#pragma unroll
    for (int s2 = 0; s2 < 2; ++s2) { u32x4 w; w.x = cvtpk(s[8 * s2 + 0], s[8 * s2 + 1]); w.y = cvtpk(s[8 * s2 + 2], s[8 * s2 + 3]); w.z = cvtpk(s[8 * s2 + 4], s[8 * s2 + 5]); w.w = cvtpk(s[8 * s2 + 6], s[8 * s2 + 7]); pf[s2] = __builtin_bit_cast(bf16x8, w); }
#pragma unroll
    for (int s2 = 0; s2 < 2; ++s2) {
        const s16x4 a0 = vtr(vt + c.vr0 + s2 * 2048), a1 = vtr(vt + c.vr0 + s2 * 2048 + 1024);
        const s16x4 b0 = vtr(vt + c.vr1 + s2 * 2048), b1 = vtr(vt + c.vr1 + s2 * 2048 + 1024);
        const bf16x8 v0 = (bf16x8){a0[0], a0[1], a0[2], a0[3], a1[0], a1[1], a1[2], a1[3]};
        const bf16x8 v1 = (bf16x8){b0[0], b0[1], b0[2], b0[3], b1[0], b1[1], b1[2], b1[3]};
        o0 = __builtin_amdgcn_mfma_f32_32x32x16_bf16(v0, pf[s2], o0, 0, 0, 0);
        o1 = __builtin_amdgcn_mfma_f32_32x32x16_bf16(v1, pf[s2], o1, 0, 0, 0);
    }
}

struct QState { float m, l; f32x16 o0, o1; };
__device__ __forceinline__ void softmax_tile(f32x16& s, QState& st, bf16x8 (&pf)[2]) {
    float mx = s[0];
#pragma unroll
    for (int r = 1; r < 16; ++r) mx = fmaxf(mx, s[r]);
    { auto rr = __builtin_amdgcn_permlane32_swap(__float_as_uint(mx), __float_as_uint(mx), false, false); mx = fmaxf(__uint_as_float(rr[0]), __uint_as_float(rr[1])); }
    const float mn = fmaxf(st.m, mx);
    if (__any(mn > st.m)) {
        const float al = __builtin_amdgcn_exp2f(st.m - mn);
        st.l *= al;
#pragma unroll
        for (int r = 0; r < 16; ++r) { st.o0[r] *= al; st.o1[r] *= al; }
        st.m = mn;
    }
    float ps = 0.f;
#pragma unroll
    for (int r = 0; r < 16; ++r) { s[r] = __builtin_amdgcn_exp2f(s[r] - st.m); ps += s[r]; }
    st.l += ps;
#pragma unroll
    for (int s2 = 0; s2 < 2; ++s2) { u32x4 w; w.x = cvtpk(s[8 * s2 + 0], s[8 * s2 + 1]); w.y = cvtpk(s[8 * s2 + 2], s[8 * s2 + 3]); w.z = cvtpk(s[8 * s2 + 4], s[8 * s2 + 5]); w.w = cvtpk(s[8 * s2 + 6], s[8 * s2 + 7]); pf[s2] = __builtin_bit_cast(bf16x8, w); }
}
__device__ __forceinline__ void tile_core2(const Ctx& c, const LAS unsigned char* vt, const LAS unsigned char* kt, const bf16x8 (&qa)[4], const bf16x8 (&qb)[4], QState& A, QState& B) {
    bf16x8 kf[4];
    { const int ksw = ((c.lane & 31) >> 1) & 7;
#pragma unroll
      for (int ks = 0; ks < 4; ++ks) kf[ks] = *(const LAS bf16x8*)(kt + c.kr + (((2 * ks + c.h) ^ ksw) << 4)); }
    f32x16 sa, sb;
#pragma unroll
    for (int r = 0; r < 16; ++r) { sa[r] = 0.f; sb[r] = 0.f; }
#pragma unroll
    for (int ks = 0; ks < 4; ++ks) { sa = __builtin_amdgcn_mfma_f32_32x32x16_bf16(kf[ks], qa[ks], sa, 0, 0, 0); sb = __builtin_amdgcn_mfma_f32_32x32x16_bf16(kf[ks], qb[ks], sb, 0, 0, 0); }
    bf16x8 pa[2], pb[2];
    softmax_tile(sa, A, pa); softmax_tile(sb, B, pb);
#pragma unroll
    for (int s2 = 0; s2 < 2; ++s2) {
        const s16x4 a0 = vtr(vt + c.vr0 + s2 * 2048), a1 = vtr(vt + c.vr0 + s2 * 2048 + 1024);
        const s16x4 b0 = vtr(vt + c.vr1 + s2 * 2048), b1 = vtr(vt + c.vr1 + s2 * 2048 + 1024);
        const bf16x8 v0 = (bf16x8){a0[0], a0[1], a0[2], a0[3], a1[0], a1[1], a1[2], a1[3]};
        const bf16x8 v1 = (bf16x8){b0[0], b0[1], b0[2], b0[3], b1[0], b1[1], b1[2], b1[3]};
        A.o0 = __builtin_amdgcn_mfma_f32_32x32x16_bf16(v0, pa[s2], A.o0, 0, 0, 0); A.o1 = __builtin_amdgcn_mfma_f32_32x32x16_bf16(v1, pa[s2], A.o1, 0, 0, 0);
        B.o0 = __builtin_amdgcn_mfma_f32_32x32x16_bf16(v0, pb[s2], B.o0, 0, 0, 0); B.o1 = __builtin_amdgcn_mfma_f32_32x32x16_bf16(v1, pb[s2], B.o1, 0, 0, 0);
    }
}

__device__ __forceinline__ void dma16(__amdgpu_buffer_rsrc_t rs, LAS unsigned char* dst, int vo, int so) { __builtin_amdgcn_raw_ptr_buffer_load_lds(rs, (LAS void*)dst, 16, vo, so, 0, 0); }
template <class Spec>
__device__ __forceinline__ void run_dma(const Spec& sp, const Ctx& c, const bf16x8 (&qf)[4], float& m, float& l, f32x16& o0, f32x16& o1) {
    constexpr int NT = Spec::NT;
    LAS unsigned char* vt = c.vl; LAS unsigned char* kt = c.vl + 4096;
    asm volatile("s_waitcnt vmcnt(0) lgkmcnt(0)" ::: "memory");
    sp.dmaK(0, kt); sp.dmaV(0, vt);
    __builtin_amdgcn_sched_barrier(0);
#pragma unroll 1
    for (int t = 0; t < NT; ++t) {
        const bool more = t + 1 < NT;
        asm volatile("s_waitcnt vmcnt(4)" ::: "memory");
        bf16x8 kf[4];
        { const int ksw = ((c.lane & 31) >> 1) & 7;
#pragma unroll
          for (int ks = 0; ks < 4; ++ks) kf[ks] = *(const LAS bf16x8*)(kt + c.kr + (((2 * ks + c.h) ^ ksw) << 4)); }
        asm volatile("s_waitcnt lgkmcnt(0)" ::: "memory");
        if (more) sp.dmaK(t + 1, kt);
        __builtin_amdgcn_sched_barrier(0);
        f32x16 s;
#pragma unroll
        for (int r = 0; r < 16; ++r) s[r] = 0.f;
#pragma unroll
        for (int ks = 0; ks < 4; ++ks) s = __builtin_amdgcn_mfma_f32_32x32x16_bf16(kf[ks], qf[ks], s, 0, 0, 0);
        sp.bias(t, s);
        QState st; bf16x8 pf[2];
        st.m = m; st.l = l; st.o0 = o0; st.o1 = o1;
        softmax_tile(s, st, pf);
        m = st.m; l = st.l; o0 = st.o0; o1 = st.o1;
        if (more) asm volatile("s_waitcnt vmcnt(4)" ::: "memory"); else asm volatile("s_waitcnt vmcnt(0)" ::: "memory");
        const s16x4 a0 = vtr(vt + c.vr0), a1 = vtr(vt + c.vr0 + 1024), a2 = vtr(vt + c.vr0 + 2048), a3 = vtr(vt + c.vr0 + 3072);
        const s16x4 b0 = vtr(vt + c.vr1), b1 = vtr(vt + c.vr1 + 1024), b2 = vtr(vt + c.vr1 + 2048), b3 = vtr(vt + c.vr1 + 3072);
        asm volatile("s_waitcnt lgkmcnt(0)" ::: "memory");
        if (more) sp.dmaV(t + 1, vt);
        __builtin_amdgcn_sched_barrier(0);
        const bf16x8 v00 = (bf16x8){a0[0], a0[1], a0[2], a0[3], a1[0], a1[1], a1[2], a1[3]}, v01 = (bf16x8){a2[0], a2[1], a2[2], a2[3], a3[0], a3[1], a3[2], a3[3]};
        const bf16x8 v10 = (bf16x8){b0[0], b0[1], b0[2], b0[3], b1[0], b1[1], b1[2], b1[3]}, v11 = (bf16x8){b2[0], b2[1], b2[2], b2[3], b3[0], b3[1], b3[2], b3[3]};
        o0 = __builtin_amdgcn_mfma_f32_32x32x16_bf16(v00, pf[0], o0, 0, 0, 0); o1 = __builtin_amdgcn_mfma_f32_32x32x16_bf16(v10, pf[0], o1, 0, 0, 0);
        o0 = __builtin_amdgcn_mfma_f32_32x32x16_bf16(v01, pf[1], o0, 0, 0, 0); o1 = __builtin_amdgcn_mfma_f32_32x32x16_bf16(v11, pf[1], o1, 0, 0, 0);
    }
}
template <class Spec>
__device__ __forceinline__ void run(const Spec& sp, const Ctx& c, const bf16x8 (&qf)[4], float& m, float& l, f32x16& o0, f32x16& o1) {
    constexpr int NT = Spec::NT;
    static_assert(NT >= 4, "tile loop is peeled for NT >= 4");
    u32x4 kA[4], vA[4], kB[4], vB[4];
    sp.loadKV(0, kA, vA); sp.loadKV(1, kB, vB);
    int t = 0;
#pragma unroll 1
    for (; t + 3 < NT; t += 2) {
        tile_step<true>(sp, c, t, t + 2, kA, vA, qf, m, l, o0, o1);
        tile_step<true>(sp, c, t + 1, t + 3, kB, vB, qf, m, l, o0, o1);
    }
    if constexpr ((NT & 1) == 0) {
        tile_step<false>(sp, c, NT - 2, 0, kA, vA, qf, m, l, o0, o1);
        tile_step<false>(sp, c, NT - 1, 0, kB, vB, qf, m, l, o0, o1);
    } else {
        tile_step<true>(sp, c, NT - 3, NT - 1, kA, vA, qf, m, l, o0, o1);
        tile_step<false>(sp, c, NT - 2, 0, kB, vB, qf, m, l, o0, o1);
        tile_step<false>(sp, c, NT - 1, 0, kA, vA, qf, m, l, o0, o1);
    }
}
__device__ __forceinline__ float pair_sum(float v) { auto rr = __builtin_amdgcn_permlane32_swap(__float_as_uint(v), __float_as_uint(v), false, false); return __uint_as_float(rr[0]) + __uint_as_float(rr[1]); }
template <class P> __device__ __forceinline__ void store_o(P rowp, const f32x16& o0, const f32x16& o1, float inv, int h) {
#pragma unroll
    for (int g4 = 0; g4 < 4; ++g4) {
        u32x2 w0, w1; w0.x = cvtpk(o0[4 * g4] * inv, o0[4 * g4 + 1] * inv); w0.y = cvtpk(o0[4 * g4 + 2] * inv, o0[4 * g4 + 3] * inv);
        w1.x = cvtpk(o1[4 * g4] * inv, o1[4 * g4 + 1] * inv); w1.y = cvtpk(o1[4 * g4 + 2] * inv, o1[4 * g4 + 3] * inv);
        *(u32x2*)(rowp + (8 * g4 + 4 * h) * 2) = w0; *(u32x2*)(rowp + (32 + 8 * g4 + 4 * h) * 2) = w1;
    }
}
__device__ __forceinline__ void load_q(const unsigned char* qrow, int h, bf16x8 (&qf)[4]) {
#pragma unroll
    for (int ks = 0; ks < 4; ++ks) qf[ks] = *(const bf16x8*)(qrow + (16 * ks + 8 * h) * 2);
}

__device__ __forceinline__ u32x4 bload(__amdgpu_buffer_rsrc_t rs, int vo, int so) { return __builtin_amdgcn_raw_buffer_load_b128(rs, vo, so, 0); }
constexpr int NA_NEGIDX = 544;
struct SpecNA {
    static constexpr int NT = 9;
    __amdgpu_buffer_rsrc_t rs; int vo[4]; int rw0, kcolK, kcolV;
    int qr, r0q, bidx; const LAS float* btab; f32x16 madd;
    int dk0, dk1, dv0;
    __device__ __forceinline__ void dmaK(int t, LAS unsigned char* kt) const { int row = rw0 + t; row = row > GRID_R - 1 ? GRID_R - 1 : row; const int so = row * (GRID_W * 128) + kcolK;
        dma16(rs, kt, dk0, so); dma16(rs, kt + 1024, dk1, so + 1024); dma16(rs, kt + 2048, dk0, so + 2048); dma16(rs, kt + 3072, dk1, so + 3072); }
    __device__ __forceinline__ void dmaV(int t, LAS unsigned char* vt) const { int row = rw0 + t; row = row > GRID_R - 1 ? GRID_R - 1 : row; const int so = row * (GRID_W * 128) + kcolV;
        dma16(rs, vt, dv0, so); dma16(rs, vt + 1024, dv0, so + 1024); dma16(rs, vt + 2048, dv0, so + 2048); dma16(rs, vt + 3072, dv0, so + 3072); }
    __device__ __forceinline__ void loadKV(int t, u32x4 (&kr)[4], u32x4 (&vr)[4]) const {
        int row = rw0 + t; row = row > GRID_R - 1 ? GRID_R - 1 : row; const int so = row * (GRID_W * 128);
#pragma unroll
        for (int i = 0; i < 4; ++i) { kr[i] = bload(rs, vo[i], so + kcolK); vr[i] = bload(rs, vo[i], so + kcolV); } }
    __device__ __forceinline__ void bias(int t, f32x16& s) const {
        const int row = rw0 + t; const bool rv = (unsigned)(row - r0q) < 8u;
        const int idx = rv ? bidx + (row - qr + 7) * 31 : NA_NEGIDX;
        float bv[16];
#pragma unroll
        for (int rg = 0; rg < 16; ++rg) bv[rg] = btab[idx + crow0(rg)];
#pragma unroll
        for (int rg = 0; rg < 16; ++rg) asm volatile("" : "+v"(bv[rg]));
#pragma unroll
        for (int rg = 0; rg < 16; ++rg) s[rg] = (s[rg] + bv[rg]) + madd[rg];
    }
};
struct SpecDil {
    static constexpr int NT = 5;
    __amdgpu_buffer_rsrc_t rs; int pi[4]; int cb, kcolK, kcolV;
    int pos0, dil, q, h; const LAS float* btab;
    int ck0, ck1, cv0;
    __device__ __forceinline__ int cl(int p) const { return p < 0 ? 0 : (p > SEQ - 1 ? SEQ - 1 : p); }
    __device__ __forceinline__ void dmaK(int t, LAS unsigned char* kt) const { const int d = 32 * dil * t;
        dma16(rs, kt, cl(pi[0] + d) * 128 + ck0, kcolK); dma16(rs, kt + 1024, cl(pi[1] + d) * 128 + ck1, kcolK); dma16(rs, kt + 2048, cl(pi[2] + d) * 128 + ck0, kcolK); dma16(rs, kt + 3072, cl(pi[3] + d) * 128 + ck1, kcolK); }
    __device__ __forceinline__ void dmaV(int t, LAS unsigned char* vt) const { const int d = 32 * dil * t;
        dma16(rs, vt, cl(pi[0] + d) * 128 + cv0, kcolV); dma16(rs, vt + 1024, cl(pi[1] + d) * 128 + cv0, kcolV); dma16(rs, vt + 2048, cl(pi[2] + d) * 128 + cv0, kcolV); dma16(rs, vt + 3072, cl(pi[3] + d) * 128 + cv0, kcolV); }
    __device__ __forceinline__ void loadKV(int t, u32x4 (&kr)[4], u32x4 (&vr)[4]) const {
#pragma unroll
        for (int i = 0; i < 4; ++i) { int p = pi[i] + 32 * dil * t; p = p < 0 ? 0 : (p > SEQ - 1 ? SEQ - 1 : p); const int vo = p * 128 + cb; kr[i] = bload(rs, vo, kcolK); vr[i] = bload(rs, vo, kcolV); } }
    __device__ __forceinline__ void bias(int t, f32x16& s) const {
        const int idx = 32 + 32 * t + 4 * h - q;
        float bv[16];
#pragma unroll
        for (int rg = 0; rg < 16; ++rg) bv[rg] = btab[idx + crow0(rg)];
#pragma unroll
        for (int rg = 0; rg < 16; ++rg) asm volatile("" : "+v"(bv[rg]));
#pragma unroll
        for (int rg = 0; rg < 16; ++rg) s[rg] += bv[rg];
        const int lo = pos0 + dil * (-64 + 32 * t);
        if (lo < 0 || lo + 31 * dil >= SEQ) {
            const int pb = lo + dil * 4 * h;
#pragma unroll
            for (int rg = 0; rg < 16; ++rg) { const int pk = pb + dil * crow0(rg); s[rg] = ((unsigned)pk < (unsigned)SEQ) ? s[rg] : NEG_INF; }
        }
    }
};
struct SpecMem {
    static constexpr int NT = 8;
    __amdgpu_buffer_rsrc_t rs; int vo[4];
    __device__ __forceinline__ void loadKV(int t, u32x4 (&kr)[4], u32x4 (&vr)[4]) const {
        const int so = t * 32 * 128;
#pragma unroll
        for (int i = 0; i < 4; ++i) { kr[i] = bload(rs, vo[i], so); vr[i] = bload(rs, vo[i], so + 4 * BATCH * MEM_LEN * 128); } }
    __device__ __forceinline__ void bias(int, f32x16&) const {}
};

__device__ __forceinline__ void phase2(const MArgs& a, LAS unsigned char* lds, int vcu, int G) {
    const int tid = threadIdx.x, lane = tid & 63, wave = __builtin_amdgcn_readfirstlane(tid >> 6);
    const Ctx c = make_ctx(lds, wave, lane);
    const unsigned char* QKV = a.ws + WS_QKV; const unsigned char* KVM = a.ws + WS_KVM; unsigned char* MIX = a.ws + WS_MIX;
    const float* rpb = (const float*)(a.ws + WS_RPB); const float* biasD = (const float*)(a.ws + WS_BIASD);
    LAS float* lb = (LAS float*)(lds + L_BIAS);
    const int key_lo = lane >> 3, chunk16 = (lane & 7) * 16;
    for (int u = vcu; u < BATCH * NA_HEADS * (GRID_R / 4); u += G) {
        const int rg = u & 31, head = (u >> 5) & 7, b = u >> 8;
        __syncthreads();
        for (int i = tid; i < 576; i += NTHREADS) lb[i] = (i >= 32 && i < 32 + 465) ? rpb[head * 465 + i - 32] : (i >= NA_NEGIDX ? NEG_INF : 0.f);
        __syncthreads();
        const int rp = 2 * rg + (wave >> 2), I = wave & 3;
        const int qr = 2 * rp + (c.q >> 4), cq = 16 * I + (c.q & 15);
        const int sc = 16 * I - 8 < 0 ? 0 : (16 * I - 8 > 32 ? 32 : 16 * I - 8);
        const int c0 = cq - 8 < 0 ? 0 : (cq - 8 > GRID_W - 16 ? GRID_W - 16 : cq - 8);
        SpecNA sp; sp.rs = __builtin_amdgcn_make_buffer_rsrc((void*)(QKV + ((size_t)(C_KA / 64 + head) * NTOK + (size_t)b * SEQ) * 128), 0, 0x7fffffff, 0x00020000);
#pragma unroll
        for (int i = 0; i < 4; ++i) sp.vo[i] = (sc + key_lo + 8 * i) * 128 + chunk16;
        { const int chn = lane & 7, g16 = lane >> 4; sp.dk0 = (sc + key_lo) * 128 + ((chn ^ (g16 & 7)) << 4); sp.dk1 = (sc + key_lo) * 128 + ((chn ^ ((g16 + 4) & 7)) << 4); sp.dv0 = (sc + key_lo) * 128 + ((chn ^ ((g16 & 1) << 2)) << 4); }
        sp.rw0 = 2 * rp - 4 < 0 ? 0 : (2 * rp - 4 > GRID_R - 8 ? GRID_R - 8 : 2 * rp - 4);
        sp.kcolK = 0; sp.kcolV = ((C_VA - C_KA) / 64) * NTOK * 128;
        sp.qr = qr; sp.r0q = qr - 4 < 0 ? 0 : (qr - 4 > GRID_R - 8 ? GRID_R - 8 : qr - 4);
        sp.bidx = 32 + (sc - cq + 15) + 4 * c.h; sp.btab = lb;
#pragma unroll
        for (int r2 = 0; r2 < 16; ++r2) sp.madd[r2] = ((unsigned)(sc + crow0(r2) + 4 * c.h - c0) < 16u) ? 0.f : NEG_INF;
        const int tq = b * SEQ + qr * GRID_W + cq;
        bf16x8 qf[4]; load_q(QKV + ((size_t)(C_QA / 64 + head) * NTOK + tq) * 128, c.h, qf);
        float m = -1e30f, l = 0.f; f32x16 o0, o1;
#pragma unroll
        for (int i = 0; i < 16; ++i) { o0[i] = 0.f; o1[i] = 0.f; }
        run_dma(sp, c, qf, m, l, o0, o1);
        const float inv = 1.f / pair_sum(l);
        store_o(MIX + (size_t)tq * (DM * 2) + (head * 64) * 2, o0, o1, inv, c.h);
    }
    {
        struct NoBias { __device__ __forceinline__ void bias(int, f32x16&) const {} } nb;
        const int nqb = SEQ / 256;
        for (int u = vcu; u < BATCH * MEM_HEADS * 8; u += G) {
            const int pair = u >> 3, head = pair & 3, b = pair >> 2;
            __syncthreads();
            { const unsigned char* kb = KVM + ((size_t)head * BATCH * MEM_LEN + (size_t)b * MEM_LEN) * 128; const unsigned char* vb = kb + (size_t)4 * BATCH * MEM_LEN * 128;
#pragma unroll
              for (int i = 0; i < 4; ++i) { const int idx = tid + NTHREADS * i, key = idx >> 3, ch = idx & 7;
                  const u32x4 kv = *(const u32x4*)(kb + (size_t)key * 128 + ch * 16), vv = *(const u32x4*)(vb + (size_t)key * 128 + ch * 16);
                  *(LAS u32x4*)(lds + key * 128 + ((ch ^ ((key >> 1) & 7)) << 4)) = kv;
                  *(LAS u32x4*)(lds + 32768 + key * 128 + ((ch ^ (((key >> 1) & 1) << 2)) << 4)) = vv; } }
            __syncthreads();
#pragma unroll 1
            for (int qq = 0; qq < 2; ++qq) {
                const int q0 = (4 * (u & 7) + 2 * qq) * 256 + wave * 64; if (q0 >= SEQ) break;
                const int tqa = b * SEQ + q0 + c.q, tqb = tqa + 32;
                bf16x8 qa[4], qbf[4]; load_q(QKV + ((size_t)(C_QM / 64 + head) * NTOK + tqa) * 128, c.h, qa); load_q(QKV + ((size_t)(C_QM / 64 + head) * NTOK + tqb) * 128, c.h, qbf);
                QState A, B; A.m = -1e30f; A.l = 0.f; B.m = -1e30f; B.l = 0.f;
#pragma unroll
                for (int i = 0; i < 16; ++i) { A.o0[i] = 0.f; A.o1[i] = 0.f; B.o0[i] = 0.f; B.o1[i] = 0.f; }
#pragma unroll 1
                for (int t = 0; t < 8; ++t) tile_core2(c, lds + 32768 + t * 4096, lds + t * 4096, qa, qbf, A, B);
                store_o(MIX + (size_t)tqa * (DM * 2) + (NA_W + 256 + head * 64) * 2, A.o0, A.o1, 1.f / pair_sum(A.l), c.h);
                store_o(MIX + (size_t)tqb * (DM * 2) + (NA_W + 256 + head * 64) * 2, B.o0, B.o1, 1.f / pair_sum(B.l), c.h);
            }
        }
        __syncthreads();
    }
    LAS unsigned char* so = lds + L_SO; LAS float* sm = (LAS float*)(lds + L_SM); LAS float* sl = (LAS float*)(lds + L_SL);
    for (int u = vcu; u < BATCH * 4 * (SEQ / 512); u += G) {
        const int blk = u & 15, hh = (u >> 4) & 3, b = u >> 6;
        __syncthreads();
        for (int i = tid; i < 3 * 192; i += NTHREADS) { const int g = i / 192, j = i - 192 * g - 32; lb[i] = (j >= 0 && j <= 128) ? biasD[(g * 4 + hh) * 129 + j] : NEG_INF; }
        __syncthreads();
#pragma unroll 1
        for (int g = 0; g < 3; ++g) {
            const int dil = g == 0 ? 1 : (g == 1 ? 4 : 16), head = g * 4 + hh;
#pragma unroll 1
            for (int k = 0; k < 2; ++k) {
                const int tl = wave * 2 + k;
                const int base = g == 0 ? 32 * tl : (g == 1 ? (tl & 3) + 128 * (tl >> 2) : tl);
                const int tql = base + dil * c.q;
                const int tq = b * SEQ + blk * 512 + tql;
                SpecDil sp; sp.rs = __builtin_amdgcn_make_buffer_rsrc((void*)(QKV + ((size_t)(C_KD / 64 + head) * NTOK + (size_t)b * SEQ) * 128), 0, 0x7fffffff, 0x00020000); sp.pos0 = blk * 512 + base; sp.dil = dil; sp.q = c.q; sp.h = c.h; sp.btab = lb + g * 192; sp.cb = chunk16;
#pragma unroll
                for (int i = 0; i < 4; ++i) sp.pi[i] = sp.pos0 + dil * (-64 + key_lo + 8 * i);
                sp.kcolK = 0; sp.kcolV = ((C_VD - C_KD) / 64) * NTOK * 128;
                { const int chn = lane & 7, g16 = lane >> 4; sp.ck0 = (chn ^ (g16 & 7)) << 4; sp.ck1 = (chn ^ ((g16 + 4) & 7)) << 4; sp.cv0 = (chn ^ ((g16 & 1) << 2)) << 4; }
                bf16x8 qf[4]; load_q(QKV + ((size_t)(C_QD / 64 + head) * NTOK + tq) * 128, c.h, qf);
                float m, l; f32x16 o0, o1;
                if (g == 0) { m = -1e30f; l = 0.f;
#pragma unroll
                    for (int i = 0; i < 16; ++i) { o0[i] = 0.f; o1[i] = 0.f; } }
                else {
                    m = sm[tql]; const float lt = sl[tql]; l = c.h == 0 ? lt : 0.f;
                    const LAS unsigned char* rowp = so + tql * SO_PITCH;
#pragma unroll
                    for (int g4 = 0; g4 < 4; ++g4) {
                        const u32x2 w0 = *(const LAS u32x2*)(rowp + (8 * g4 + 4 * c.h) * 2), w1 = *(const LAS u32x2*)(rowp + (32 + 8 * g4 + 4 * c.h) * 2);
                        o0[4 * g4] = __uint_as_float(w0.x << 16) * lt; o0[4 * g4 + 1] = __uint_as_float(w0.x & 0xffff0000u) * lt; o0[4 * g4 + 2] = __uint_as_float(w0.y << 16) * lt; o0[4 * g4 + 3] = __uint_as_float(w0.y & 0xffff0000u) * lt;
                        o1[4 * g4] = __uint_as_float(w1.x << 16) * lt; o1[4 * g4 + 1] = __uint_as_float(w1.x & 0xffff0000u) * lt; o1[4 * g4 + 2] = __uint_as_float(w1.y << 16) * lt; o1[4 * g4 + 3] = __uint_as_float(w1.y & 0xffff0000u) * lt;
                    }
                }
                run_dma(sp, c, qf, m, l, o0, o1);
                const float lt = pair_sum(l); const float inv = 1.f / lt;
                if (g < 2) { store_o(so + tql * SO_PITCH, o0, o1, inv, c.h); if (c.h == 0) { sm[tql] = m; sl[tql] = lt; } }
                else store_o(MIX + (size_t)tq * (DM * 2) + (NA_W + hh * 64) * 2, o0, o1, inv, c.h);
            }
            __syncthreads();
        }
    }
}
}

__device__ __forceinline__ void memkv_mini(const MArgs& a, LAS unsigned char* lds, int u) {
    const int tid = threadIdx.x, lane = tid & 63, wave = __builtin_amdgcn_readfirstlane(tid >> 6);
    const int hd = u & 7, rb = u >> 3, rh = wave & 1, kq = wave >> 1, r = lane & 31, h = lane >> 5;
    const bf16_t* XNm = (const bf16_t*)(a.ws + WS_XN) + (size_t)NTOK * DM;
    const bf16_t* WT = (const bf16_t*)(a.ws + WS_WINT);
    const bf16_t* arow = XNm + (size_t)(rb * 64 + rh * 32 + r) * DM + kq * 256 + 8 * h;
    const int n0 = 64 * hd + r, n1 = n0 + 32;
    const bf16_t* b0 = WT + (size_t)(4096 + inproj_pos(n0)) * DM + kq * 256 + 8 * h;
    const bf16_t* b1 = WT + (size_t)(4096 + inproj_pos(n1)) * DM + kq * 256 + 8 * h;
    f32x16 c0, c1;
#pragma unroll
    for (int i = 0; i < 16; ++i) { c0[i] = 0.f; c1[i] = 0.f; }
#pragma unroll 4
    for (int s2 = 0; s2 < 16; ++s2) {
        const bf16x8 af = *(const bf16x8*)(arow + 16 * s2), bf0 = *(const bf16x8*)(b0 + 16 * s2), bf1 = *(const bf16x8*)(b1 + 16 * s2);
        c0 = __builtin_amdgcn_mfma_f32_32x32x16_bf16(af, bf0, c0, 0, 0, 0);
        c1 = __builtin_amdgcn_mfma_f32_32x32x16_bf16(af, bf1, c1, 0, 0, 0);
    }
    LAS float* part = (LAS float*)lds + ((kq * 2 + rh) * 32) * 64;
#pragma unroll
    for (int i = 0; i < 16; ++i) { const int row = (i & 3) + 8 * (i >> 2) + 4 * h; part[row * 64 + r] = c0[i]; part[row * 64 + 32 + r] = c1[i]; }
    __syncthreads();
    { const int row = tid >> 3, cg = tid & 7; const int rh2 = row >> 5, rr = row & 31;
      float v[8];
#pragma unroll
      for (int j = 0; j < 8; ++j) { float sacc = 0.f;
#pragma unroll
          for (int q = 0; q < 4; ++q) sacc += ((LAS float*)lds)[(((q * 2 + rh2) * 32) + rr) * 64 + cg * 8 + j];
          v[j] = sacc; }
      float ss = 0.f;
#pragma unroll
      for (int j = 0; j < 8; ++j) ss += v[j] * v[j];
      ss += __shfl_xor(ss, 1); ss += __shfl_xor(ss, 2); ss += __shfl_xor(ss, 4);
      const float rn = hd < 4 ? rsqrtf(ss * (1.f / 64.f) + EPS) : 1.f;
      u32x4 w;
      if (hd < 4) { const float* gq = a.in[4] + 5 * 64 + cg * 8;
          w.x = att::cvtpk(v[0] * rn * gq[0], v[1] * rn * gq[1]); w.y = att::cvtpk(v[2] * rn * gq[2], v[3] * rn * gq[3]); w.z = att::cvtpk(v[4] * rn * gq[4], v[5] * rn * gq[5]); w.w = att::cvtpk(v[6] * rn * gq[6], v[7] * rn * gq[7]); }
      else { w.x = att::cvtpk(v[0], v[1]); w.y = att::cvtpk(v[2], v[3]); w.z = att::cvtpk(v[4], v[5]); w.w = att::cvtpk(v[6], v[7]); }
      bf16_t* KVM = (bf16_t*)(a.ws + WS_KVM);
      *(u32x4*)(KVM + ((size_t)hd * (BATCH * MEM_LEN) + rb * 64 + row) * 64 + cg * 8) = w;
    }
    __syncthreads();
}

__device__ __forceinline__ void phase4(const MArgs& a, LAS unsigned char* lds, int vcu, int G, bool dry) {
    const int tid = threadIdx.x, lane = tid & 63, wave = __builtin_amdgcn_readfirstlane(tid >> 6);
    const int r = lane & 15, kq = lane >> 4;
    LAS float* sR = (LAS float*)(lds + wave * 4096);
    LAS float* sLg = sR + 16;
    const bf16_t* x1 = (const bf16_t*)(a.ws + WS_X1B); const float* g_ffn = a.in[10];
    const bf16_t* WfH = (const bf16_t*)(a.ws + WS_WRF); const bf16_t* WfL = WfH + 32 * 3 * 64 * 8; const float* b48 = (const float*)(a.ws + WS_WRF + 2 * 32 * 3 * 64 * 8 * 2);
    constexpr int P4_MAXSLOT = 512;
    LAS int* hP = (LAS int*)(lds + 32768); LAS int* hE = hP + 128; LAS int* bP = hE + 32; LAS int* bE = bP + 128; LAS int* tinfo = bE + 32;
    for (int i = tid; i < 320 + P4_MAXSLOT * 4; i += NTHREADS) hP[i] = i < 320 ? 0 : -1;
    __syncthreads();
    int slot0 = wave * 16;
    bf16_t* H = (bf16_t*)(a.ws + WS_H); float* tokg = (float*)(a.ws + WS_TOKG); float* trstd = (float*)(a.ws + WS_RSTD); int* lists = (int*)(a.ws + WS_LIST); unsigned* count = (unsigned*)(a.ws + WS_CTL) + CW_COUNT;
    int* elists = (int*)(a.ws + WS_ELIST); int* tokP = (int*)(a.ws + WS_TOKP); unsigned* ecount = (unsigned*)(a.ws + WS_CTL) + CW_ECOUNT;
    for (int tile = vcu * NWAVES + wave; tile < NTOK / 16; tile += G * NWAVES) {
        const int tok0 = tile * 16;
        const bf16_t* xr = x1 + (size_t)(tok0 + r) * DM + 8 * kq;
        bf16_t* hr = H + (size_t)(tok0 + r) * DM + 8 * kq;
        f32x4 acc[3]; float ss = 0.f;
#pragma unroll
        for (int ct = 0; ct < 3; ++ct) acc[ct] = (f32x4){0.f, 0.f, 0.f, 0.f};
#pragma unroll 2
        for (int s = 0; s < 32; ++s) {
            const u32x4 xw = *(const u32x4*)(xr + 32 * s);
            const f32x4 xa = (f32x4){__uint_as_float(xw.x << 16), __uint_as_float(xw.x & 0xffff0000u), __uint_as_float(xw.y << 16), __uint_as_float(xw.y & 0xffff0000u)};
            const f32x4 xb = (f32x4){__uint_as_float(xw.z << 16), __uint_as_float(xw.z & 0xffff0000u), __uint_as_float(xw.w << 16), __uint_as_float(xw.w & 0xffff0000u)};
            ss += (xa[0] * xa[0] + xa[1] * xa[1]) + (xa[2] * xa[2] + xa[3] * xa[3]) + (xb[0] * xb[0] + xb[1] * xb[1]) + (xb[2] * xb[2] + xb[3] * xb[3]);
            const bf16x8 ah = __builtin_bit_cast(bf16x8, xw);
#pragma unroll
            for (int ct = 0; ct < 3; ++ct) {
                const bf16x8 wh = *(const bf16x8*)(WfH + ((size_t)(s * 3 + ct) * 64 + lane) * 8), wl = *(const bf16x8*)(WfL + ((size_t)(s * 3 + ct) * 64 + lane) * 8);
                acc[ct] = __builtin_amdgcn_mfma_f32_16x16x32_bf16(ah, wh, acc[ct], 0, 0, 0);
                acc[ct] = __builtin_amdgcn_mfma_f32_16x16x32_bf16(ah, wl, acc[ct], 0, 0, 0);
            }
        }
        ss += __shfl_xor(ss, 16); ss += __shfl_xor(ss, 32);
        const float rstd = rsqrtf(ss * (1.f / DM) + EPS);
        if (kq == 0) { sR[r] = rstd; trstd[tok0 + r] = rstd; }
#pragma unroll
        for (int ct = 0; ct < 3; ++ct) { const float bb = b48[16 * ct + r];
#pragma unroll
            for (int i = 0; i < 4; ++i) { const int tk = 4 * kq + i; sLg[tk * 48 + 16 * ct + r] = acc[ct][i] * sR[tk] + bb; } }
        if (lane < 16) {
            const int tok = tok0 + lane; const LAS float* lg = sLg + lane * 48;
            int gi = 0; float gm = lg[0];
            for (int i = 1; i < 4; ++i) if (lg[i] > gm) { gm = lg[i]; gi = i; }
            float den = 0.f; for (int i = 0; i < 4; ++i) den += __expf(lg[i] - gm);
            const float grp_gate = 1.f / den;
            const LAS float* fl = lg + 4 + gi * 8;
            int i0 = 0; float v0 = fl[0];
            for (int i = 1; i < 8; ++i) if (fl[i] > v0) { v0 = fl[i]; i0 = i; }
            int i1 = -1; float v1 = -3.0e38f;
            for (int i = 0; i < 8; ++i) if (i != i0 && fl[i] > v1) { v1 = fl[i]; i1 = i; }
            const float e1 = __expf(v1 - v0); const float g0 = grp_gate / (1.f + e1), g1 = grp_gate * e1 / (1.f + e1);
            int pa, pb; float ga, gb;
            if (i0 < i1) { pa = i0; pb = i1; ga = g0; gb = g1; } else { pa = i1; pb = i0; ga = g1; gb = g0; }
            const int L = gi * 28 + pa * 8 - pa * (pa + 1) / 2 + (pb - pa - 1);
            tokg[tok * 2] = ga; tokg[tok * 2 + 1] = gb;
            if (!dry) {
                const int ea = gi * 8 + pa, eb = gi * 8 + pb;
                if (slot0 + 16 <= P4_MAXSLOT) {
                    const int rp = __hip_atomic_fetch_add(&hP[L], 1, __ATOMIC_RELAXED, __HIP_MEMORY_SCOPE_WORKGROUP);
                    const int ra = __hip_atomic_fetch_add(&hE[ea], 1, __ATOMIC_RELAXED, __HIP_MEMORY_SCOPE_WORKGROUP);
                    const int rb = __hip_atomic_fetch_add(&hE[eb], 1, __ATOMIC_RELAXED, __HIP_MEMORY_SCOPE_WORKGROUP);
                    LAS int* ti = tinfo + (slot0 + lane) * 4;
                    ti[0] = tok; ti[1] = (L << 16) | rp; ti[2] = (ea << 16) | ra; ti[3] = (eb << 16) | rb;
                } else {
                    const unsigned pos = atomicAdd(&count[L], 1u); lists[(size_t)L * NTOK + pos] = tok; tokP[tok] = (L << 16) | (int)pos;
                    const unsigned qa = atomicAdd(&ecount[ea], 1u); elists[(size_t)ea * NTOK + qa] = tok * 2;
                    const unsigned qb = atomicAdd(&ecount[eb], 1u); elists[(size_t)eb * NTOK + qb] = tok * 2 + 1;
                }
            }
        }
        slot0 += NWAVES * 16;
    }
    if (!dry) {
        __syncthreads();
        const int nslot = slot0 - wave * 16 < P4_MAXSLOT ? slot0 - wave * 16 : P4_MAXSLOT;
        if (tid < NPAIR) { const int h = hP[tid]; bP[tid] = h ? (int)atomicAdd(&count[tid], (unsigned)h) : 0; }
        else if (tid >= 128 && tid < 128 + NEXP) { const int h = hE[tid - 128]; bE[tid - 128] = h ? (int)atomicAdd(&ecount[tid - 128], (unsigned)h) : 0; }
        __syncthreads();
        for (int sidx = tid; sidx < nslot; sidx += NTHREADS) {
            const LAS int* ti = tinfo + sidx * 4; const int tok = ti[0];
            if (tok >= 0) {
                const int L = ti[1] >> 16, pos = bP[L] + (ti[1] & 0xffff); lists[(size_t)L * NTOK + pos] = tok; tokP[tok] = (L << 16) | pos;
                const int ea = ti[2] >> 16, eb = ti[3] >> 16;
                elists[(size_t)ea * NTOK + bE[ea] + (ti[2] & 0xffff)] = tok * 2;
                elists[(size_t)eb * NTOK + bE[eb] + (ti[3] & 0xffff)] = tok * 2 + 1;
            }
        }
    }
}

#define XB_TMO      128
#define XB_XCNT(j)  (256  + 64 * (j))
#define XB_XSUB(j)  (1280 + 64 * (j))
#define XB_XGEN(j)  (2304 + 64 * (j))
#define XB_TOP      3328
#define XB_TOPGEN   3392
#define XCD_BAR_WORDS 3456
#define XB_SPIN_CAP (1u << 18)
__device__ __forceinline__ unsigned xb_ld(unsigned* p)              { return __hip_atomic_load(p, __ATOMIC_RELAXED, __HIP_MEMORY_SCOPE_AGENT); }
__device__ __forceinline__ unsigned xb_add(unsigned* p, unsigned v) { return __hip_atomic_fetch_add(p, v, __ATOMIC_RELAXED, __HIP_MEMORY_SCOPE_AGENT); }
__device__ __forceinline__ unsigned xb_xcc_id() { return (unsigned)__builtin_amdgcn_s_getreg((3 << 11) | 20) & 0xFu; }
#define XB_SPIN(cond, bar) do { unsigned _sp = 0; while (cond) { __builtin_amdgcn_s_sleep(1); \
    if ((++_sp & 255u) == 0u) { if (xb_ld(&(bar)[XB_TMO])) break; if (_sp > XB_SPIN_CAP) { atomicAdd(&(bar)[XB_TMO], 1u); break; } } } } while (0)
struct XcdBarrier { unsigned* bar; unsigned x; volatile LAS unsigned* st; };
__device__ __forceinline__ XcdBarrier xcd_barrier_post(unsigned* bar, volatile LAS unsigned* st) {
    XcdBarrier b; b.bar = bar; b.x = xb_xcc_id(); b.st = st;
    if (threadIdx.x == 0) (void)xb_add(&bar[XB_XCNT(b.x)], 1u);
    return b;
}
__device__ __forceinline__ void xcd_barrier_complete(unsigned* bar, unsigned x, unsigned& nloc, unsigned& nx) {
    const unsigned G = gridDim.x * gridDim.y * gridDim.z;
    unsigned sum, cnt, mine, sp = 0u;
    for (;;) {
        sum = 0u; cnt = 0u; mine = 0u;
#pragma unroll
        for (unsigned j = 0; j < 16; ++j) { const unsigned c = xb_ld(&bar[XB_XCNT(j)]); sum += c; cnt += (c > 0u) ? 1u : 0u; mine = (j == x) ? c : mine; }
        if (sum == G) break;
        __builtin_amdgcn_s_sleep(1);
        if ((++sp & 255u) == 0u) { if (xb_ld(&bar[XB_TMO])) break; if (sp > XB_SPIN_CAP) { atomicAdd(&bar[XB_TMO], 1u); break; } }
    }
    nloc = mine > 0u ? mine : 1u; nx = cnt > 0u ? cnt : 1u;
}
__device__ __forceinline__ void xcd_barrier(const XcdBarrier& b) {
    asm volatile("s_waitcnt vmcnt(0)" ::: "memory");
    __syncthreads();
    if (threadIdx.x == 0) {
        unsigned* bar = b.bar;
        __builtin_amdgcn_s_waitcnt(0);
        unsigned nloc = b.st[0], nx = b.st[1];
        if (nloc == 0u) { xcd_barrier_complete(bar, b.x, nloc, nx); b.st[0] = nloc; b.st[1] = nx; }
        const unsigned old = xb_add(&bar[XB_XSUB(b.x)], 1u);
        const unsigned gen = old / nloc;
        if (old + 1u == (gen + 1u) * nloc) {
            __builtin_amdgcn_fence(__ATOMIC_RELEASE, "agent");
            asm volatile("s_waitcnt vmcnt(0)" ::: "memory");
            const unsigned og = xb_add(&bar[XB_TOP], 1u);
            const unsigned tg = og / nx;
            if (og + 1u == (tg + 1u) * nx) xb_add(&bar[XB_TOPGEN], 1u);
            else XB_SPIN(xb_ld(&bar[XB_TOPGEN]) == tg, bar);
            __builtin_amdgcn_fence(__ATOMIC_ACQUIRE, "agent");
            xb_add(&bar[XB_XGEN(b.x)], 1u);
            asm volatile("s_waitcnt vmcnt(0)" ::: "memory");
        } else {
            XB_SPIN(xb_ld(&bar[XB_XGEN(b.x)]) == gen, bar);
            __builtin_amdgcn_fence(__ATOMIC_ACQUIRE, "agent");
            asm volatile("s_waitcnt vmcnt(0)" ::: "memory");
        }
    }
    __syncthreads();
}
constexpr int CW_BAR = 4096;
constexpr int MISC_OFF = LDS_BYTES - 256;

__global__ void __launch_bounds__(NTHREADS, 2) mega(MArgs a) {
    extern __shared__ __attribute__((aligned(16))) unsigned char lds_raw[];
    LAS unsigned char* lds = (LAS unsigned char*)lds_raw;
    const int G = gridDim.x; const int bx = blockIdx.x; const int vcu = (G % 8 == 0) ? (bx % 8) * (G / 8) + bx / 8 : bx;
    const int lo = a.ph_lo, hi = a.ph_hi;
#define IN_PH(k) (lo <= (k) && (k) < hi)
    volatile LAS unsigned* misc = (volatile LAS unsigned*)(lds + MISC_OFF);
    if (threadIdx.x < 2) misc[threadIdx.x] = 0u;
    __syncthreads();
    XcdBarrier xbar; xbar.bar = (unsigned*)(a.ws + WS_CTL) + CW_BAR; xbar.x = 0; xbar.st = misc;
    if (hi - lo > 1) xbar = xcd_barrier_post((unsigned*)(a.ws + WS_CTL) + CW_BAR, misc);
#define SEAM(k) do { if (IN_PH(k) && IN_PH((k) + 1)) { if ((k) == 0) cg::this_grid().sync(); else xcd_barrier(xbar); } } while (0)
    if (IN_PH(0)) { phase0(a, lds, vcu, G); }
    SEAM(0);
    if (IN_PH(1)) {
        for (int u = bx; u < 256; u += G) memkv_mini(a, lds, u);
        SchedInProj S{(const char*)(a.ws + WS_XN), (const char*)(a.ws + WS_WINT), G, bx};
        EpiInProj E{(bf16_t*)(a.ws + WS_QKV), (bf16_t*)(a.ws + WS_KVM), a.in[4], (const float*)(a.ws + WS_RSTDX)};
        pg8::gemm_phase<EpiInProj, SchedInProj, false, true>(lds, DM / 64, DM, DM, S, E);
    }
    SEAM(1);
    if (IN_PH(2)) { att::phase2(a, lds, vcu, G); }
    SEAM(2);
    if (IN_PH(3)) {
        SchedOutProj S{(const char*)(a.ws + WS_MIX), (const char*)(a.ws + WS_WOT), G, bx};
        EpiOutProj E{(const bf16_t*)(a.ws + WS_XN), (bf16_t*)(a.ws + WS_X1B)};
        pg8::gemm_phase<EpiOutProj, SchedOutProj, false, true>(lds, DM / 64, DM, DM, S, E);
    }
    SEAM(3);
    if (IN_PH(4) || lo == 7) { phase4(a, lds, vcu, G, lo == 7); }
    SEAM(4);
    if (IN_PH(5)) {
        const unsigned* count = (const unsigned*)(a.ws + WS_CTL) + CW_COUNT; const unsigned* ecount = (const unsigned*)(a.ws + WS_CTL) + CW_ECOUNT;
        moe_build_tiles(lds, count, ecount);
        const LAS int* tt = (const LAS int*)(lds + TT_OFF);
        SchedMoe1 S{(const char*)(a.ws + WS_X1B), (const char*)(a.ws + WS_W13T), (const int*)(a.ws + WS_ELIST), ecount, tt, tt[TT_E], G, bx};
        EpiMoe1 E{(bf16_t*)(a.ws + WS_ACT), (const int*)(a.ws + WS_ELIST), ecount, (const float*)(a.ws + WS_TOKG), (const float*)(a.ws + WS_RSTD), (const int*)(a.ws + WS_TOKP), tt};
        pg8::gemm_phase<EpiMoe1, SchedMoe1, true, true>(lds, DM / 64, DM, DM, S, E);
    }
    SEAM(5);
    if (IN_PH(6) || lo == 8) {
        const unsigned* count = (const unsigned*)(a.ws + WS_CTL) + CW_COUNT;
        const int ntiles = moe_build_tiles(lds, count, (const unsigned*)(a.ws + WS_CTL) + CW_ECOUNT);
        SchedMoe2 S{(const char*)(a.ws + WS_ACT), (const char*)(a.ws + WS_W2T), (const LAS int*)(lds + TT_OFF), ntiles, G, bx};
        EpiMoe2 E{a.out, (const bf16_t*)(a.ws + WS_X1B), (const int*)(a.ws + WS_LIST), count, lo == 8 ? 0.f : 1.f};
        pg8::gemm_phase<EpiMoe2, SchedMoe2, false, true>(lds, DM / 64, DM, DEXP, S, E);
    }
#undef IN_PH
#undef SEAM
}

static void launch_mega(const MArgs& base, int lo, int hi, int grid, hipStream_t stream) {
    MArgs a = base; a.ph_lo = lo; a.ph_hi = hi;
    hipLaunchKernelGGL(mega, dim3(grid), dim3(NTHREADS), LDS_BYTES, stream, a);
}
extern "C" void kernel_launch(void* const* d_in, const int* in_sizes, int n_in, void* d_out, int out_size, void* d_ws, size_t ws_size, hipStream_t stream) {
    if (n_in != 18 || ws_size < WS_END || out_size != NTOK * DM) { fprintf(stderr, "kernel_launch: unexpected sizes n_in %d ws %zu out %d\n", n_in, ws_size, out_size); return; }
    static int grid = 0;
    if (grid == 0) {
        int dev = 0, cus = 0, per_cu = 0;
        if (hipGetDevice(&dev) != hipSuccess || hipDeviceGetAttribute(&cus, hipDeviceAttributeMultiprocessorCount, dev) != hipSuccess) { grid = -1; return; }
        if (hipFuncSetAttribute((const void*)mega, hipFuncAttributeMaxDynamicSharedMemorySize, LDS_BYTES) != hipSuccess) { fprintf(stderr, "hipFuncSetAttribute failed\n"); grid = -1; return; }
        if (hipOccupancyMaxActiveBlocksPerMultiprocessor(&per_cu, (const void*)mega, NTHREADS, LDS_BYTES) != hipSuccess || per_cu < 1) { fprintf(stderr, "occupancy query failed (%d)\n", per_cu); grid = -1; return; }
        grid = cus * per_cu;
    }
    if (grid < 0) return;
    MArgs base; memset(&base, 0, sizeof base);
    for (int i = 0; i < 18; ++i) base.in[i] = (const float*)d_in[i];
    base.out = (float*)d_out; base.ws = (unsigned char*)d_ws;
    static_assert((CW_BAR + XCD_BAR_WORDS) * 4 <= 65536 && (CW_ECOUNT + NEXP) * 4 <= 65536, "control words inside the zeroed region");
    (void)hipMemsetAsync((unsigned char*)d_ws + WS_CTL, 0, 65536, stream);
#if MK_ONE_LAUNCH
    base.ph_lo = 0; base.ph_hi = 7;
    void* args[] = {&base};
    hipError_t e = hipLaunchCooperativeKernel((const void*)mega, dim3(grid), dim3(NTHREADS), args, LDS_BYTES, stream);
    if (e != hipSuccess) fprintf(stderr, "cooperative launch failed: %s (grid %d)\n", hipGetErrorString(e), grid);
#else
    for (int p = 0; p < 7; ++p) { launch_mega(base, p, p + 1, grid, stream); if (p == MK_REP_PHASE) launch_mega(base, p, p + 1, grid, stream); if (p == 4 && MK_REP_PHASE == 7) launch_mega(base, 7, 8, grid, stream); if (p == 6 && MK_REP_PHASE == 8) launch_mega(base, 8, 9, grid, stream); }
#endif
    (void)in_sizes;
}
```

```cpp
#include <hip/hip_runtime.h>
#include <hip/hip_cooperative_groups.h>
#include <cstdio>
#include <cstdint>
#include <cstring>

constexpr int DM = 1024, BATCH = 8, SEQ = 8192, NTOK = BATCH * SEQ;
constexpr int HD = 64, MEM_LEN = 256, GRID_W = 64, GRID_R = SEQ / GRID_W;
constexpr int NA_HEADS = 8, DIL_HEADS = 12, MEM_HEADS = 4;
constexpr int NA_W = 512, DIL_W = 768, MEM_W = 256, IN_COLS = 4096;
constexpr int C_QA = 0, C_KA = 512, C_VA = 1024, C_QD = 1536, C_KD = 2304, C_VD = 3072, C_QM = 3840;
constexpr int NEXP = 32, DEXP = 512;
constexpr int NPAIR = 112;
constexpr int MROWS = NTOK + MEM_LEN * BATCH;
constexpr float EPS = 1e-6f;
constexpr float LOG2E = 1.4426950408889634f;
constexpr float QSCALE = 0.125f * LOG2E;

typedef unsigned short bf16_t;
namespace cg = cooperative_groups;
#ifndef MK_ONE_LAUNCH
#define MK_ONE_LAUNCH 1
#endif
#ifndef MK_REP_PHASE
#define MK_REP_PHASE -1
#endif

constexpr size_t MiB = 1u << 20;
constexpr size_t WS_CTL = 0;
constexpr size_t WS_BIASD = 1 * MiB;
constexpr size_t WS_RPB = 1 * MiB + 64 * 1024;
constexpr size_t WS_WRF = 1 * MiB + 128 * 1024;
constexpr size_t WS_TOKG = 2 * MiB;
constexpr size_t WS_RSTD = 2 * MiB + 512 * 1024;
constexpr size_t WS_LIST = 4 * MiB;
constexpr size_t WS_KVM = 32 * MiB;
constexpr size_t WS_ELIST = 36 * MiB;
constexpr size_t WS_TOKP = 2 * MiB + 768 * 1024;
constexpr size_t WS_WT = 48 * MiB;
constexpr size_t WS_XN = 160 * MiB;
constexpr size_t WS_QKV = 304 * MiB;
constexpr size_t WS_H = WS_QKV;
constexpr size_t WS_X1Q = WS_QKV;
constexpr float SC_X1 = 16.f, SC_W13 = 512.f, SC_ACT = 8.f, SC_W2 = 256.f;
constexpr size_t WS_ACT = WS_QKV + 128 * MiB;
constexpr size_t WS_X1B = 640 * MiB;
constexpr size_t WS_MIX = 816 * MiB;
constexpr size_t WS_RSTDX = 3 * MiB;
constexpr size_t WS_END = 944 * MiB;
constexpr int MAXTILES = NTOK / 256 + NPAIR;
constexpr int CW_COUNT = 64;
constexpr int CW_ECOUNT = 256;
constexpr int MAXETILES = 2 * NTOK / 256 + 32;

__device__ __forceinline__ float bf2f(bf16_t v) { return __uint_as_float((unsigned)v << 16); }
__device__ __forceinline__ bf16_t f2bf(float f) { unsigned u = __float_as_uint(f); return (bf16_t)((u + 0x7fffu + ((u >> 16) & 1u)) >> 16); }
__device__ __forceinline__ float wave_sum(float v) {
#pragma unroll
    for (int o = 1; o < 64; o <<= 1) v += __shfl_xor(v, o);
    return v;
}

__device__ __forceinline__ int t5_bucket(int rel) {
    const int n = rel < 0 ? -rel : rel;
    const int upper = rel > 0 ? 16 : 0;
    const float nf = (float)(n < 1 ? 1 : n);
    int large = 8 + (int)(logf(nf / 8.f) / logf(128.f) * 8.f);
    large = large < 15 ? large : 15;
    return upper + (n < 8 ? n : large);
}
__device__ __forceinline__ void pair_experts(int L, int& ea, int& eb) {
    const int grp = L / 28; int idx = L % 28; int a = 0;
    while (idx >= 7 - a) { idx -= 7 - a; ++a; }
    ea = grp * 8 + a; eb = grp * 8 + a + 1 + idx;
}

#define LAS __attribute__((address_space(3)))
typedef short bf16x8 __attribute__((ext_vector_type(8)));
typedef float f32x4 __attribute__((ext_vector_type(4)));
typedef float f32x16 __attribute__((ext_vector_type(16)));
typedef unsigned u32x4 __attribute__((ext_vector_type(4)));
typedef unsigned u32x2 __attribute__((ext_vector_type(2)));

constexpr int NWAVES = 8, NTHREADS = 512;
constexpr int LDS_BYTES = 163840;
constexpr int RING_BYTES = 131072;

constexpr size_t WS_WINT = WS_WT;
constexpr size_t WS_WOT = WS_WINT + (size_t)4608 * 1024 * 2;
constexpr size_t WS_W13T = WS_WOT + (size_t)1024 * 1024 * 2;
constexpr size_t WS_W2T = WS_W13T + (size_t)32 * 1024 * 1024 * 2;
static_assert(WS_W2T + (size_t)32 * 1024 * 512 * 2 <= WS_XN, "weight copies fit");
static_assert(WS_ACT + (size_t)MAXTILES * 256 * 1024 * 2 <= WS_X1B && WS_X1B + (size_t)NTOK * 1024 * 2 <= WS_MIX, "ACT | X1B | MIX do not overlap");

__device__ __forceinline__ unsigned cvt_pk_bf16(float lo, float hi) { unsigned r; asm volatile("v_cvt_pk_bf16_f32 %0, %1, %2" : "=v"(r) : "v"(lo), "v"(hi)); return r; }
__device__ __forceinline__ unsigned pk4_fp8(float a, float b, float c, float d) { int w = 0; w = __builtin_amdgcn_cvt_pk_fp8_f32(a, b, w, false); w = __builtin_amdgcn_cvt_pk_fp8_f32(c, d, w, true); return (unsigned)w; }
__device__ __forceinline__ unsigned pk2(float lo, float hi) { return (unsigned)f2bf(lo) | ((unsigned)f2bf(hi) << 16); }

namespace pg8 {
constexpr int BM = 256, BK = 64, HALF = 128, HTB = HALF * BK * 2, NXCD = 8, WGM = 8;
__device__ __forceinline__ int lds_byte(int r, int c) { const int st = (r >> 4) * 2 + (c >> 5), rr = r & 15, cc = c & 31, ob = rr * 64 + cc * 2; return st * 1024 + (ob ^ (((ob >> 9) & 1) << 5)); }
__device__ __forceinline__ void stage_rc(int b, int& R, int& C) { const int st = b / 1024, sb = b % 1024, swz = sb ^ (((sb >> 9) & 1) << 5); R = (st >> 1) * 16 + swz / 64; C = (st & 1) * 32 + (swz % 64) / 2; }
__device__ __forceinline__ int perm32(int rho) { const int n = rho >> 4, i = rho & 15; return 8 * (i >> 2) + 4 * n + (i & 3); }

typedef short bf16x16_t __attribute__((ext_vector_type(16)));
typedef int i32x4_t __attribute__((ext_vector_type(4)));
typedef int i32x8_t __attribute__((ext_vector_type(8)));
__device__ __forceinline__ f32x4 mfma_fp8(const bf16x8& a0, const bf16x8& a1, const bf16x8& b0, const bf16x8& b1, const f32x4& c) {
    const i32x8_t A = __builtin_shufflevector(__builtin_bit_cast(i32x4_t, a0), __builtin_bit_cast(i32x4_t, a1), 0, 1, 2, 3, 4, 5, 6, 7);
    const i32x8_t B = __builtin_shufflevector(__builtin_bit_cast(i32x4_t, b0), __builtin_bit_cast(i32x4_t, b1), 0, 1, 2, 3, 4, 5, 6, 7);
    return __builtin_amdgcn_mfma_scale_f32_16x16x128_f8f6f4(A, B, c, 0, 0, 0, 0x7F7F7F7F, 0, 0x7F7F7F7F);
}
struct Unit { const char* A; const char* B0; const char* B1; int ksplit; int e0, e1, e2, e3; };

__device__ __forceinline__ int xcd_remap(int L, int nwg) { const int q = nwg / NXCD, r = nwg % NXCD, xcd = L % NXCD, off = L / NXCD; return (xcd < r ? xcd * (q + 1) : r * (q + 1) + (xcd - r) * q) + off; }

template <class Epi, class Sched, bool GATHER, bool ALIGN_EPI, bool FP8 = false>
__device__ __forceinline__ void gemm_phase(LAS unsigned char* lds, const int nt, const int lda, const int ldb, const Sched& S, const Epi& E) {
    const int tid = threadIdx.x, wid = __builtin_amdgcn_readfirstlane(tid >> 6), lane = tid & 63, wr = wid >> 2, wc = wid & 3, fr = lane & 15, fq = lane >> 4;
    int sR[2], sC[2]; unsigned voffB[2];
#pragma unroll
    for (int i = 0; i < 2; ++i) { int R, C; stage_rc(tid * 16 + i * 8192, R, C); sR[i] = R; sC[i] = C; const int Rb = Epi::PERM ? ((R & ~31) + perm32(R & 31)) : R; voffB[i] = (unsigned)(Rb * ldb + C) * 2u; }
    const size_t kstep = (size_t)(BK * 2);
    const size_t hstepB = (size_t)HALF * ldb * 2;
    const unsigned ldsw = (unsigned)wid * 1024u;
    const int aoff = lds_byte(wr * 64 + fr, fq * 8), boff = lds_byte(wc * 32 + fr, fq * 8);
#define PG8_SA(b, h) (((b) * 2 + (h)) * HTB)
#define PG8_SB(b, h) ((4 + (b) * 2 + (h)) * HTB)
#define PG8_STAGE(bufoff, gbase, voff) do { _Pragma("unroll") for (int _i = 0; _i < 2; ++_i) \
        __builtin_amdgcn_global_load_lds((const unsigned*)((const char*)(gbase) + (voff)[_i]), (LAS unsigned*)(lds + (bufoff) + ldsw + _i * 8192), 16, 0, 0); } while (0)
#define PG8_LDA(dst, b, h) do { _Pragma("unroll") for (int m = 0; m < 4; ++m) { \
        if constexpr (FP8) { const i32x4_t lo_ = *(const LAS i32x4_t*)(lds + PG8_SA(b, h) + aoff + m * 2048), hi_ = *(const LAS i32x4_t*)(lds + PG8_SA(b, h) + aoff + m * 2048 + 1024); dst##W[m] = __builtin_shufflevector(lo_, hi_, 0, 1, 2, 3, 4, 5, 6, 7); } \
        else { _Pragma("unroll") for (int k = 0; k < 2; ++k) dst[m][k] = *(const LAS bf16x8*)(lds + PG8_SA(b, h) + aoff + m * 2048 + k * 1024); } } } while (0)
#define PG8_LDB(dst, b, h) do { _Pragma("unroll") for (int n = 0; n < 2; ++n) { \
        if constexpr (FP8) { const i32x4_t lo_ = *(const LAS i32x4_t*)(lds + PG8_SB(b, h) + boff + n * 2048), hi_ = *(const LAS i32x4_t*)(lds + PG8_SB(b, h) + boff + n * 2048 + 1024); dst##W[n] = __builtin_shufflevector(lo_, hi_, 0, 1, 2, 3, 4, 5, 6, 7); } \
        else { _Pragma("unroll") for (int k = 0; k < 2; ++k) dst[n][k] = *(const LAS bf16x8*)(lds + PG8_SB(b, h) + boff + n * 2048 + k * 1024); } } } while (0)
#define PG8_MMA(ai, bj, At, Bt) do { __builtin_amdgcn_s_setprio(1); _Pragma("unroll") for (int m = 0; m < 4; ++m) _Pragma("unroll") for (int n = 0; n < 2; ++n) { \
        if constexpr (FP8) asm("v_mfma_scale_f32_16x16x128_f8f6f4 %0, %1, %2, %0, %3, %3 op_sel_hi:[0,0,0]" : "+v"(acc[ai][bj][m][n]) : "v"(Bt##W[n]), "v"(At##W[m]), "v"(one8)); \
        else { _Pragma("unroll") for (int k = 0; k < 2; ++k) acc[ai][bj][m][n] = __builtin_amdgcn_mfma_f32_16x16x32_bf16(Bt[n][k], At[m][k], acc[ai][bj][m][n], 0, 0, 0); } } __builtin_amdgcn_s_setprio(0); } while (0)
#define PG8_WAIT_V(n) asm volatile("s_waitcnt vmcnt(" #n ")" ::: "memory")
#define PG8_WAIT_L(n) asm volatile("s_waitcnt lgkmcnt(" #n ")" ::: "memory")
#define PG8_BAR __builtin_amdgcn_s_barrier()
#define PG8_SCHED __builtin_amdgcn_sched_barrier(0)
#define PG8_BP(u, t) (((t) < (u).ksplit ? (u).B0 : (u).B1) + (size_t)(t) * kstep)
    Unit cur, nxt; int ui = 0;
    if (!S.next(0, cur)) return;
    f32x4 acc[2][2][4][2];
#pragma unroll
    for (int a = 0; a < 2; ++a)
#pragma unroll
        for (int b = 0; b < 2; ++b)
#pragma unroll
            for (int m = 0; m < 4; ++m)
#pragma unroll
                for (int n = 0; n < 2; ++n) acc[a][b][m][n] = (f32x4){0.f, 0.f, 0.f, 0.f};
    bf16x8 At[4][2], B0[2][2], B1[2][2];
    i32x8_t AtW[4], B0W[2], B1W[2];
    const int one8 = 0x7F7F7F7F;
    unsigned vA[2][2], nvA[2][2];
    S.template aoffs<GATHER>(cur, sR, sC, lda, vA);
    const char* cA = cur.A; const char* cB0 = PG8_BP(cur, 0); const char* cB1 = PG8_BP(cur, 1);
    PG8_STAGE(PG8_SB(0, 0), cB0, voffB); PG8_STAGE(PG8_SB(0, 1), cB0 + hstepB, voffB); PG8_STAGE(PG8_SA(0, 0), cA, vA[0]); PG8_STAGE(PG8_SA(0, 1), cA, vA[1]);
    if (wr == 1) PG8_BAR;
    PG8_WAIT_V(2); PG8_BAR;
    PG8_STAGE(PG8_SB(1, 0), cB1, voffB); PG8_STAGE(PG8_SA(1, 0), cA + kstep, vA[0]); PG8_STAGE(PG8_SB(1, 1), cB1 + hstepB, voffB);
    PG8_WAIT_V(6); PG8_BAR;
    for (;;) {
        const bool has_next = S.next(ui + 1, nxt);
        if (!has_next) nxt = cur;
        if constexpr (GATHER) {
            if (has_next) S.template aoffs<GATHER>(nxt, sR, sC, lda, nvA);
            else {
#pragma unroll
                for (int h = 0; h < 2; ++h)
#pragma unroll
                    for (int i = 0; i < 2; ++i) nvA[h][i] = vA[h][i];
            }
        }
        const char* nA = nxt.A;
#pragma unroll 1
        for (int t = 0; t < nt; t += 2) {
            const bool last = (t == nt - 2);
            const char* a1 = cA + (size_t)(t + 1) * kstep;
            const char* a2 = last ? nA : cA + (size_t)(t + 2) * kstep; const char* a3 = a2 + kstep;
            const char* b2 = last ? PG8_BP(nxt, 0) : PG8_BP(cur, t + 2); const char* b3 = last ? PG8_BP(nxt, 1) : PG8_BP(cur, t + 3);
            unsigned wA[2][2];
#pragma unroll
            for (int h = 0; h < 2; ++h)
#pragma unroll
                for (int i = 0; i < 2; ++i) { if constexpr (GATHER) { const unsigned msk = last ? 0xffffffffu : 0u; wA[h][i] = vA[h][i] ^ ((vA[h][i] ^ nvA[h][i]) & msk); } else wA[h][i] = vA[h][i]; }
            PG8_LDB(B0, 0, 0); PG8_LDB(B1, 0, 1); PG8_SCHED; PG8_LDA(At, 0, 0); PG8_STAGE(PG8_SA(1, 1), a1, vA[1]);
            PG8_WAIT_V(8); PG8_WAIT_L(0); PG8_BAR; PG8_MMA(0, 0, At, B0); PG8_MMA(0, 1, At, B1); PG8_BAR; PG8_SCHED;
            PG8_LDA(At, 0, 1); PG8_STAGE(PG8_SB(0, 0), b2, voffB); PG8_STAGE(PG8_SB(0, 1), b2 + hstepB, voffB); PG8_STAGE(PG8_SA(0, 0), a2, wA[0]);
            PG8_WAIT_V(8); PG8_WAIT_L(0); PG8_BAR; PG8_MMA(1, 0, At, B0); PG8_MMA(1, 1, At, B1); PG8_BAR; PG8_SCHED;
            PG8_LDB(B0, 1, 0); PG8_LDB(B1, 1, 1); PG8_SCHED; PG8_LDA(At, 1, 0); PG8_STAGE(PG8_SA(0, 1), a2, wA[1]);
            PG8_WAIT_V(8); PG8_WAIT_L(0); PG8_BAR; PG8_MMA(0, 0, At, B0); PG8_MMA(0, 1, At, B1); PG8_BAR; PG8_SCHED;
            PG8_LDA(At, 1, 1); PG8_STAGE(PG8_SB(1, 0), b3, voffB); PG8_STAGE(PG8_SB(1, 1), b3 + hstepB, voffB); PG8_STAGE(PG8_SA(1, 0), a3, wA[0]);
            PG8_WAIT_V(8); PG8_WAIT_L(0); PG8_BAR; PG8_MMA(1, 0, At, B0); PG8_MMA(1, 1, At, B1); PG8_BAR; PG8_SCHED;
        }
        if constexpr (ALIGN_EPI) { if (wr == 0) PG8_BAR; }
        if constexpr (FP8) asm volatile("s_nop 15\n\ts_nop 15" ::: "memory");
        E(acc, cur, wr, wc, fr, fq);
        if (!has_next) break;
#pragma unroll
        for (int a = 0; a < 2; ++a)
#pragma unroll
            for (int b = 0; b < 2; ++b)
#pragma unroll
                for (int m = 0; m < 4; ++m)
#pragma unroll
                    for (int n = 0; n < 2; ++n) acc[a][b][m][n] = (f32x4){0.f, 0.f, 0.f, 0.f};
        cur = nxt; cA = nA; ++ui;
        if constexpr (GATHER) {
#pragma unroll
            for (int h = 0; h < 2; ++h)
#pragma unroll
                for (int i = 0; i < 2; ++i) vA[h][i] = nvA[h][i];
        }
        if constexpr (ALIGN_EPI) { if (wr == 1) PG8_BAR; }
    }
    PG8_WAIT_V(0);
    if constexpr (!ALIGN_EPI) { if (wr == 0) PG8_BAR; }
    PG8_BAR;
#undef PG8_SA
#undef PG8_SB
#undef PG8_STAGE
#undef PG8_LDA
#undef PG8_LDB
#undef PG8_MMA
#undef PG8_WAIT_V
#undef PG8_WAIT_L
#undef PG8_BAR
#undef PG8_SCHED
#undef PG8_BP
}
}

struct MArgs {
    const float* in[18]; float* out; unsigned char* ws; int ph_lo, ph_hi, var, pad_;
};

__device__ __forceinline__ void p0_transpose_item(const float* W, int N, int k0, int n0, bf16_t* WT, int dst_row0, int ldk, LAS float* scr, int lane, const float* kscale = nullptr, float fp8scale = 0.f) {
    { const int kr = lane >> 3, g = lane & 7;
      const float* src = W + (size_t)(k0 + kr) * N + n0 + 4 * g;
      f32x4 v[8];
#pragma unroll
      for (int i = 0; i < 8; ++i) v[i] = *(const f32x4*)(src + (size_t)(8 * i) * N);
#pragma unroll
      for (int i = 0; i < 8; ++i) { const int kk = kr + 8 * i; *(LAS f32x4*)(scr + kk * 36 + ((g ^ i) << 2)) = v[i]; } }
    const int c = lane & 7;
    float ks[8];
    if (kscale) { const f32x4 s0 = *(const f32x4*)(kscale + k0 + 8 * c), s1 = *(const f32x4*)(kscale + k0 + 8 * c + 4); ks[0] = s0[0]; ks[1] = s0[1]; ks[2] = s0[2]; ks[3] = s0[3]; ks[4] = s1[0]; ks[5] = s1[1]; ks[6] = s1[2]; ks[7] = s1[3]; }
    else {
#pragma unroll
        for (int j = 0; j < 8; ++j) ks[j] = 1.f; }
    asm volatile("s_waitcnt lgkmcnt(0)" ::: "memory");
#pragma unroll
    for (int j = 0; j < 4; ++j) { const int n = (lane >> 3) + 8 * j; const LAS float* sp = scr + (8 * c) * 36 + ((((n >> 2) ^ c) << 2) | (n & 3));
        if (fp8scale != 0.f) {
            u32x2 o; o.x = pk4_fp8(sp[0 * 36] * ks[0] * fp8scale, sp[1 * 36] * ks[1] * fp8scale, sp[2 * 36] * ks[2] * fp8scale, sp[3 * 36] * ks[3] * fp8scale);
            o.y = pk4_fp8(sp[4 * 36] * ks[4] * fp8scale, sp[5 * 36] * ks[5] * fp8scale, sp[6 * 36] * ks[6] * fp8scale, sp[7 * 36] * ks[7] * fp8scale);
            *(u32x2*)((unsigned char*)WT + (size_t)(dst_row0 + n) * ldk + k0 + 8 * c) = o;
        } else {
        u32x4 o; o.x = pk2(sp[0 * 36] * ks[0], sp[1 * 36] * ks[1]); o.y = pk2(sp[2 * 36] * ks[2], sp[3 * 36] * ks[3]); o.z = pk2(sp[4 * 36] * ks[4], sp[5 * 36] * ks[5]); o.w = pk2(sp[6 * 36] * ks[6], sp[7 * 36] * ks[7]);
        *(u32x4*)(WT + (size_t)(dst_row0 + n) * ldk + k0 + 8 * c) = o; } }
    asm volatile("s_waitcnt lgkmcnt(0)" ::: "memory");
}
__device__ __forceinline__ int inproj_pos(int n) { const int l = n & 255; return (n & ~255) + 128 * ((l >> 5) & 1) + 32 * (l >> 6) + (l & 31); }

__device__ __forceinline__ void phase0(const MArgs& a, LAS unsigned char* lds, int vcu, int G) {
    const int tid = threadIdx.x, lane = tid & 63, wave = __builtin_amdgcn_readfirstlane(tid >> 6);
    unsigned char* ws = a.ws;
    LAS float* scr = (LAS float*)(lds + wave * 16384);
    const int gw = vcu * NWAVES + wave, NGW = G * NWAVES;
    constexpr int I_IN = 16 * 128, I_MK = 16 * 16, I_O = 16 * 32, I_W1 = 32 * 16 * 16, I_W2 = 32 * 8 * 32;
    constexpr int NITEMS = I_IN + I_MK + I_O + 2 * I_W1 + I_W2;
    bf16_t* WinT = (bf16_t*)(ws + WS_WINT); bf16_t* WoT = (bf16_t*)(ws + WS_WOT); bf16_t* W13T = (bf16_t*)(ws + WS_W13T); bf16_t* W2T = (bf16_t*)(ws + WS_W2T);
    for (int it = gw; it < NITEMS; it += NGW) {
        int r = it;
        if (r < I_IN) { const int kb = r / 128, nb = r % 128; p0_transpose_item(a.in[3], IN_COLS, kb * 64, nb * 32, WinT, inproj_pos(nb * 32), DM, scr, lane, a.in[2]); continue; } r -= I_IN;
        if (r < I_MK) { const int kb = r / 16, nb = r % 16; p0_transpose_item(a.in[8], 512, kb * 64, nb * 32, WinT, 4096 + inproj_pos(nb * 32), DM, scr, lane); continue; } r -= I_MK;
        if (r < I_O) { const int kb = r / 32, nb = r % 32; p0_transpose_item(a.in[9], DM, kb * 64, nb * 32, WoT, nb * 32, DM, scr, lane); continue; } r -= I_O;
        if (r < 2 * I_W1) { const int which = r / I_W1; r %= I_W1; const int e = r / 256, kb = (r % 256) / 16, nb = r % 16; const int n0 = nb * 32;
            p0_transpose_item(a.in[15 + which] + (size_t)e * DM * DEXP, DEXP, kb * 64, n0, W13T, e * 1024 + 256 * (n0 >> 7) + 128 * which + (n0 & 127), DM, scr, lane, a.in[10], SC_W13); continue; } r -= 2 * I_W1;
        { const int e = r / 256, kb = (r % 256) / 32, nb = r % 32; p0_transpose_item(a.in[17] + (size_t)e * DEXP * DM, DM, kb * 64, nb * 32, W2T, e * 1024 + nb * 32, DEXP, scr, lane, nullptr, SC_W2); }
    }
    bf16_t* XN = (bf16_t*)(ws + WS_XN); float* rstdx = (float*)(ws + WS_RSTDX);
    for (int r = gw; r < MROWS; r += NGW) {
        const bool isx = r < NTOK;
        const float* src = isx ? a.in[0] + (size_t)r * DM : a.in[1] + (size_t)(r - NTOK) * DM;
        const float4* xr = (const float4*)src;
        float4 v[4]; float s = 0.f;
#pragma unroll
        for (int j = 0; j < 4; ++j) { v[j] = xr[lane + 64 * j]; s += v[j].x * v[j].x + v[j].y * v[j].y + v[j].z * v[j].z + v[j].w * v[j].w; }
        s = wave_sum(s);
        const float rstd = rsqrtf(s * (1.f / DM) + EPS);
        if (isx) { if (lane == 0) rstdx[r] = rstd; }
        const float sc = isx ? 1.f : rstd;
#pragma unroll
        for (int j = 0; j < 4; ++j) {
            float4 gg = (float4){1.f, 1.f, 1.f, 1.f}; if (!isx) gg = ((const float4*)a.in[7])[lane + 64 * j];
            u32x2 o; o.x = pk2(v[j].x * sc * gg.x, v[j].y * sc * gg.y); o.y = pk2(v[j].z * sc * gg.z, v[j].w * sc * gg.w);
            ((u32x2*)(XN + (size_t)r * DM))[lane + 64 * j] = o;
        }
    }
    { bf16_t* WfH = (bf16_t*)(ws + WS_WRF); bf16_t* WfL = WfH + 32 * 3 * 64 * 8; float* b48 = (float*)(ws + WS_WRF + 2 * 32 * 3 * 64 * 8 * 2);
      for (int t = vcu * NTHREADS + tid; t < 32 * 3 * 64 * 8 + 48; t += G * NTHREADS) {
          if (t < 32 * 3 * 64 * 8) { const int j = t & 7, ln = (t >> 3) & 63, sc = t >> 9, ct = sc % 3, st = sc / 3; const int k = 32 * st + 8 * (ln >> 4) + j, col = 16 * ct + (ln & 15);
              const float w = (col < 4 ? a.in[11][k * 4 + col] : (col < 36 ? a.in[13][k * 32 + col - 4] : 0.f)) * a.in[10][k];
              const bf16_t hi = f2bf(w); WfH[t] = hi; WfL[t] = f2bf(w - bf2f(hi)); }
          else { const int col = t - 32 * 3 * 64 * 8; b48[col] = col < 4 ? a.in[12][col] : (col < 36 ? a.in[14][col - 4] : 0.f); }
      } }
    float* biasD = (float*)(ws + WS_BIASD); float* rpb = (float*)(ws + WS_RPB);
    for (int t = vcu * NTHREADS + tid; t < 8 * 15 * 31; t += G * NTHREADS) {
        if (t < 3 * 4 * 129) { const int j = t % 129, hh = (t / 129) % 4, g = t / (129 * 4); const int dil = g == 0 ? 1 : (g == 1 ? 4 : 16);
            biasD[t] = a.in[6][t5_bucket((j - 64) * dil) * 12 + g * 4 + hh] * LOG2E; }
        rpb[t] = a.in[5][t] * LOG2E;
    }
}

struct SchedInProj {
    const char* A; const char* B; int G, c;
    __device__ __forceinline__ bool next(int i, pg8::Unit& u) const {
        const int L = i * G + c; constexpr int NW = 256 * 16;
        int pm, pn;
        if (L < NW) { const int wgid = pg8::xcd_remap(L, NW); const int nig = pg8::WGM * 16, gid = wgid / nig, fm = gid * pg8::WGM; pm = fm + ((wgid % nig) % pg8::WGM); pn = (wgid % nig) / pg8::WGM; }
        else return false;
        u.A = A + (size_t)pm * 256 * DM * 2; u.B0 = B + (size_t)pn * 256 * DM * 2; u.B1 = u.B0; u.ksplit = 1 << 30; u.e0 = pm; u.e1 = pn; u.e2 = 0; u.e3 = 0;
        return true;
    }
    template <bool GATHER> __device__ __forceinline__ void aoffs(const pg8::Unit&, const int (&sR)[2], const int (&sC)[2], int lda, unsigned (&v)[2][2]) const {
#pragma unroll
        for (int h = 0; h < 2; ++h)
#pragma unroll
            for (int i = 0; i < 2; ++i) v[h][i] = (unsigned)((sR[i] + 128 * h) * lda + sC[i]) * 2u;
    }
};
struct EpiInProj {
    static constexpr bool PERM = true;
    bf16_t* QKV; bf16_t* KVM; const float* gain; const float* rstdx;
    __device__ __forceinline__ void operator()(const f32x4 (&acc)[2][2][4][2], const pg8::Unit& u, int wr, int wc, int fr, int fq) const {
        const int pm = u.e0, pn = u.e1;
        int gi = -1; float sc = 1.f; bf16_t* base; int hplane, nrows, rowt;
        if (pn < 16) { base = QKV; hplane = 4 * pn; nrows = NTOK; rowt = pm * 256;
            if (pn < 2) { gi = 0; sc = QSCALE; } else if (pn < 4) gi = 1; else if (pn < 6) gi = -1; else if (pn < 9) { gi = 2; sc = QSCALE; } else if (pn < 12) gi = 3; else if (pn < 15) gi = -1; else { gi = 4; sc = QSCALE; } }
        else { base = KVM; hplane = 4 * (pn - 16); nrows = BATCH * MEM_LEN; rowt = (pm - 256) * 256; gi = pn == 16 ? 5 : -1; }
        float gv[2][2][4];
#pragma unroll
        for (int bj = 0; bj < 2; ++bj)
#pragma unroll
            for (int n = 0; n < 2; ++n)
#pragma unroll
                for (int j = 0; j < 4; ++j) gv[bj][n][j] = gi >= 0 ? gain[gi * 64 + 32 * bj + 8 * fq + 4 * n + j] * sc : 1.f;
#pragma unroll
        for (int ai = 0; ai < 2; ++ai)
#pragma unroll
            for (int m = 0; m < 4; ++m) {
                const float rx = pn < 16 ? rstdx[rowt + ai * 128 + wr * 64 + m * 16 + fr] : 1.f;
                float ss = 0.f;
#pragma unroll
                for (int bj = 0; bj < 2; ++bj)
#pragma unroll
                    for (int n = 0; n < 2; ++n) { const f32x4 x = acc[ai][bj][m][n]; ss += (x[0] * x[0] + x[1] * x[1]) + (x[2] * x[2] + x[3] * x[3]); }
                ss += __shfl_xor(ss, 16); ss += __shfl_xor(ss, 32);
                const float r = (gi >= 0 ? rsqrtf(ss * (rx * rx) * (1.f / 64.f) + EPS) : 1.f) * rx;
                bf16_t* rowp = base + ((size_t)(hplane + wc) * nrows + (rowt + ai * 128 + wr * 64 + m * 16 + fr)) * 64 + 8 * fq;
#pragma unroll
                for (int bj = 0; bj < 2; ++bj) {
                    const f32x4 v0 = acc[ai][bj][m][0], v1 = acc[ai][bj][m][1];
                    u32x4 w;
                    w.x = cvt_pk_bf16(v0[0] * r * gv[bj][0][0], v0[1] * r * gv[bj][0][1]); w.y = cvt_pk_bf16(v0[2] * r * gv[bj][0][2], v0[3] * r * gv[bj][0][3]);
                    w.z = cvt_pk_bf16(v1[0] * r * gv[bj][1][0], v1[1] * r * gv[bj][1][1]); w.w = cvt_pk_bf16(v1[2] * r * gv[bj][1][2], v1[3] * r * gv[bj][1][3]);
                    *(u32x4*)(rowp + 32 * bj) = w;
                }
            }
    }
};


struct SchedOutProj {
    const char* A; const char* B; int G, c;
    __device__ __forceinline__ bool next(int i, pg8::Unit& u) const {
        const int L = i * G + c; constexpr int NW = 256 * 4;
        if (L >= NW) return false;
        const int wgid = pg8::xcd_remap(L, NW); const int nig = pg8::WGM * 4, gid = wgid / nig, fm = gid * pg8::WGM; const int pm = fm + ((wgid % nig) % pg8::WGM), pn = (wgid % nig) / pg8::WGM;
        u.A = A + (size_t)pm * 256 * DM * 2; u.B0 = B + (size_t)pn * 256 * DM * 2; u.B1 = u.B0; u.ksplit = 1 << 30; u.e0 = pm; u.e1 = pn; u.e2 = 0; u.e3 = 0;
        return true;
    }
    template <bool GATHER> __device__ __forceinline__ void aoffs(const pg8::Unit&, const int (&sR)[2], const int (&sC)[2], int lda, unsigned (&v)[2][2]) const {
#pragma unroll
        for (int h = 0; h < 2; ++h)
#pragma unroll
            for (int i = 0; i < 2; ++i) v[h][i] = (unsigned)((sR[i] + 128 * h) * lda + sC[i]) * 2u;
    }
};
struct EpiOutProj {
    static constexpr bool PERM = true;
    const bf16_t* X; bf16_t* O; unsigned char* Q8;
    __device__ __forceinline__ void operator()(const f32x4 (&acc)[2][2][4][2], const pg8::Unit& u, int wr, int wc, int fr, int fq) const {
        const int row0 = u.e0 * 256 + wr * 64 + fr, col0 = u.e1 * 256 + wc * 32 + 8 * fq;
        u32x4 xv[2][4][2];
#pragma unroll
        for (int ai = 0; ai < 2; ++ai)
#pragma unroll
            for (int m = 0; m < 4; ++m) { const size_t off = (size_t)(row0 + ai * 128 + m * 16) * DM + col0;
#pragma unroll
                for (int bj = 0; bj < 2; ++bj) xv[ai][m][bj] = *(const u32x4*)(X + off + bj * 128); }
#pragma unroll
        for (int ai = 0; ai < 2; ++ai)
#pragma unroll
            for (int m = 0; m < 4; ++m) { const size_t off = (size_t)(row0 + ai * 128 + m * 16) * DM + col0;
#pragma unroll
                for (int bj = 0; bj < 2; ++bj) { const u32x4 w0 = xv[ai][m][bj];
                    const f32x4 x0 = (f32x4){__uint_as_float(w0.x << 16), __uint_as_float(w0.x & 0xffff0000u), __uint_as_float(w0.y << 16), __uint_as_float(w0.y & 0xffff0000u)};
                    const f32x4 x1v = (f32x4){__uint_as_float(w0.z << 16), __uint_as_float(w0.z & 0xffff0000u), __uint_as_float(w0.w << 16), __uint_as_float(w0.w & 0xffff0000u)};
                    const f32x4 v0 = x0 + acc[ai][bj][m][0], v1 = x1v + acc[ai][bj][m][1];
                    u32x4 w; w.x = cvt_pk_bf16(v0[0], v0[1]); w.y = cvt_pk_bf16(v0[2], v0[3]); w.z = cvt_pk_bf16(v1[0], v1[1]); w.w = cvt_pk_bf16(v1[2], v1[3]);
                    *(u32x4*)(O + off + bj * 128) = w;
                    u32x2 q; q.x = pk4_fp8(v0[0] * SC_X1, v0[1] * SC_X1, v0[2] * SC_X1, v0[3] * SC_X1); q.y = pk4_fp8(v1[0] * SC_X1, v1[1] * SC_X1, v1[2] * SC_X1, v1[3] * SC_X1);
                    *(u32x2*)(Q8 + off + bj * 128) = q; } }
    }
};

constexpr int TT_OFF = RING_BYTES;
constexpr int TT_PBASE = 1 + 2 * MAXTILES, TT_E = TT_PBASE + NPAIR;
static_assert((TT_E + 1 + 2 * MAXETILES) * 4 <= 16384, "tile tables fit the spare LDS");
__device__ __forceinline__ int moe_build_tiles(LAS unsigned char* lds, const unsigned* count, const unsigned* ecount) {
    LAS int* tt = (LAS int*)(lds + TT_OFF);
    __syncthreads();
    if (threadIdx.x == 0) {
        int nt = 0;
        for (int L = 0; L < NPAIR; ++L) { tt[TT_PBASE + L] = nt; const int c = (int)__hip_atomic_load(count + L, __ATOMIC_RELAXED, __HIP_MEMORY_SCOPE_AGENT); for (int r = 0; r < c; r += 256) { tt[1 + nt] = L; tt[1 + MAXTILES + nt] = r; ++nt; } }
        tt[0] = nt;
    }
    if (threadIdx.x == 64) {
        int ne = 0;
        for (int e = 0; e < NEXP; ++e) { const int c = (int)__hip_atomic_load(ecount + e, __ATOMIC_RELAXED, __HIP_MEMORY_SCOPE_AGENT); for (int r = 0; r < c; r += 256) { tt[TT_E + 1 + ne] = e; tt[TT_E + 1 + MAXETILES + ne] = r; ++ne; } }
        tt[TT_E] = ne;
    }
    __syncthreads();
    return tt[0];
}
struct SchedMoe1 {
    const char* Hb; const char* W13T; const int* elists; const unsigned* ecount; const LAS int* tt; int netiles, G, c;
    __device__ __forceinline__ bool next(int i, pg8::Unit& u) const {
        const int L = i * G + c, nwg = netiles * 4;
        if (L >= nwg) return false;
        const int U = pg8::xcd_remap(L, nwg), T = U >> 2, pn = U & 3;
        const int e = tt[TT_E + 1 + T], row0 = tt[TT_E + 1 + MAXETILES + T];
        u.A = Hb; u.B0 = W13T + ((size_t)e * 1024 + pn * 256) * DM; u.B1 = u.B0; u.ksplit = 1 << 30; u.e0 = T; u.e1 = pn; u.e2 = e; u.e3 = row0;
        return true;
    }
    template <bool GATHER> __device__ __forceinline__ void aoffs(const pg8::Unit& u, const int (&sR)[2], const int (&sC)[2], int lda, unsigned (&v)[2][2]) const {
        const int cnt = (int)ecount[u.e2]; const int* lp = elists + (size_t)u.e2 * NTOK;
#pragma unroll
        for (int h = 0; h < 2; ++h)
#pragma unroll
            for (int i = 0; i < 2; ++i) { int p = u.e3 + 128 * h + sR[i]; p = p < cnt ? p : cnt - 1; const int tok = lp[p] >> 1; v[h][i] = (unsigned)(tok * lda + sC[i]) * 2u; }
    }
};
struct EpiMoe1 {
    static constexpr bool PERM = true;
    bf16_t* ACT; const int* elists; const unsigned* ecount; const float* tokg; const float* trstd; const int* tokP; const LAS int* tt;
    __device__ __forceinline__ void operator()(const f32x4 (&acc)[2][2][4][2], const pg8::Unit& u, int wr, int wc, int fr, int fq) const {
        const int pn = u.e1, e = u.e2, row0 = u.e3;
        const int cnt = (int)ecount[e]; const int* lp = elists + (size_t)e * NTOK;
#pragma unroll
        for (int ai = 0; ai < 2; ++ai)
#pragma unroll
            for (int m = 0; m < 4; ++m) {
                const int p = row0 + ai * 128 + wr * 64 + m * 16 + fr;
                if (p < cnt) {
                    const int ent = lp[p], tok = ent >> 1, role = ent & 1;
                    const float g = tokg[tok * 2 + role] * SC_ACT; const float rs = trstd[tok] * (1.f / (SC_X1 * SC_W13)); const int tp = tokP[tok];
                    const int drow = tt[TT_PBASE + (tp >> 16)] * 256 + (tp & 0xffff);
                    const f32x4 a0 = acc[ai][0][m][0], a1 = acc[ai][0][m][1], b0 = acc[ai][1][m][0], b1 = acc[ai][1][m][1];
                    float o[8];
#pragma unroll
                    for (int j = 0; j < 4; ++j) { const float x0 = a0[j] * rs, x1v = a1[j] * rs; o[j] = x0 / (1.f + __expf(-x0)) * (b0[j] * rs) * g; o[4 + j] = x1v / (1.f + __expf(-x1v)) * (b1[j] * rs) * g; }
#pragma unroll
                    for (int j = 0; j < 8; ++j) o[j] = __builtin_fminf(__builtin_fmaxf(o[j], -448.f), 448.f);
                    u32x2 w; w.x = pk4_fp8(o[0], o[1], o[2], o[3]); w.y = pk4_fp8(o[4], o[5], o[6], o[7]);
                    *(u32x2*)((unsigned char*)ACT + (size_t)drow * DM + 512 * role + 128 * pn + 32 * wc + 8 * fq) = w;
                }
            }
    }
};
struct SchedMoe2 {
    const char* ACTb; const char* W2T; const LAS int* tt; int ntiles, G, c;
    __device__ __forceinline__ bool next(int i, pg8::Unit& u) const {
        const int L = i * G + c, nwg = ntiles * 4;
        if (L >= nwg) return false;
        const int U = pg8::xcd_remap(L, nwg), T = U >> 2, pn = U & 3;
        const int list = tt[1 + T], row0 = tt[1 + MAXTILES + T];
        int ea, eb; pair_experts(list, ea, eb);
        u.A = ACTb + (size_t)T * 256 * DM; u.B0 = W2T + ((size_t)ea * 1024 + pn * 256) * DEXP; u.B1 = W2T + ((size_t)eb * 1024 + pn * 256) * DEXP - 4 * 128; u.ksplit = 4;
        u.e0 = T; u.e1 = pn; u.e2 = list; u.e3 = row0;
        return true;
    }
    template <bool GATHER> __device__ __forceinline__ void aoffs(const pg8::Unit&, const int (&sR)[2], const int (&sC)[2], int lda, unsigned (&v)[2][2]) const {
#pragma unroll
        for (int h = 0; h < 2; ++h)
#pragma unroll
            for (int i = 0; i < 2; ++i) v[h][i] = (unsigned)((sR[i] + 128 * h) * lda + sC[i]) * 2u;
    }
};
struct EpiMoe2 {
    static constexpr bool PERM = true;
    float* O; const bf16_t* X1; const int* lists; const unsigned* count; float scale; int var;
    __device__ __forceinline__ void operator()(const f32x4 (&acc)[2][2][4][2], const pg8::Unit& u, int wr, int wc, int fr, int fq) const {
        if (!MK_ONE_LAUNCH && var == 1) return;
        const int pn = u.e1, list = u.e2, row0 = u.e3;
        const int cnt = (int)count[list]; const int* lp = lists + (size_t)list * NTOK;
        const int col0 = pn * 256 + wc * 32 + 8 * fq;
        int tok[2][4];
#pragma unroll
        for (int ai = 0; ai < 2; ++ai)
#pragma unroll
            for (int m = 0; m < 4; ++m) { const int p = row0 + ai * 128 + wr * 64 + m * 16 + fr; tok[ai][m] = p < cnt ? lp[p] : -1; }
#pragma unroll
        for (int ai = 0; ai < 2; ++ai) {
            u32x4 xv[4][2];
#pragma unroll
            for (int m = 0; m < 4; ++m) { const bf16_t* rowp = X1 + (size_t)(tok[ai][m] < 0 ? 0 : tok[ai][m]) * DM + col0;
#pragma unroll
                for (int bj = 0; bj < 2; ++bj) xv[m][bj] = (!MK_ONE_LAUNCH && var == 3) ? (u32x4){0u, 0u, 0u, 0u} : *(const u32x4*)(rowp + bj * 128); }
            if (!MK_ONE_LAUNCH && var == 2) { unsigned t = 0;
#pragma unroll
                for (int m = 0; m < 4; ++m) t |= xv[m][0].x ^ xv[m][1].y ^ xv[m][0].z ^ xv[m][1].w;
                if (t == 0x12345678u) O[0] = 0.f; continue; }
#pragma unroll
            for (int m = 0; m < 4; ++m) if (tok[ai][m] >= 0) { float* rowp = O + (size_t)tok[ai][m] * DM + col0;
#pragma unroll
                for (int bj = 0; bj < 2; ++bj) { const u32x4 w = xv[m][bj];
                    const f32x4 x0 = (f32x4){__uint_as_float(w.x << 16), __uint_as_float(w.x & 0xffff0000u), __uint_as_float(w.y << 16), __uint_as_float(w.y & 0xffff0000u)};
                    const f32x4 x1v = (f32x4){__uint_as_float(w.z << 16), __uint_as_float(w.z & 0xffff0000u), __uint_as_float(w.w << 16), __uint_as_float(w.w & 0xffff0000u)};
                    *(f32x4*)(rowp + bj * 128) = x0 + acc[ai][bj][m][0] * scale; *(f32x4*)(rowp + bj * 128 + 4) = x1v + acc[ai][bj][m][1] * scale; } }
            asm volatile("" ::: "memory");
        }
    }
};


namespace att {
typedef short v4i16_t __attribute__((ext_vector_type(4)));
typedef short s16x4 __attribute__((ext_vector_type(4)));
typedef float f32x2_t __attribute__((ext_vector_type(2)));
typedef __bf16 bf16x2_t __attribute__((ext_vector_type(2)));
__device__ __forceinline__ unsigned cvtpk(float lo, float hi) { f32x2_t v = {lo, hi}; bf16x2_t b = __builtin_convertvector(v, bf16x2_t); return __builtin_bit_cast(unsigned, b); }
__device__ __forceinline__ s16x4 vtr(const LAS unsigned char* p) { return __builtin_bit_cast(s16x4, __builtin_amdgcn_ds_read_tr16_b64_v4i16((LAS v4i16_t*)p)); }
__device__ __forceinline__ constexpr int crow0(int r) { return (r & 3) + 8 * (r >> 2); }
constexpr float NEG_INF = -__builtin_huge_valf();

constexpr int L_V = 0;
constexpr int L_SO = 65536, SO_PITCH = 136;
constexpr int L_SM = L_SO + 512 * SO_PITCH;
constexpr int L_SL = L_SM + 2048;
constexpr int L_BIAS = L_SL + 2048;
constexpr int L_NATAB = L_SO;
static_assert(L_BIAS + 4096 <= LDS_BYTES - 256 && 8 * 576 * 4 <= 512 * SO_PITCH, "attention LDS map");

struct Ctx {
    int lane, q, h;
    LAS unsigned char* vl;
    unsigned vw, vr0, vr1;
    unsigned kw, kr;
};
__device__ __forceinline__ Ctx make_ctx(LAS unsigned char* lds, int wave, int lane) {
    Ctx c; c.lane = lane; c.q = lane & 31; c.h = lane >> 5; c.vl = lds + L_V + wave * 8192;
    { const int key = lane >> 3, ch = lane & 7, swz = ((key >> 1) & 1) << 2; c.vw = (unsigned)(key * 128 + ((ch ^ swz) << 4)); }
    { const int qp = (lane & 15) >> 2, p = lane & 3, sub = (lane >> 4) & 1, swz = ((qp >> 1) & 1) << 2, x = 2 * sub + (p >> 1);
      c.vr0 = (unsigned)((4 * c.h + qp) * 128 + (((0 ^ swz) + x) << 4) + (p & 1) * 8);
      c.vr1 = (unsigned)((4 * c.h + qp) * 128 + (((4 ^ swz) + x) << 4) + (p & 1) * 8); }
    c.kw = (unsigned)((lane >> 3) * 128);
    c.kr = (unsigned)((lane & 31) * 128);
    return c;
}

template <class Spec>
__device__ __forceinline__ void tile_core(const Spec& sp, const Ctx& c, int t, const LAS unsigned char* vt, const LAS unsigned char* kt, const bf16x8 (&qf)[4], float& m, float& l, f32x16& o0, f32x16& o1);
template <bool LOAD, class Spec>
__device__ __forceinline__ void tile_step(const Spec& sp, const Ctx& c, int t, int tnext, u32x4 (&kreg)[4], u32x4 (&vreg)[4], const bf16x8 (&qf)[4], float& m, float& l, f32x16& o0, f32x16& o1) {
    const int key_lo = c.lane >> 3, chn = c.lane & 7;
#pragma unroll
    for (int i = 0; i < 4; ++i) {
        *(LAS u32x4*)(c.vl + c.vw + i * 1024) = vreg[i];
        const int ksw = ((key_lo >> 1) + 4 * i) & 7;
        *(LAS u32x4*)(c.vl + 4096 + c.kw + i * 1024 + ((chn ^ ksw) << 4)) = kreg[i];
    }
    if constexpr (LOAD) { sp.loadKV(tnext, kreg, vreg); __builtin_amdgcn_sched_barrier(0); }
    tile_core(sp, c, t, c.vl, c.vl + 4096, qf, m, l, o0, o1);
}
template <class Spec>
__device__ __forceinline__ void tile_core(const Spec& sp, const Ctx& c, int t, const LAS unsigned char* vt, const LAS unsigned char* kt, const bf16x8 (&qf)[4], float& m, float& l, f32x16& o0, f32x16& o1) {
    bf16x8 kf[4];
    { const int ksw = ((c.lane & 31) >> 1) & 7;
#pragma unroll
      for (int ks = 0; ks < 4; ++ks) kf[ks] = *(const LAS bf16x8*)(kt + c.kr + (((2 * ks + c.h) ^ ksw) << 4)); }
    f32x16 s;
#pragma unroll
    for (int r = 0; r < 16; ++r) s[r] = 0.f;
#pragma unroll
    for (int ks = 0; ks < 4; ++ks) s = __builtin_amdgcn_mfma_f32_32x32x16_bf16(kf[ks], qf[ks], s, 0, 0, 0);
    sp.bias(t, s);
    float mx = s[0];
#pragma unroll
    for (int r = 1; r < 16; ++r) mx = fmaxf(mx, s[r]);
    { auto rr = __builtin_amdgcn_permlane32_swap(__float_as_uint(mx), __float_as_uint(mx), false, false); mx = fmaxf(__uint_as_float(rr[0]), __uint_as_float(rr[1])); }
    const float mn = fmaxf(m, mx);
    if (__any(mn > m)) {
        const float al = __builtin_amdgcn_exp2f(m - mn);
        l *= al;
#pragma unroll
        for (int r = 0; r < 16; ++r) { o0[r] *= al; o1[r] *= al; }
        m = mn;
    }
    float ps = 0.f;
#pragma unroll
    for (int r = 0; r < 16; ++r) { s[r] = __builtin_amdgcn_exp2f(s[r] - m); ps += s[r]; }
    l += ps;
    bf16x8 pf[2];
#pragma unroll
    for (int s2 = 0; s2 < 2; ++s2) { u32x4 w; w.x = cvtpk(s[8 * s2 + 0], s[8 * s2 + 1]); w.y = cvtpk(s[8 * s2 + 2], s[8 * s2 + 3]); w.z = cvtpk(s[8 * s2 + 4], s[8 * s2 + 5]); w.w = cvtpk(s[8 * s2 + 6], s[8 * s2 + 7]); pf[s2] = __builtin_bit_cast(bf16x8, w); }
#pragma unroll
    for (int s2 = 0; s2 < 2; ++s2) {
        const s16x4 a0 = vtr(vt + c.vr0 + s2 * 2048), a1 = vtr(vt + c.vr0 + s2 * 2048 + 1024);
        const s16x4 b0 = vtr(vt + c.vr1 + s2 * 2048), b1 = vtr(vt + c.vr1 + s2 * 2048 + 1024);
        const bf16x8 v0 = (bf16x8){a0[0], a0[1], a0[2], a0[3], a1[0], a1[1], a1[2], a1[3]};
        const bf16x8 v1 = (bf16x8){b0[0], b0[1], b0[2], b0[3], b1[0], b1[1], b1[2], b1[3]};
        o0 = __builtin_amdgcn_mfma_f32_32x32x16_bf16(v0, pf[s2], o0, 0, 0, 0);
        o1 = __builtin_amdgcn_mfma_f32_32x32x16_bf16(v1, pf[s2], o1, 0, 0, 0);
    }
}

struct QState { float m, l; f32x16 o0, o1; };
__device__ __forceinline__ void softmax_tile(f32x16& s, QState& st, bf16x8 (&pf)[2]) {
    float mx = s[0];
#pragma unroll
    for (int r = 1; r < 16; ++r) mx = fmaxf(mx, s[r]);
    { auto rr = __builtin_amdgcn_permlane32_swap(__float_as_uint(mx), __float_as_uint(mx), false, false); mx = fmaxf(__uint_as_float(rr[0]), __uint_as_float(rr[1])); }
    const float mn = fmaxf(st.m, mx);
    if (__any(mn > st.m)) {
        const float al = __builtin_amdgcn_exp2f(st.m - mn);
        st.l *= al;
#pragma unroll
        for (int r = 0; r < 16; ++r) { st.o0[r] *= al; st.o1[r] *= al; }
        st.m = mn;
    }
    float ps = 0.f;
#pragma unroll
    for (int r = 0; r < 16; ++r) { s[r] = __builtin_amdgcn_exp2f(s[r] - st.m); ps += s[r]; }
    st.l += ps;
#pragma unroll
    for (int s2 = 0; s2 < 2; ++s2) { u32x4 w; w.x = cvtpk(s[8 * s2 + 0], s[8 * s2 + 1]); w.y = cvtpk(s[8 * s2 + 2], s[8 * s2 + 3]); w.z = cvtpk(s[8 * s2 + 4], s[8 * s2 + 5]); w.w = cvtpk(s[8 * s2 + 6], s[8 * s2 + 7]); pf[s2] = __builtin_bit_cast(bf16x8, w); }
}
__device__ __forceinline__ void tile_core2(const Ctx& c, const LAS unsigned char* vt, const LAS unsigned char* kt, const bf16x8 (&qa)[4], const bf16x8 (&qb)[4], QState& A, QState& B) {
    bf16x8 kf[4];
    { const int ksw = ((c.lane & 31) >> 1) & 7;
#pragma unroll
      for (int ks = 0; ks < 4; ++ks) kf[ks] = *(const LAS bf16x8*)(kt + c.kr + (((2 * ks + c.h) ^ ksw) << 4)); }
    f32x16 sa, sb;
#pragma unroll
    for (int r = 0; r < 16; ++r) { sa[r] = 0.f; sb[r] = 0.f; }
#pragma unroll
    for (int ks = 0; ks < 4; ++ks) { sa = __builtin_amdgcn_mfma_f32_32x32x16_bf16(kf[ks], qa[ks], sa, 0, 0, 0); sb = __builtin_amdgcn_mfma_f32_32x32x16_bf16(kf[ks], qb[ks], sb, 0, 0, 0); }
    bf16x8 pa[2], pb[2];
    softmax_tile(sa, A, pa); softmax_tile(sb, B, pb);
#pragma unroll
    for (int s2 = 0; s2 < 2; ++s2) {
        const s16x4 a0 = vtr(vt + c.vr0 + s2 * 2048), a1 = vtr(vt + c.vr0 + s2 * 2048 + 1024);
        const s16x4 b0 = vtr(vt + c.vr1 + s2 * 2048), b1 = vtr(vt + c.vr1 + s2 * 2048 + 1024);
        const bf16x8 v0 = (bf16x8){a0[0], a0[1], a0[2], a0[3], a1[0], a1[1], a1[2], a1[3]};
        const bf16x8 v1 = (bf16x8){b0[0], b0[1], b0[2], b0[3], b1[0], b1[1], b1[2], b1[3]};
        A.o0 = __builtin_amdgcn_mfma_f32_32x32x16_bf16(v0, pa[s2], A.o0, 0, 0, 0); A.o1 = __builtin_amdgcn_mfma_f32_32x32x16_bf16(v1, pa[s2], A.o1, 0, 0, 0);
        B.o0 = __builtin_amdgcn_mfma_f32_32x32x16_bf16(v0, pb[s2], B.o0, 0, 0, 0); B.o1 = __builtin_amdgcn_mfma_f32_32x32x16_bf16(v1, pb[s2], B.o1, 0, 0, 0);
    }
}

__device__ __forceinline__ void dma16(__amdgpu_buffer_rsrc_t rs, LAS unsigned char* dst, int vo, int so) { __builtin_amdgcn_raw_ptr_buffer_load_lds(rs, (LAS void*)dst, 16, vo, so, 0, 0); }
__device__ __forceinline__ unsigned lds_u32(const LAS unsigned char* p) { return (unsigned)(uintptr_t)p; }
template <class Spec>
__device__ __forceinline__ void run_dma(const Spec& sp, const Ctx& c, const bf16x8 (&qf)[4], float& m, float& l, f32x16& o0, f32x16& o1) {
    constexpr int NT = Spec::NT;
    LAS unsigned char* vt = c.vl; LAS unsigned char* kt = c.vl + 4096;
    unsigned ka[4];
    { const int ksw = ((c.lane & 31) >> 1) & 7;
#pragma unroll
      for (int ks = 0; ks < 4; ++ks) ka[ks] = lds_u32(kt) + c.kr + (((2 * ks + c.h) ^ ksw) << 4); }
    const unsigned va0 = lds_u32(vt) + c.vr0, va1 = lds_u32(vt) + c.vr1;
    asm volatile("s_waitcnt vmcnt(0) lgkmcnt(0)" ::: "memory");
    sp.dmaK(0, kt); sp.dmaV(0, vt);
    __builtin_amdgcn_sched_barrier(0);
#pragma unroll 1
    for (int t = 0; t < NT; ++t) {
        const bool more = t + 1 < NT;
        asm volatile("s_waitcnt vmcnt(4)" ::: "memory");
        bf16x8 kf0, kf1, kf2, kf3;
        asm volatile("ds_read_b128 %0, %1" : "=v"(kf0) : "v"(ka[0]) : "memory");
        asm volatile("ds_read_b128 %0, %1" : "=v"(kf1) : "v"(ka[1]) : "memory");
        asm volatile("ds_read_b128 %0, %1" : "=v"(kf2) : "v"(ka[2]) : "memory");
        asm volatile("ds_read_b128 %0, %1" : "=v"(kf3) : "v"(ka[3]) : "memory");
        asm volatile("s_waitcnt lgkmcnt(0)" : "+v"(kf0), "+v"(kf1), "+v"(kf2), "+v"(kf3) :: "memory");
        __builtin_amdgcn_sched_barrier(0);
        if (more) sp.dmaK(t + 1, kt);
        __builtin_amdgcn_sched_barrier(0);
        f32x16 s;
#pragma unroll
        for (int r = 0; r < 16; ++r) s[r] = 0.f;
        s = __builtin_amdgcn_mfma_f32_32x32x16_bf16(kf0, qf[0], s, 0, 0, 0); s = __builtin_amdgcn_mfma_f32_32x32x16_bf16(kf1, qf[1], s, 0, 0, 0);
        s = __builtin_amdgcn_mfma_f32_32x32x16_bf16(kf2, qf[2], s, 0, 0, 0); s = __builtin_amdgcn_mfma_f32_32x32x16_bf16(kf3, qf[3], s, 0, 0, 0);
        sp.bias(t, s);
        QState st; bf16x8 pf[2];
        st.m = m; st.l = l; st.o0 = o0; st.o1 = o1;
        softmax_tile(s, st, pf);
        m = st.m; l = st.l; o0 = st.o0; o1 = st.o1;
        __builtin_amdgcn_sched_barrier(0);
        if (more) asm volatile("s_waitcnt vmcnt(4)" ::: "memory"); else asm volatile("s_waitcnt vmcnt(0)" ::: "memory");
        s16x4 a0, a1, a2, a3, b0, b1, b2, b3;
        asm volatile("ds_read_b64_tr_b16 %0, %1" : "=v"(a0) : "v"(va0) : "memory");
        asm volatile("ds_read_b64_tr_b16 %0, %1 offset:1024" : "=v"(a1) : "v"(va0) : "memory");
        asm volatile("ds_read_b64_tr_b16 %0, %1 offset:2048" : "=v"(a2) : "v"(va0) : "memory");
        asm volatile("ds_read_b64_tr_b16 %0, %1 offset:3072" : "=v"(a3) : "v"(va0) : "memory");
        asm volatile("ds_read_b64_tr_b16 %0, %1" : "=v"(b0) : "v"(va1) : "memory");
        asm volatile("ds_read_b64_tr_b16 %0, %1 offset:1024" : "=v"(b1) : "v"(va1) : "memory");
        asm volatile("ds_read_b64_tr_b16 %0, %1 offset:2048" : "=v"(b2) : "v"(va1) : "memory");
        asm volatile("ds_read_b64_tr_b16 %0, %1 offset:3072" : "=v"(b3) : "v"(va1) : "memory");
        asm volatile("s_waitcnt lgkmcnt(0)" : "+v"(a0), "+v"(a1), "+v"(a2), "+v"(a3), "+v"(b0), "+v"(b1), "+v"(b2), "+v"(b3) :: "memory");
        __builtin_amdgcn_sched_barrier(0);
        if (more) sp.dmaV(t + 1, vt);
        __builtin_amdgcn_sched_barrier(0);
        const bf16x8 v00 = (bf16x8){a0[0], a0[1], a0[2], a0[3], a1[0], a1[1], a1[2], a1[3]}, v01 = (bf16x8){a2[0], a2[1], a2[2], a2[3], a3[0], a3[1], a3[2], a3[3]};
        const bf16x8 v10 = (bf16x8){b0[0], b0[1], b0[2], b0[3], b1[0], b1[1], b1[2], b1[3]}, v11 = (bf16x8){b2[0], b2[1], b2[2], b2[3], b3[0], b3[1], b3[2], b3[3]};
        o0 = __builtin_amdgcn_mfma_f32_32x32x16_bf16(v00, pf[0], o0, 0, 0, 0); o1 = __builtin_amdgcn_mfma_f32_32x32x16_bf16(v10, pf[0], o1, 0, 0, 0);
        o0 = __builtin_amdgcn_mfma_f32_32x32x16_bf16(v01, pf[1], o0, 0, 0, 0); o1 = __builtin_amdgcn_mfma_f32_32x32x16_bf16(v11, pf[1], o1, 0, 0, 0);
    }
}

__device__ __forceinline__ void load_q_asm(const unsigned char* qrow, int h, bf16x8& q0, bf16x8& q1, bf16x8& q2, bf16x8& q3) {
    const unsigned char* p = qrow + 16 * h;
    asm volatile("global_load_dwordx4 %0, %1, off" : "=v"(q0) : "v"(p) : "memory");
    asm volatile("global_load_dwordx4 %0, %1, off offset:32" : "=v"(q1) : "v"(p) : "memory");
    asm volatile("global_load_dwordx4 %0, %1, off offset:64" : "=v"(q2) : "v"(p) : "memory");
    asm volatile("global_load_dwordx4 %0, %1, off offset:96" : "=v"(q3) : "v"(p) : "memory");
}
template <class Spec>
__device__ __forceinline__ void run_dma_x(const Spec& sp, const Ctx& c, bf16x8& q0, bf16x8& q1, bf16x8& q2, bf16x8& q3, QState& st,
                                          bool first, bool hn, __amdgpu_buffer_rsrc_t rsn, int rw0n, const unsigned char* qrow_n) {
    constexpr int NT = Spec::NT;
    LAS unsigned char* vt = c.vl; LAS unsigned char* kt = c.vl + 4096;
    unsigned ka[4];
    { const int ksw = ((c.lane & 31) >> 1) & 7;
#pragma unroll
      for (int ks = 0; ks < 4; ++ks) ka[ks] = lds_u32(kt) + c.kr + (((2 * ks + c.h) ^ ksw) << 4); }
    const unsigned va0 = lds_u32(vt) + c.vr0, va1 = lds_u32(vt) + c.vr1;
#pragma unroll 1
    for (int t = 0; t < NT; ++t) {
        const bool lastt = t + 1 == NT;
        if (t == 0 && !first) asm volatile("s_waitcnt vmcnt(12)" ::: "memory"); else asm volatile("s_waitcnt vmcnt(4)" ::: "memory");
        bf16x8 kf0, kf1, kf2, kf3;
        asm volatile("ds_read_b128 %0, %1" : "=v"(kf0) : "v"(ka[0]) : "memory");
        asm volatile("ds_read_b128 %0, %1" : "=v"(kf1) : "v"(ka[1]) : "memory");
        asm volatile("ds_read_b128 %0, %1" : "=v"(kf2) : "v"(ka[2]) : "memory");
        asm volatile("ds_read_b128 %0, %1" : "=v"(kf3) : "v"(ka[3]) : "memory");
        asm volatile("s_waitcnt lgkmcnt(0)" : "+v"(kf0), "+v"(kf1), "+v"(kf2), "+v"(kf3) :: "memory");
        __builtin_amdgcn_sched_barrier(0);
        if (!lastt) sp.dmaK(t + 1, kt);
        __builtin_amdgcn_sched_barrier(0);
        f32x16 s;
#pragma unroll
        for (int r = 0; r < 16; ++r) s[r] = 0.f;
        s = __builtin_amdgcn_mfma_f32_32x32x16_bf16(kf0, q0, s, 0, 0, 0); s = __builtin_amdgcn_mfma_f32_32x32x16_bf16(kf1, q1, s, 0, 0, 0);
        s = __builtin_amdgcn_mfma_f32_32x32x16_bf16(kf2, q2, s, 0, 0, 0); s = __builtin_amdgcn_mfma_f32_32x32x16_bf16(kf3, q3, s, 0, 0, 0);
        if (lastt && hn) {
            __builtin_amdgcn_sched_barrier(0);
            load_q_asm(qrow_n, c.h, q0, q1, q2, q3); sp.dmaK_n(rsn, rw0n, kt);
            __builtin_amdgcn_sched_barrier(0);
        }
        sp.bias(t, s);
        bf16x8 pf[2];
        softmax_tile(s, st, pf);
        __builtin_amdgcn_sched_barrier(0);
        if (t == 0 && !first) asm volatile("s_waitcnt vmcnt(12)" ::: "memory");
        else if (lastt) { if (hn) asm volatile("s_waitcnt vmcnt(8)" ::: "memory"); else asm volatile("s_waitcnt vmcnt(0)" ::: "memory"); }
        else asm volatile("s_waitcnt vmcnt(4)" ::: "memory");
        s16x4 a0, a1, a2, a3, b0, b1, b2, b3;
        asm volatile("ds_read_b64_tr_b16 %0, %1" : "=v"(a0) : "v"(va0) : "memory");
        asm volatile("ds_read_b64_tr_b16 %0, %1 offset:1024" : "=v"(a1) : "v"(va0) : "memory");
        asm volatile("ds_read_b64_tr_b16 %0, %1 offset:2048" : "=v"(a2) : "v"(va0) : "memory");
        asm volatile("ds_read_b64_tr_b16 %0, %1 offset:3072" : "=v"(a3) : "v"(va0) : "memory");
        asm volatile("ds_read_b64_tr_b16 %0, %1" : "=v"(b0) : "v"(va1) : "memory");
        asm volatile("ds_read_b64_tr_b16 %0, %1 offset:1024" : "=v"(b1) : "v"(va1) : "memory");
        asm volatile("ds_read_b64_tr_b16 %0, %1 offset:2048" : "=v"(b2) : "v"(va1) : "memory");
        asm volatile("ds_read_b64_tr_b16 %0, %1 offset:3072" : "=v"(b3) : "v"(va1) : "memory");
        asm volatile("s_waitcnt lgkmcnt(0)" : "+v"(a0), "+v"(a1), "+v"(a2), "+v"(a3), "+v"(b0), "+v"(b1), "+v"(b2), "+v"(b3) :: "memory");
        __builtin_amdgcn_sched_barrier(0);
        if (!lastt) sp.dmaV(t + 1, vt); else if (hn) sp.dmaV_n(rsn, rw0n, vt);
        __builtin_amdgcn_sched_barrier(0);
        const bf16x8 v00 = (bf16x8){a0[0], a0[1], a0[2], a0[3], a1[0], a1[1], a1[2], a1[3]}, v01 = (bf16x8){a2[0], a2[1], a2[2], a2[3], a3[0], a3[1], a3[2], a3[3]};
        const bf16x8 v10 = (bf16x8){b0[0], b0[1], b0[2], b0[3], b1[0], b1[1], b1[2], b1[3]}, v11 = (bf16x8){b2[0], b2[1], b2[2], b2[3], b3[0], b3[1], b3[2], b3[3]};
        st.o0 = __builtin_amdgcn_mfma_f32_32x32x16_bf16(v00, pf[0], st.o0, 0, 0, 0); st.o1 = __builtin_amdgcn_mfma_f32_32x32x16_bf16(v10, pf[0], st.o1, 0, 0, 0);
        st.o0 = __builtin_amdgcn_mfma_f32_32x32x16_bf16(v01, pf[1], st.o0, 0, 0, 0); st.o1 = __builtin_amdgcn_mfma_f32_32x32x16_bf16(v11, pf[1], st.o1, 0, 0, 0);
    }
}
template <class Spec>
__device__ __forceinline__ void run(const Spec& sp, const Ctx& c, const bf16x8 (&qf)[4], float& m, float& l, f32x16& o0, f32x16& o1) {
    constexpr int NT = Spec::NT;
    static_assert(NT >= 4, "tile loop is peeled for NT >= 4");
    u32x4 kA[4], vA[4], kB[4], vB[4];
    sp.loadKV(0, kA, vA); sp.loadKV(1, kB, vB);
    int t = 0;
#pragma unroll 1
    for (; t + 3 < NT; t += 2) {
        tile_step<true>(sp, c, t, t + 2, kA, vA, qf, m, l, o0, o1);
        tile_step<true>(sp, c, t + 1, t + 3, kB, vB, qf, m, l, o0, o1);
    }
    if constexpr ((NT & 1) == 0) {
        tile_step<false>(sp, c, NT - 2, 0, kA, vA, qf, m, l, o0, o1);
        tile_step<false>(sp, c, NT - 1, 0, kB, vB, qf, m, l, o0, o1);
    } else {
        tile_step<true>(sp, c, NT - 3, NT - 1, kA, vA, qf, m, l, o0, o1);
        tile_step<false>(sp, c, NT - 2, 0, kB, vB, qf, m, l, o0, o1);
        tile_step<false>(sp, c, NT - 1, 0, kA, vA, qf, m, l, o0, o1);
    }
}
__device__ __forceinline__ float pair_sum(float v) { auto rr = __builtin_amdgcn_permlane32_swap(__float_as_uint(v), __float_as_uint(v), false, false); return __uint_as_float(rr[0]) + __uint_as_float(rr[1]); }
template <class P> __device__ __forceinline__ void store_o(P rowp, const f32x16& o0, const f32x16& o1, float inv, int h) {
#pragma unroll
    for (int g4 = 0; g4 < 4; ++g4) {
        u32x2 w0, w1; w0.x = cvtpk(o0[4 * g4] * inv, o0[4 * g4 + 1] * inv); w0.y = cvtpk(o0[4 * g4 + 2] * inv, o0[4 * g4 + 3] * inv);
        w1.x = cvtpk(o1[4 * g4] * inv, o1[4 * g4 + 1] * inv); w1.y = cvtpk(o1[4 * g4 + 2] * inv, o1[4 * g4 + 3] * inv);
        *(u32x2*)(rowp + (8 * g4 + 4 * h) * 2) = w0; *(u32x2*)(rowp + (32 + 8 * g4 + 4 * h) * 2) = w1;
    }
}
__device__ __forceinline__ void load_q(const unsigned char* qrow, int h, bf16x8 (&qf)[4]) {
#pragma unroll
    for (int ks = 0; ks < 4; ++ks) qf[ks] = *(const bf16x8*)(qrow + (16 * ks + 8 * h) * 2);
}

__device__ __forceinline__ u32x4 bload(__amdgpu_buffer_rsrc_t rs, int vo, int so) { return __builtin_amdgcn_raw_buffer_load_b128(rs, vo, so, 0); }
constexpr int NA_NEGIDX = 544;
struct SpecNA {
    static constexpr int NT = 9;
    __amdgpu_buffer_rsrc_t rs; int vo[4]; int rw0, kcolK, kcolV;
    int qr, r0q, bidx; const LAS float* btab; f32x16 madd;
    int dk0, dk1, dv0;
    __device__ __forceinline__ void dmaK(int t, LAS unsigned char* kt) const { int row = rw0 + t; row = row > GRID_R - 1 ? GRID_R - 1 : row; const int so = row * (GRID_W * 128) + kcolK;
        dma16(rs, kt, dk0, so); dma16(rs, kt + 1024, dk1, so + 1024); dma16(rs, kt + 2048, dk0, so + 2048); dma16(rs, kt + 3072, dk1, so + 3072); }
    __device__ __forceinline__ void dmaV(int t, LAS unsigned char* vt) const { int row = rw0 + t; row = row > GRID_R - 1 ? GRID_R - 1 : row; const int so = row * (GRID_W * 128) + kcolV;
        dma16(rs, vt, dv0, so); dma16(rs, vt + 1024, dv0, so + 1024); dma16(rs, vt + 2048, dv0, so + 2048); dma16(rs, vt + 3072, dv0, so + 3072); }
    __device__ __forceinline__ void dmaK_n(__amdgpu_buffer_rsrc_t rsn, int rw0n, LAS unsigned char* kt) const { const int so = rw0n * (GRID_W * 128) + kcolK;
        dma16(rsn, kt, dk0, so); dma16(rsn, kt + 1024, dk1, so + 1024); dma16(rsn, kt + 2048, dk0, so + 2048); dma16(rsn, kt + 3072, dk1, so + 3072); }
    __device__ __forceinline__ void dmaV_n(__amdgpu_buffer_rsrc_t rsn, int rw0n, LAS unsigned char* vt) const { const int so = rw0n * (GRID_W * 128) + kcolV;
        dma16(rsn, vt, dv0, so); dma16(rsn, vt + 1024, dv0, so + 1024); dma16(rsn, vt + 2048, dv0, so + 2048); dma16(rsn, vt + 3072, dv0, so + 3072); }
    __device__ __forceinline__ void loadKV(int t, u32x4 (&kr)[4], u32x4 (&vr)[4]) const {
        int row = rw0 + t; row = row > GRID_R - 1 ? GRID_R - 1 : row; const int so = row * (GRID_W * 128);
#pragma unroll
        for (int i = 0; i < 4; ++i) { kr[i] = bload(rs, vo[i], so + kcolK); vr[i] = bload(rs, vo[i], so + kcolV); } }
    __device__ __forceinline__ void bias(int t, f32x16& s) const {
        const int row = rw0 + t; const bool rv = (unsigned)(row - r0q) < 8u;
        const int idx = rv ? bidx + (row - qr + 7) * 31 : NA_NEGIDX;
        float bv[16];
#pragma unroll
        for (int rg = 0; rg < 16; ++rg) bv[rg] = btab[idx + crow0(rg)];
#pragma unroll
        for (int rg = 0; rg < 16; ++rg) asm volatile("" : "+v"(bv[rg]));
#pragma unroll
        for (int rg = 0; rg < 16; ++rg) s[rg] = (s[rg] + bv[rg]) + madd[rg];
    }
};
struct SpecDil {
    static constexpr int NT = 5;
    __amdgpu_buffer_rsrc_t rs; int pi[4]; int cb, kcolK, kcolV;
    int pos0, dil, q, h; const LAS float* btab;
    int ck0, ck1, cv0;
    __device__ __forceinline__ int cl(int p) const { return p < 0 ? 0 : (p > SEQ - 1 ? SEQ - 1 : p); }
    __device__ __forceinline__ void dmaK(int t, LAS unsigned char* kt) const { const int d = 32 * dil * t;
        dma16(rs, kt, cl(pi[0] + d) * 128 + ck0, kcolK); dma16(rs, kt + 1024, cl(pi[1] + d) * 128 + ck1, kcolK); dma16(rs, kt + 2048, cl(pi[2] + d) * 128 + ck0, kcolK); dma16(rs, kt + 3072, cl(pi[3] + d) * 128 + ck1, kcolK); }
    __device__ __forceinline__ void dmaV(int t, LAS unsigned char* vt) const { const int d = 32 * dil * t;
        dma16(rs, vt, cl(pi[0] + d) * 128 + cv0, kcolV); dma16(rs, vt + 1024, cl(pi[1] + d) * 128 + cv0, kcolV); dma16(rs, vt + 2048, cl(pi[2] + d) * 128 + cv0, kcolV); dma16(rs, vt + 3072, cl(pi[3] + d) * 128 + cv0, kcolV); }
    __device__ __forceinline__ void loadKV(int t, u32x4 (&kr)[4], u32x4 (&vr)[4]) const {
#pragma unroll
        for (int i = 0; i < 4; ++i) { int p = pi[i] + 32 * dil * t; p = p < 0 ? 0 : (p > SEQ - 1 ? SEQ - 1 : p); const int vo = p * 128 + cb; kr[i] = bload(rs, vo, kcolK); vr[i] = bload(rs, vo, kcolV); } }
    __device__ __forceinline__ void bias(int t, f32x16& s) const {
        const int idx = 32 + 32 * t + 4 * h - q;
        float bv[16];
#pragma unroll
        for (int rg = 0; rg < 16; ++rg) bv[rg] = btab[idx + crow0(rg)];
#pragma unroll
        for (int rg = 0; rg < 16; ++rg) asm volatile("" : "+v"(bv[rg]));
#pragma unroll
        for (int rg = 0; rg < 16; ++rg) s[rg] += bv[rg];
        const int lo = pos0 + dil * (-64 + 32 * t);
        if (lo < 0 || lo + 31 * dil >= SEQ) {
            const int pb = lo + dil * 4 * h;
#pragma unroll
            for (int rg = 0; rg < 16; ++rg) { const int pk = pb + dil * crow0(rg); s[rg] = ((unsigned)pk < (unsigned)SEQ) ? s[rg] : NEG_INF; }
        }
    }
};
struct SpecMem {
    static constexpr int NT = 8;
    __amdgpu_buffer_rsrc_t rs; int vo[4];
    __device__ __forceinline__ void loadKV(int t, u32x4 (&kr)[4], u32x4 (&vr)[4]) const {
        const int so = t * 32 * 128;
#pragma unroll
        for (int i = 0; i < 4; ++i) { kr[i] = bload(rs, vo[i], so); vr[i] = bload(rs, vo[i], so + 4 * BATCH * MEM_LEN * 128); } }
    __device__ __forceinline__ void bias(int, f32x16&) const {}
};

__device__ __forceinline__ void phase2(const MArgs& a, LAS unsigned char* lds, int vcu, int G) {
    const int tid = threadIdx.x, lane = tid & 63, wave = __builtin_amdgcn_readfirstlane(tid >> 6);
    const Ctx c = make_ctx(lds, wave, lane);
    const unsigned char* QKV = a.ws + WS_QKV; const unsigned char* KVM = a.ws + WS_KVM; unsigned char* MIX = a.ws + WS_MIX;
    const float* rpb = (const float*)(a.ws + WS_RPB); const float* biasD = (const float*)(a.ws + WS_BIASD);
    LAS float* lb = (LAS float*)(lds + L_BIAS);
    const int key_lo = lane >> 3, chunk16 = (lane & 7) * 16;
    const int parts = (!MK_ONE_LAUNCH && a.ph_lo >= 20) ? 1 << (a.ph_lo - 20) : 7;
    if (parts & 1) { LAS float* nt = (LAS float*)(lds + L_NATAB);
      __syncthreads();
      for (int i = tid; i < 8 * 576; i += NTHREADS) { const int hd = i / 576, j = i - 576 * hd; nt[i] = (j >= 32 && j < 32 + 465) ? rpb[hd * 465 + j - 32] : (j >= NA_NEGIDX ? NEG_INF : 0.f); }
      __syncthreads(); }
    if (parts & 1) {
        constexpr int NU = BATCH * NA_HEADS * (GRID_R / 4);
        const int I_ = wave & 3, cq_ = 16 * I_ + (c.q & 15);
        const int sc_ = 16 * I_ - 8 < 0 ? 0 : (16 * I_ - 8 > 32 ? 32 : 16 * I_ - 8); const int c0_ = cq_ - 8 < 0 ? 0 : (cq_ - 8 > GRID_W - 16 ? GRID_W - 16 : cq_ - 8);
        SpecNA sp;
        { const int chn_ = lane & 7, g16_ = lane >> 4; sp.dk0 = (sc_ + key_lo) * 128 + ((chn_ ^ (g16_ & 7)) << 4); sp.dk1 = (sc_ + key_lo) * 128 + ((chn_ ^ ((g16_ + 4) & 7)) << 4); sp.dv0 = (sc_ + key_lo) * 128 + ((chn_ ^ ((g16_ & 1) << 2)) << 4); }
        sp.kcolK = 0; sp.kcolV = ((C_VA - C_KA) / 64) * NTOK * 128; sp.bidx = 32 + (sc_ - cq_ + 15) + 4 * c.h;
#pragma unroll
        for (int r2 = 0; r2 < 16; ++r2) sp.madd[r2] = ((unsigned)(sc_ + crow0(r2) + 4 * c.h - c0_) < 16u) ? 0.f : NEG_INF;
#define NA_UNIT(u_, RS, RW0, QR, TQ, HEAD) do { const int rg_ = (u_) & 31, head_ = ((u_) >> 5) & 7, b_ = (u_) >> 8; const int rp_ = 2 * rg_ + (wave >> 2); \
            RS = __builtin_amdgcn_make_buffer_rsrc((void*)(QKV + ((size_t)(C_KA / 64 + head_) * NTOK + (size_t)b_ * SEQ) * 128), 0, 0x7fffffff, 0x00020000); \
            RW0 = 2 * rp_ - 4 < 0 ? 0 : (2 * rp_ - 4 > GRID_R - 8 ? GRID_R - 8 : 2 * rp_ - 4); QR = 2 * rp_ + (c.q >> 4); TQ = b_ * SEQ + QR * GRID_W + cq_; HEAD = head_; } while (0)
        int u = vcu; bool have = u < NU, first = true;
        int tq = 0, head = 0, qr = 0, rw0 = 0; __amdgpu_buffer_rsrc_t rs = __builtin_amdgcn_make_buffer_rsrc((void*)QKV, 0, 0x7fffffff, 0x00020000);
        bf16x8 q0, q1, q2, q3;
        if (have) {
            NA_UNIT(u, rs, rw0, qr, tq, head);
            sp.rs = rs; sp.rw0 = rw0;
            asm volatile("s_waitcnt vmcnt(0) lgkmcnt(0)" ::: "memory");
            load_q_asm(QKV + ((size_t)(C_QA / 64 + head) * NTOK + tq) * 128, c.h, q0, q1, q2, q3);
            sp.dmaK(0, c.vl + 4096); sp.dmaV(0, c.vl);
            asm volatile("s_waitcnt vmcnt(8)" : "+v"(q0), "+v"(q1), "+v"(q2), "+v"(q3) :: "memory");
            __builtin_amdgcn_sched_barrier(0);
        }
        while (have) {
            __builtin_amdgcn_s_barrier();
            const int un = u + G; const bool hn = un < NU;
            int tqn = tq, headn = head, qrn = qr, rw0n = rw0; __amdgpu_buffer_rsrc_t rsn = rs;
            if (hn) NA_UNIT(un, rsn, rw0n, qrn, tqn, headn);
            sp.rs = rs; sp.rw0 = rw0; sp.qr = qr; sp.r0q = qr - 4 < 0 ? 0 : (qr - 4 > GRID_R - 8 ? GRID_R - 8 : qr - 4); sp.btab = (const LAS float*)(lds + L_NATAB) + head * 576;
            QState st; st.m = -1e30f; st.l = 0.f;
#pragma unroll
            for (int i = 0; i < 16; ++i) { st.o0[i] = 0.f; st.o1[i] = 0.f; }
            run_dma_x(sp, c, q0, q1, q2, q3, st, first, hn, rsn, rw0n, QKV + ((size_t)(C_QA / 64 + headn) * NTOK + tqn) * 128);
            const float inv = 1.f / pair_sum(st.l);
            store_o(MIX + (size_t)tq * (DM * 2) + (head * 64) * 2, st.o0, st.o1, inv, c.h);
            if (hn) { asm volatile("s_waitcnt vmcnt(16)" : "+v"(q0), "+v"(q1), "+v"(q2), "+v"(q3) :: "memory");
                      __builtin_amdgcn_sched_barrier(0); }
            rs = rsn; rw0 = rw0n; qr = qrn; tq = tqn; head = headn; u = un; have = hn; first = false;
        }
#undef NA_UNIT
        asm volatile("s_waitcnt vmcnt(0)" ::: "memory");
    }
    if (parts & 2) {
        struct NoBias { __device__ __forceinline__ void bias(int, f32x16&) const {} } nb;
        const int nqb = SEQ / 256;
        for (int u = vcu; u < BATCH * MEM_HEADS * 8; u += G) {
            const int pair = u >> 3, head = pair & 3, b = pair >> 2;
            __syncthreads();
            { const unsigned char* kb = KVM + ((size_t)head * BATCH * MEM_LEN + (size_t)b * MEM_LEN) * 128; const unsigned char* vb = kb + (size_t)4 * BATCH * MEM_LEN * 128;
#pragma unroll
              for (int i = 0; i < 4; ++i) { const int idx = tid + NTHREADS * i, key = idx >> 3, ch = idx & 7;
                  const u32x4 kv = *(const u32x4*)(kb + (size_t)key * 128 + ch * 16), vv = *(const u32x4*)(vb + (size_t)key * 128 + ch * 16);
                  *(LAS u32x4*)(lds + key * 128 + ((ch ^ ((key >> 1) & 7)) << 4)) = kv;
                  *(LAS u32x4*)(lds + 32768 + key * 128 + ((ch ^ (((key >> 1) & 1) << 2)) << 4)) = vv; } }
            __syncthreads();
#pragma unroll 1
            for (int qq = 0; qq < 2; ++qq) {
                const int q0 = (4 * (u & 7) + 2 * qq) * 256 + wave * 64; if (q0 >= SEQ) break;
                const int tqa = b * SEQ + q0 + c.q, tqb = tqa + 32;
                bf16x8 qa[4], qbf[4]; load_q(QKV + ((size_t)(C_QM / 64 + head) * NTOK + tqa) * 128, c.h, qa); load_q(QKV + ((size_t)(C_QM / 64 + head) * NTOK + tqb) * 128, c.h, qbf);
                QState A, B; A.m = -1e30f; A.l = 0.f; B.m = -1e30f; B.l = 0.f;
#pragma unroll
                for (int i = 0; i < 16; ++i) { A.o0[i] = 0.f; A.o1[i] = 0.f; B.o0[i] = 0.f; B.o1[i] = 0.f; }
#pragma unroll 1
                for (int t = 0; t < 8; ++t) tile_core2(c, lds + 32768 + t * 4096, lds + t * 4096, qa, qbf, A, B);
                store_o(MIX + (size_t)tqa * (DM * 2) + (NA_W + 256 + head * 64) * 2, A.o0, A.o1, 1.f / pair_sum(A.l), c.h);
                store_o(MIX + (size_t)tqb * (DM * 2) + (NA_W + 256 + head * 64) * 2, B.o0, B.o1, 1.f / pair_sum(B.l), c.h);
            }
        }
        __syncthreads();
    }
    LAS unsigned char* so = lds + L_SO; LAS float* sm = (LAS float*)(lds + L_SM); LAS float* sl = (LAS float*)(lds + L_SL);
    if (parts & 4) for (int u = vcu; u < BATCH * 4 * (SEQ / 512); u += G) {
        const int blk = u & 15, hh = (u >> 4) & 3, b = u >> 6;
        __syncthreads();
        for (int i = tid; i < 3 * 192; i += NTHREADS) { const int g = i / 192, j = i - 192 * g - 32; lb[i] = (j >= 0 && j <= 128) ? biasD[(g * 4 + hh) * 129 + j] : NEG_INF; }
        __syncthreads();
#pragma unroll 1
        for (int g = 0; g < 3; ++g) {
            const int dil = g == 0 ? 1 : (g == 1 ? 4 : 16), head = g * 4 + hh;
#pragma unroll 1
            for (int k = 0; k < 2; ++k) {
                const int tl = wave * 2 + k;
                const int base = g == 0 ? 32 * tl : (g == 1 ? (tl & 3) + 128 * (tl >> 2) : tl);
                const int tql = base + dil * c.q;
                const int tq = b * SEQ + blk * 512 + tql;
                SpecDil sp; sp.rs = __builtin_amdgcn_make_buffer_rsrc((void*)(QKV + ((size_t)(C_KD / 64 + head) * NTOK + (size_t)b * SEQ) * 128), 0, 0x7fffffff, 0x00020000); sp.pos0 = blk * 512 + base; sp.dil = dil; sp.q = c.q; sp.h = c.h; sp.btab = lb + g * 192; sp.cb = chunk16;
#pragma unroll
                for (int i = 0; i < 4; ++i) sp.pi[i] = sp.pos0 + dil * (-64 + key_lo + 8 * i);
                sp.kcolK = 0; sp.kcolV = ((C_VD - C_KD) / 64) * NTOK * 128;
                { const int chn = lane & 7, g16 = lane >> 4; sp.ck0 = (chn ^ (g16 & 7)) << 4; sp.ck1 = (chn ^ ((g16 + 4) & 7)) << 4; sp.cv0 = (chn ^ ((g16 & 1) << 2)) << 4; }
                bf16x8 qf[4]; load_q(QKV + ((size_t)(C_QD / 64 + head) * NTOK + tq) * 128, c.h, qf);
                float m, l; f32x16 o0, o1;
                if (g == 0) { m = -1e30f; l = 0.f;
#pragma unroll
                    for (int i = 0; i < 16; ++i) { o0[i] = 0.f; o1[i] = 0.f; } }
                else {
                    m = sm[tql]; const float lt = sl[tql]; l = c.h == 0 ? lt : 0.f;
                    const LAS unsigned char* rowp = so + tql * SO_PITCH;
#pragma unroll
                    for (int g4 = 0; g4 < 4; ++g4) {
                        const u32x2 w0 = *(const LAS u32x2*)(rowp + (8 * g4 + 4 * c.h) * 2), w1 = *(const LAS u32x2*)(rowp + (32 + 8 * g4 + 4 * c.h) * 2);
                        o0[4 * g4] = __uint_as_float(w0.x << 16) * lt; o0[4 * g4 + 1] = __uint_as_float(w0.x & 0xffff0000u) * lt; o0[4 * g4 + 2] = __uint_as_float(w0.y << 16) * lt; o0[4 * g4 + 3] = __uint_as_float(w0.y & 0xffff0000u) * lt;
                        o1[4 * g4] = __uint_as_float(w1.x << 16) * lt; o1[4 * g4 + 1] = __uint_as_float(w1.x & 0xffff0000u) * lt; o1[4 * g4 + 2] = __uint_as_float(w1.y << 16) * lt; o1[4 * g4 + 3] = __uint_as_float(w1.y & 0xffff0000u) * lt;
                    }
                }
                run_dma(sp, c, qf, m, l, o0, o1);
                const float lt = pair_sum(l); const float inv = 1.f / lt;
                if (g < 2) { store_o(so + tql * SO_PITCH, o0, o1, inv, c.h); if (c.h == 0) { sm[tql] = m; sl[tql] = lt; } }
                else store_o(MIX + (size_t)tq * (DM * 2) + (NA_W + hh * 64) * 2, o0, o1, inv, c.h);
            }
            __syncthreads();
        }
    }
}
}

__device__ __forceinline__ void memkv_mini(const MArgs& a, LAS unsigned char* lds, int u) {
    const int tid = threadIdx.x, lane = tid & 63, wave = __builtin_amdgcn_readfirstlane(tid >> 6);
    const int hd = u & 7, rb = u >> 3, rh = wave & 1, kq = wave >> 1, r = lane & 31, h = lane >> 5;
    const bf16_t* XNm = (const bf16_t*)(a.ws + WS_XN) + (size_t)NTOK * DM;
    const bf16_t* WT = (const bf16_t*)(a.ws + WS_WINT);
    const bf16_t* arow = XNm + (size_t)(rb * 64 + rh * 32 + r) * DM + kq * 256 + 8 * h;
    const int n0 = 64 * hd + r, n1 = n0 + 32;
    const bf16_t* b0 = WT + (size_t)(4096 + inproj_pos(n0)) * DM + kq * 256 + 8 * h;
    const bf16_t* b1 = WT + (size_t)(4096 + inproj_pos(n1)) * DM + kq * 256 + 8 * h;
    f32x16 c0, c1;
#pragma unroll
    for (int i = 0; i < 16; ++i) { c0[i] = 0.f; c1[i] = 0.f; }
#pragma unroll 4
    for (int s2 = 0; s2 < 16; ++s2) {
        const bf16x8 af = *(const bf16x8*)(arow + 16 * s2), bf0 = *(const bf16x8*)(b0 + 16 * s2), bf1 = *(const bf16x8*)(b1 + 16 * s2);
        c0 = __builtin_amdgcn_mfma_f32_32x32x16_bf16(af, bf0, c0, 0, 0, 0);
        c1 = __builtin_amdgcn_mfma_f32_32x32x16_bf16(af, bf1, c1, 0, 0, 0);
    }
    LAS float* part = (LAS float*)lds + ((kq * 2 + rh) * 32) * 64;
#pragma unroll
    for (int i = 0; i < 16; ++i) { const int row = (i & 3) + 8 * (i >> 2) + 4 * h; part[row * 64 + r] = c0[i]; part[row * 64 + 32 + r] = c1[i]; }
    __syncthreads();
    { const int row = tid >> 3, cg = tid & 7; const int rh2 = row >> 5, rr = row & 31;
      float v[8];
#pragma unroll
      for (int j = 0; j < 8; ++j) { float sacc = 0.f;
#pragma unroll
          for (int q = 0; q < 4; ++q) sacc += ((LAS float*)lds)[(((q * 2 + rh2) * 32) + rr) * 64 + cg * 8 + j];
          v[j] = sacc; }
      float ss = 0.f;
#pragma unroll
      for (int j = 0; j < 8; ++j) ss += v[j] * v[j];
      ss += __shfl_xor(ss, 1); ss += __shfl_xor(ss, 2); ss += __shfl_xor(ss, 4);
      const float rn = hd < 4 ? rsqrtf(ss * (1.f / 64.f) + EPS) : 1.f;
      u32x4 w;
      if (hd < 4) { const float* gq = a.in[4] + 5 * 64 + cg * 8;
          w.x = att::cvtpk(v[0] * rn * gq[0], v[1] * rn * gq[1]); w.y = att::cvtpk(v[2] * rn * gq[2], v[3] * rn * gq[3]); w.z = att::cvtpk(v[4] * rn * gq[4], v[5] * rn * gq[5]); w.w = att::cvtpk(v[6] * rn * gq[6], v[7] * rn * gq[7]); }
      else { w.x = att::cvtpk(v[0], v[1]); w.y = att::cvtpk(v[2], v[3]); w.z = att::cvtpk(v[4], v[5]); w.w = att::cvtpk(v[6], v[7]); }
      bf16_t* KVM = (bf16_t*)(a.ws + WS_KVM);
      *(u32x4*)(KVM + ((size_t)hd * (BATCH * MEM_LEN) + rb * 64 + row) * 64 + cg * 8) = w;
    }
    __syncthreads();
}

__device__ __forceinline__ void phase4(const MArgs& a, LAS unsigned char* lds, int vcu, int G, bool dry) {
    const int tid = threadIdx.x, lane = tid & 63, wave = __builtin_amdgcn_readfirstlane(tid >> 6);
    const int r = lane & 15, kq = lane >> 4;
    LAS float* sR = (LAS float*)(lds + wave * 4096);
    LAS float* sLg = sR + 16;
    const bf16_t* x1 = (const bf16_t*)(a.ws + WS_X1B); const float* g_ffn = a.in[10];
    const bf16_t* WfH = (const bf16_t*)(a.ws + WS_WRF); const bf16_t* WfL = WfH + 32 * 3 * 64 * 8; const float* b48 = (const float*)(a.ws + WS_WRF + 2 * 32 * 3 * 64 * 8 * 2);
    constexpr int P4_MAXSLOT = 512;
    LAS int* hP = (LAS int*)(lds + 32768); LAS int* hE = hP + 128; LAS int* bP = hE + 32; LAS int* bE = bP + 128; LAS int* tinfo = bE + 32;
    for (int i = tid; i < 320 + P4_MAXSLOT * 4; i += NTHREADS) hP[i] = i < 320 ? 0 : -1;
    __syncthreads();
    int slot0 = wave * 16;
    bf16_t* H = (bf16_t*)(a.ws + WS_H); float* tokg = (float*)(a.ws + WS_TOKG); float* trstd = (float*)(a.ws + WS_RSTD); int* lists = (int*)(a.ws + WS_LIST); unsigned* count = (unsigned*)(a.ws + WS_CTL) + CW_COUNT;
    int* elists = (int*)(a.ws + WS_ELIST); int* tokP = (int*)(a.ws + WS_TOKP); unsigned* ecount = (unsigned*)(a.ws + WS_CTL) + CW_ECOUNT;
    for (int tile = vcu * NWAVES + wave; tile < NTOK / 16; tile += G * NWAVES) {
        const int tok0 = tile * 16;
        const bf16_t* xr = x1 + (size_t)(tok0 + r) * DM + 8 * kq;
        bf16_t* hr = H + (size_t)(tok0 + r) * DM + 8 * kq;
        f32x4 acc[3]; float ss = 0.f;
#pragma unroll
        for (int ct = 0; ct < 3; ++ct) acc[ct] = (f32x4){0.f, 0.f, 0.f, 0.f};
#pragma unroll 2
        for (int s = 0; s < 32; ++s) {
            const u32x4 xw = *(const u32x4*)(xr + 32 * s);
            const f32x4 xa = (f32x4){__uint_as_float(xw.x << 16), __uint_as_float(xw.x & 0xffff0000u), __uint_as_float(xw.y << 16), __uint_as_float(xw.y & 0xffff0000u)};
            const f32x4 xb = (f32x4){__uint_as_float(xw.z << 16), __uint_as_float(xw.z & 0xffff0000u), __uint_as_float(xw.w << 16), __uint_as_float(xw.w & 0xffff0000u)};
            ss += (xa[0] * xa[0] + xa[1] * xa[1]) + (xa[2] * xa[2] + xa[3] * xa[3]) + (xb[0] * xb[0] + xb[1] * xb[1]) + (xb[2] * xb[2] + xb[3] * xb[3]);
            const bf16x8 ah = __builtin_bit_cast(bf16x8, xw);
#pragma unroll
            for (int ct = 0; ct < 3; ++ct) {
                const bf16x8 wh = *(const bf16x8*)(WfH + ((size_t)(s * 3 + ct) * 64 + lane) * 8), wl = *(const bf16x8*)(WfL + ((size_t)(s * 3 + ct) * 64 + lane) * 8);
                acc[ct] = __builtin_amdgcn_mfma_f32_16x16x32_bf16(ah, wh, acc[ct], 0, 0, 0);
                acc[ct] = __builtin_amdgcn_mfma_f32_16x16x32_bf16(ah, wl, acc[ct], 0, 0, 0);
            }
        }
        ss += __shfl_xor(ss, 16); ss += __shfl_xor(ss, 32);
        const float rstd = rsqrtf(ss * (1.f / DM) + EPS);
        if (kq == 0) { sR[r] = rstd; trstd[tok0 + r] = rstd; }
#pragma unroll
        for (int ct = 0; ct < 3; ++ct) { const float bb = b48[16 * ct + r];
#pragma unroll
            for (int i = 0; i < 4; ++i) { const int tk = 4 * kq + i; sLg[tk * 48 + 16 * ct + r] = acc[ct][i] * sR[tk] + bb; } }
        if (lane < 16) {
            const int tok = tok0 + lane; const LAS float* lg = sLg + lane * 48;
            int gi = 0; float gm = lg[0];
            for (int i = 1; i < 4; ++i) if (lg[i] > gm) { gm = lg[i]; gi = i; }
            float den = 0.f; for (int i = 0; i < 4; ++i) den += __expf(lg[i] - gm);
            const float grp_gate = 1.f / den;
            const LAS float* fl = lg + 4 + gi * 8;
            int i0 = 0; float v0 = fl[0];
            for (int i = 1; i < 8; ++i) if (fl[i] > v0) { v0 = fl[i]; i0 = i; }
            int i1 = -1; float v1 = -3.0e38f;
            for (int i = 0; i < 8; ++i) if (i != i0 && fl[i] > v1) { v1 = fl[i]; i1 = i; }
            const float e1 = __expf(v1 - v0); const float g0 = grp_gate / (1.f + e1), g1 = grp_gate * e1 / (1.f + e1);
            int pa, pb; float ga, gb;
            if (i0 < i1) { pa = i0; pb = i1; ga = g0; gb = g1; } else { pa = i1; pb = i0; ga = g1; gb = g0; }
            const int L = gi * 28 + pa * 8 - pa * (pa + 1) / 2 + (pb - pa - 1);
            tokg[tok * 2] = ga; tokg[tok * 2 + 1] = gb;
            if (!dry) {
                const int ea = gi * 8 + pa, eb = gi * 8 + pb;
                if (slot0 + 16 <= P4_MAXSLOT) {
                    const int rp = __hip_atomic_fetch_add(&hP[L], 1, __ATOMIC_RELAXED, __HIP_MEMORY_SCOPE_WORKGROUP);
                    const int ra = __hip_atomic_fetch_add(&hE[ea], 1, __ATOMIC_RELAXED, __HIP_MEMORY_SCOPE_WORKGROUP);
                    const int rb = __hip_atomic_fetch_add(&hE[eb], 1, __ATOMIC_RELAXED, __HIP_MEMORY_SCOPE_WORKGROUP);
                    LAS int* ti = tinfo + (slot0 + lane) * 4;
                    ti[0] = tok; ti[1] = (L << 16) | rp; ti[2] = (ea << 16) | ra; ti[3] = (eb << 16) | rb;
                } else {
                    const unsigned pos = atomicAdd(&count[L], 1u); lists[(size_t)L * NTOK + pos] = tok; tokP[tok] = (L << 16) | (int)pos;
                    const unsigned qa = atomicAdd(&ecount[ea], 1u); elists[(size_t)ea * NTOK + qa] = tok * 2;
                    const unsigned qb = atomicAdd(&ecount[eb], 1u); elists[(size_t)eb * NTOK + qb] = tok * 2 + 1;
                }
            }
        }
        slot0 += NWAVES * 16;
    }
    if (!dry) {
        __syncthreads();
        const int nslot = slot0 - wave * 16 < P4_MAXSLOT ? slot0 - wave * 16 : P4_MAXSLOT;
        if (tid < NPAIR) { const int h = hP[tid]; bP[tid] = h ? (int)atomicAdd(&count[tid], (unsigned)h) : 0; }
        else if (tid >= 128 && tid < 128 + NEXP) { const int h = hE[tid - 128]; bE[tid - 128] = h ? (int)atomicAdd(&ecount[tid - 128], (unsigned)h) : 0; }
        __syncthreads();
        for (int sidx = tid; sidx < nslot; sidx += NTHREADS) {
            const LAS int* ti = tinfo + sidx * 4; const int tok = ti[0];
            if (tok >= 0) {
                const int L = ti[1] >> 16, pos = bP[L] + (ti[1] & 0xffff); lists[(size_t)L * NTOK + pos] = tok; tokP[tok] = (L << 16) | pos;
                const int ea = ti[2] >> 16, eb = ti[3] >> 16;
                elists[(size_t)ea * NTOK + bE[ea] + (ti[2] & 0xffff)] = tok * 2;
                elists[(size_t)eb * NTOK + bE[eb] + (ti[3] & 0xffff)] = tok * 2 + 1;
            }
        }
    }
}

#define XB_TMO      128
#define XB_XCNT(j)  (256  + 64 * (j))
#define XB_XSUB(j)  (1280 + 64 * (j))
#define XB_XGEN(j)  (2304 + 64 * (j))
#define XB_TOP      3328
#define XB_TOPGEN   3392
#define XCD_BAR_WORDS 3456
#define XB_SPIN_CAP (1u << 18)
__device__ __forceinline__ unsigned xb_ld(unsigned* p)              { return __hip_atomic_load(p, __ATOMIC_RELAXED, __HIP_MEMORY_SCOPE_AGENT); }
__device__ __forceinline__ unsigned xb_add(unsigned* p, unsigned v) { return __hip_atomic_fetch_add(p, v, __ATOMIC_RELAXED, __HIP_MEMORY_SCOPE_AGENT); }
__device__ __forceinline__ unsigned xb_xcc_id() { return (unsigned)__builtin_amdgcn_s_getreg((3 << 11) | 20) & 0xFu; }
#define XB_SPIN(cond, bar) do { unsigned _sp = 0; while (cond) { __builtin_amdgcn_s_sleep(1); \
    if ((++_sp & 255u) == 0u) { if (xb_ld(&(bar)[XB_TMO])) break; if (_sp > XB_SPIN_CAP) { atomicAdd(&(bar)[XB_TMO], 1u); break; } } } } while (0)
struct XcdBarrier { unsigned* bar; unsigned x; volatile LAS unsigned* st; };
__device__ __forceinline__ XcdBarrier xcd_barrier_post(unsigned* bar, volatile LAS unsigned* st) {
    XcdBarrier b; b.bar = bar; b.x = xb_xcc_id(); b.st = st;
    if (threadIdx.x == 0) (void)xb_add(&bar[XB_XCNT(b.x)], 1u);
    return b;
}
__device__ __forceinline__ void xcd_barrier_complete(unsigned* bar, unsigned x, unsigned& nloc, unsigned& nx) {
    const unsigned G = gridDim.x * gridDim.y * gridDim.z;
    unsigned sum, cnt, mine, sp = 0u;
    for (;;) {
        sum = 0u; cnt = 0u; mine = 0u;
#pragma unroll
        for (unsigned j = 0; j < 16; ++j) { const unsigned c = xb_ld(&bar[XB_XCNT(j)]); sum += c; cnt += (c > 0u) ? 1u : 0u; mine = (j == x) ? c : mine; }
        if (sum == G) break;
        __builtin_amdgcn_s_sleep(1);
        if ((++sp & 255u) == 0u) { if (xb_ld(&bar[XB_TMO])) break; if (sp > XB_SPIN_CAP) { atomicAdd(&bar[XB_TMO], 1u); break; } }
    }
    nloc = mine > 0u ? mine : 1u; nx = cnt > 0u ? cnt : 1u;
}
__device__ __forceinline__ void xcd_barrier(const XcdBarrier& b) {
    asm volatile("s_waitcnt vmcnt(0)" ::: "memory");
    __syncthreads();
    if (threadIdx.x == 0) {
        unsigned* bar = b.bar;
        __builtin_amdgcn_s_waitcnt(0);
        unsigned nloc = b.st[0], nx = b.st[1];
        if (nloc == 0u) { xcd_barrier_complete(bar, b.x, nloc, nx); b.st[0] = nloc; b.st[1] = nx; }
        const unsigned old = xb_add(&bar[XB_XSUB(b.x)], 1u);
        const unsigned gen = old / nloc;
        if (old + 1u == (gen + 1u) * nloc) {
            __builtin_amdgcn_fence(__ATOMIC_RELEASE, "agent");
            asm volatile("s_waitcnt vmcnt(0)" ::: "memory");
            const unsigned og = xb_add(&bar[XB_TOP], 1u);
            const unsigned tg = og / nx;
            if (og + 1u == (tg + 1u) * nx) xb_add(&bar[XB_TOPGEN], 1u);
            else XB_SPIN(xb_ld(&bar[XB_TOPGEN]) == tg, bar);
            __builtin_amdgcn_fence(__ATOMIC_ACQUIRE, "agent");
            xb_add(&bar[XB_XGEN(b.x)], 1u);
            asm volatile("s_waitcnt vmcnt(0)" ::: "memory");
        } else {
            XB_SPIN(xb_ld(&bar[XB_XGEN(b.x)]) == gen, bar);
            __builtin_amdgcn_fence(__ATOMIC_ACQUIRE, "agent");
            asm volatile("s_waitcnt vmcnt(0)" ::: "memory");
        }
    }
    __syncthreads();
}
constexpr int CW_BAR = 4096;
constexpr int MISC_OFF = LDS_BYTES - 256;

__global__ void __launch_bounds__(NTHREADS, 2) mega(MArgs a) {
    extern __shared__ __attribute__((aligned(16))) unsigned char lds_raw[];
    LAS unsigned char* lds = (LAS unsigned char*)lds_raw;
    const int G = gridDim.x; const int bx = blockIdx.x; const int vcu = (G % 8 == 0) ? (bx % 8) * (G / 8) + bx / 8 : bx;
    const int lo = a.ph_lo, hi = a.ph_hi;
#define IN_PH(k) (lo <= (k) && (k) < hi)
    volatile LAS unsigned* misc = (volatile LAS unsigned*)(lds + MISC_OFF);
    if (threadIdx.x < 2) misc[threadIdx.x] = 0u;
    __syncthreads();
    XcdBarrier xbar; xbar.bar = (unsigned*)(a.ws + WS_CTL) + CW_BAR; xbar.x = 0; xbar.st = misc;
    if (hi - lo > 1) xbar = xcd_barrier_post((unsigned*)(a.ws + WS_CTL) + CW_BAR, misc);
#define SEAM(k) do { if (IN_PH(k) && IN_PH((k) + 1)) { if ((k) == 0) cg::this_grid().sync(); else xcd_barrier(xbar); } } while (0)
    if (IN_PH(0)) { phase0(a, lds, vcu, G); }
    SEAM(0);
    if (IN_PH(1)) {
        for (int u = bx; u < 256; u += G) memkv_mini(a, lds, u);
        SchedInProj S{(const char*)(a.ws + WS_XN), (const char*)(a.ws + WS_WINT), G, bx};
        EpiInProj E{(bf16_t*)(a.ws + WS_QKV), (bf16_t*)(a.ws + WS_KVM), a.in[4], (const float*)(a.ws + WS_RSTDX)};
        pg8::gemm_phase<EpiInProj, SchedInProj, false, true>(lds, DM / 64, DM, DM, S, E);
    }
    SEAM(1);
    if (IN_PH(2) || (!MK_ONE_LAUNCH && a.ph_lo >= 20 && a.ph_lo < 23)) { att::phase2(a, lds, vcu, G); }
    SEAM(2);
    if (IN_PH(3)) {
        SchedOutProj S{(const char*)(a.ws + WS_MIX), (const char*)(a.ws + WS_WOT), G, bx};
        EpiOutProj E{(const bf16_t*)(a.ws + WS_XN), (bf16_t*)(a.ws + WS_X1B), a.ws + WS_X1Q};
        pg8::gemm_phase<EpiOutProj, SchedOutProj, false, true>(lds, DM / 64, DM, DM, S, E);
    }
    SEAM(3);
    if (IN_PH(4) || lo == 7) { phase4(a, lds, vcu, G, lo == 7); }
    SEAM(4);
    if (IN_PH(5)) {
        const unsigned* count = (const unsigned*)(a.ws + WS_CTL) + CW_COUNT; const unsigned* ecount = (const unsigned*)(a.ws + WS_CTL) + CW_ECOUNT;
        moe_build_tiles(lds, count, ecount);
        const LAS int* tt = (const LAS int*)(lds + TT_OFF);
        SchedMoe1 S{(const char*)(a.ws + WS_X1Q), (const char*)(a.ws + WS_W13T), (const int*)(a.ws + WS_ELIST), ecount, tt, tt[TT_E], G, bx};
        EpiMoe1 E{(bf16_t*)(a.ws + WS_ACT), (const int*)(a.ws + WS_ELIST), ecount, (const float*)(a.ws + WS_TOKG), (const float*)(a.ws + WS_RSTD), (const int*)(a.ws + WS_TOKP), tt};
        pg8::gemm_phase<EpiMoe1, SchedMoe1, true, true, true>(lds, DM / 128, DM / 2, DM / 2, S, E);
    }
    SEAM(5);
    if (IN_PH(6) || lo == 8) {
        const unsigned* count = (const unsigned*)(a.ws + WS_CTL) + CW_COUNT;
        const int ntiles = moe_build_tiles(lds, count, (const unsigned*)(a.ws + WS_CTL) + CW_ECOUNT);
        SchedMoe2 S{(const char*)(a.ws + WS_ACT), (const char*)(a.ws + WS_W2T), (const LAS int*)(lds + TT_OFF), ntiles, G, bx};
        EpiMoe2 E{(!MK_ONE_LAUNCH && a.var == 3) ? (float*)(a.ws + WS_XN) : a.out, (const bf16_t*)(a.ws + WS_X1B), (const int*)(a.ws + WS_LIST), count, lo == 8 ? 0.f : 1.f / (SC_ACT * SC_W2), MK_ONE_LAUNCH ? 0 : a.var};
        pg8::gemm_phase<EpiMoe2, SchedMoe2, false, true, true>(lds, DM / 128, DM / 2, DEXP / 2, S, E);
    }
#undef IN_PH
#undef SEAM
}

static void launch_mega(const MArgs& base, int lo, int hi, int grid, hipStream_t stream) {
    MArgs a = base; a.ph_lo = lo; a.ph_hi = hi;
    hipLaunchKernelGGL(mega, dim3(grid), dim3(NTHREADS), LDS_BYTES, stream, a);
}
extern "C" void kernel_launch(void* const* d_in, const int* in_sizes, int n_in, void* d_out, int out_size, void* d_ws, size_t ws_size, hipStream_t stream) {
    if (n_in != 18 || ws_size < WS_END || out_size != NTOK * DM) { fprintf(stderr, "kernel_launch: unexpected sizes n_in %d ws %zu out %d\n", n_in, ws_size, out_size); return; }
    static int grid = 0;
    if (grid == 0) {
        int dev = 0, cus = 0, per_cu = 0;
        if (hipGetDevice(&dev) != hipSuccess || hipDeviceGetAttribute(&cus, hipDeviceAttributeMultiprocessorCount, dev) != hipSuccess) { grid = -1; return; }
        if (hipFuncSetAttribute((const void*)mega, hipFuncAttributeMaxDynamicSharedMemorySize, LDS_BYTES) != hipSuccess) { fprintf(stderr, "hipFuncSetAttribute failed\n"); grid = -1; return; }
        if (hipOccupancyMaxActiveBlocksPerMultiprocessor(&per_cu, (const void*)mega, NTHREADS, LDS_BYTES) != hipSuccess || per_cu < 1) { fprintf(stderr, "occupancy query failed (%d)\n", per_cu); grid = -1; return; }
        grid = cus * per_cu;
    }
    if (grid < 0) return;
    MArgs base; memset(&base, 0, sizeof base);
    for (int i = 0; i < 18; ++i) base.in[i] = (const float*)d_in[i];
    base.out = (float*)d_out; base.ws = (unsigned char*)d_ws;
    static_assert((CW_BAR + XCD_BAR_WORDS) * 4 <= 65536 && (CW_ECOUNT + NEXP) * 4 <= 65536, "control words inside the zeroed region");
    (void)hipMemsetAsync((unsigned char*)d_ws + WS_CTL, 0, 65536, stream);
#if MK_ONE_LAUNCH
    base.ph_lo = 0; base.ph_hi = 7;
    void* args[] = {&base};
    hipError_t e = hipLaunchCooperativeKernel((const void*)mega, dim3(grid), dim3(NTHREADS), args, LDS_BYTES, stream);
    if (e != hipSuccess) fprintf(stderr, "cooperative launch failed: %s (grid %d)\n", hipGetErrorString(e), grid);
#else
    for (int p = 0; p < 7; ++p) { launch_mega(base, p, p + 1, grid, stream); if (p == MK_REP_PHASE) launch_mega(base, p, p + 1, grid, stream); if (p == 4 && MK_REP_PHASE == 7) launch_mega(base, 7, 8, grid, stream); if (p == 6 && MK_REP_PHASE == 8) launch_mega(base, 8, 9, grid, stream);
        if (p == 2 && MK_REP_PHASE >= 20 && MK_REP_PHASE < 30) for (int r = 0; r < 4; ++r) launch_mega(base, MK_REP_PHASE, MK_REP_PHASE + 1, grid, stream);
        if (MK_REP_PHASE >= 100 && p == MK_REP_PHASE % 100) { MArgs b2 = base; b2.var = MK_REP_PHASE / 100; for (int r = 0; r < 2; ++r) launch_mega(b2, p, p + 1, grid, stream); } }
#endif
    (void)in_sizes;
}
```

```cpp
#include <hip/hip_runtime.h>
#include <hip/hip_cooperative_groups.h>
#include <cstdio>
#include <cstdint>
#include <cstring>

constexpr int DM = 1024, BATCH = 8, SEQ = 8192, NTOK = BATCH * SEQ;
constexpr int HD = 64, MEM_LEN = 256, GRID_W = 64, GRID_R = SEQ / GRID_W;
constexpr int NA_HEADS = 8, DIL_HEADS = 12, MEM_HEADS = 4;
constexpr int NA_W = 512, DIL_W = 768, MEM_W = 256, IN_COLS = 4096;
constexpr int C_QA = 0, C_KA = 512, C_VA = 1024, C_QD = 1536, C_KD = 2304, C_VD = 3072, C_QM = 3840;
constexpr int NEXP = 32, DEXP = 512;
constexpr int NPAIR = 112;
constexpr int MROWS = NTOK + MEM_LEN * BATCH;
constexpr float EPS = 1e-6f;
constexpr float LOG2E = 1.4426950408889634f;
constexpr float QSCALE = 0.125f * LOG2E;

typedef unsigned short bf16_t;
namespace cg = cooperative_groups;
#ifndef MK_ONE_LAUNCH
#define MK_ONE_LAUNCH 1
#endif
#ifndef MK_REP_PHASE
#define MK_REP_PHASE -1
#endif

constexpr size_t MiB = 1u << 20;
constexpr size_t WS_CTL = 0;
constexpr size_t WS_BIASD = 1 * MiB;
constexpr size_t WS_RPB = 1 * MiB + 64 * 1024;
constexpr size_t WS_WRF = 1 * MiB + 128 * 1024;
constexpr size_t WS_TOKG = 2 * MiB;
constexpr size_t WS_RSTD = 2 * MiB + 512 * 1024;
constexpr size_t WS_LIST = 4 * MiB;
constexpr size_t WS_KVM = 32 * MiB;
constexpr size_t WS_ELIST = 36 * MiB;
constexpr size_t WS_TOKP = 2 * MiB + 768 * 1024;
constexpr size_t WS_WT = 48 * MiB;
constexpr size_t WS_XN = 160 * MiB;
constexpr size_t WS_QKV = 304 * MiB;
constexpr size_t WS_H = WS_QKV;
constexpr size_t WS_X1Q = WS_QKV;
constexpr float SC_X1 = 16.f, SC_W13 = 512.f, SC_ACT = 8.f, SC_W2 = 256.f, SC_MIX = 32.f, SC_WO = 512.f;
constexpr size_t WS_ACT = WS_QKV + 128 * MiB;
constexpr size_t WS_X1B = 640 * MiB;
constexpr size_t WS_MIX = 816 * MiB;
constexpr size_t WS_RSTDX = 3 * MiB;
constexpr size_t WS_END = 944 * MiB;
constexpr int MAXTILES = NTOK / 256 + NPAIR;
constexpr int CW_COUNT = 64;
constexpr int CW_ECOUNT = 256;
constexpr int MAXETILES = 2 * NTOK / 256 + 32;

__device__ __forceinline__ float bf2f(bf16_t v) { return __uint_as_float((unsigned)v << 16); }
__device__ __forceinline__ bf16_t f2bf(float f) { unsigned u = __float_as_uint(f); return (bf16_t)((u + 0x7fffu + ((u >> 16) & 1u)) >> 16); }
__device__ __forceinline__ float wave_sum(float v) {
#pragma unroll
    for (int o = 1; o < 64; o <<= 1) v += __shfl_xor(v, o);
    return v;
}

__device__ __forceinline__ int t5_bucket(int rel) {
    const int n = rel < 0 ? -rel : rel;
    const int upper = rel > 0 ? 16 : 0;
    const float nf = (float)(n < 1 ? 1 : n);
    int large = 8 + (int)(logf(nf / 8.f) / logf(128.f) * 8.f);
    large = large < 15 ? large : 15;
    return upper + (n < 8 ? n : large);
}
__device__ __forceinline__ void pair_experts(int L, int& ea, int& eb) {
    const int grp = L / 28; int idx = L % 28; int a = 0;
    while (idx >= 7 - a) { idx -= 7 - a; ++a; }
    ea = grp * 8 + a; eb = grp * 8 + a + 1 + idx;
}

#define LAS __attribute__((address_space(3)))
typedef short bf16x8 __attribute__((ext_vector_type(8)));
typedef float f32x4 __attribute__((ext_vector_type(4)));
typedef float f32x16 __attribute__((ext_vector_type(16)));
typedef unsigned u32x4 __attribute__((ext_vector_type(4)));
typedef unsigned u32x2 __attribute__((ext_vector_type(2)));

constexpr int NWAVES = 8, NTHREADS = 512;
constexpr int LDS_BYTES = 163840;
constexpr int RING_BYTES = 131072;

constexpr size_t WS_WINT = WS_WT;
constexpr size_t WS_WOT = WS_WINT + (size_t)4608 * 1024 * 2;
constexpr size_t WS_W13T = WS_WOT + (size_t)1024 * 1024 * 2;
constexpr size_t WS_W2T = WS_W13T + (size_t)32 * 1024 * 1024 * 2;
static_assert(WS_W2T + (size_t)32 * 1024 * 512 * 2 <= WS_XN, "weight copies fit");
static_assert(WS_ACT + (size_t)MAXTILES * 256 * 1024 * 2 <= WS_X1B && WS_X1B + (size_t)NTOK * 1024 * 2 <= WS_MIX, "ACT | X1B | MIX do not overlap");

__device__ __forceinline__ unsigned cvt_pk_bf16(float lo, float hi) { unsigned r; asm volatile("v_cvt_pk_bf16_f32 %0, %1, %2" : "=v"(r) : "v"(lo), "v"(hi)); return r; }
__device__ __forceinline__ unsigned pk4_fp8(float a, float b, float c, float d) { int w = 0; w = __builtin_amdgcn_cvt_pk_fp8_f32(a, b, w, false); w = __builtin_amdgcn_cvt_pk_fp8_f32(c, d, w, true); return (unsigned)w; }
__device__ __forceinline__ unsigned pk2(float lo, float hi) { return (unsigned)f2bf(lo) | ((unsigned)f2bf(hi) << 16); }

namespace pg8 {
constexpr int BM = 256, BK = 64, HALF = 128, HTB = HALF * BK * 2, NXCD = 8, WGM = 8;
__device__ __forceinline__ int lds_byte(int r, int c) { const int st = (r >> 4) * 2 + (c >> 5), rr = r & 15, cc = c & 31, ob = rr * 64 + cc * 2; return st * 1024 + (ob ^ (((ob >> 9) & 1) << 5)); }
__device__ __forceinline__ void stage_rc(int b, int& R, int& C) { const int st = b / 1024, sb = b % 1024, swz = sb ^ (((sb >> 9) & 1) << 5); R = (st >> 1) * 16 + swz / 64; C = (st & 1) * 32 + (swz % 64) / 2; }
__device__ __forceinline__ int perm32(int rho) { const int n = rho >> 4, i = rho & 15; return 8 * (i >> 2) + 4 * n + (i & 3); }

typedef short bf16x16_t __attribute__((ext_vector_type(16)));
typedef int i32x4_t __attribute__((ext_vector_type(4)));
typedef int i32x8_t __attribute__((ext_vector_type(8)));
__device__ __forceinline__ f32x4 mfma_fp8(const bf16x8& a0, const bf16x8& a1, const bf16x8& b0, const bf16x8& b1, const f32x4& c) {
    const i32x8_t A = __builtin_shufflevector(__builtin_bit_cast(i32x4_t, a0), __builtin_bit_cast(i32x4_t, a1), 0, 1, 2, 3, 4, 5, 6, 7);
    const i32x8_t B = __builtin_shufflevector(__builtin_bit_cast(i32x4_t, b0), __builtin_bit_cast(i32x4_t, b1), 0, 1, 2, 3, 4, 5, 6, 7);
    return __builtin_amdgcn_mfma_scale_f32_16x16x128_f8f6f4(A, B, c, 0, 0, 0, 0x7F7F7F7F, 0, 0x7F7F7F7F);
}
struct Unit { const char* A; const char* B0; const char* B1; int ksplit; int e0, e1, e2, e3; };

__device__ __forceinline__ int xcd_remap(int L, int nwg) { const int q = nwg / NXCD, r = nwg % NXCD, xcd = L % NXCD, off = L / NXCD; return (xcd < r ? xcd * (q + 1) : r * (q + 1) + (xcd - r) * q) + off; }

template <class Epi, class Sched, bool GATHER, bool ALIGN_EPI, bool FP8 = false>
__device__ __forceinline__ void gemm_phase(LAS unsigned char* lds, const int nt, const int lda, const int ldb, const Sched& S, const Epi& E) {
    const int tid = threadIdx.x, wid = __builtin_amdgcn_readfirstlane(tid >> 6), lane = tid & 63, wr = wid >> 2, wc = wid & 3, fr = lane & 15, fq = lane >> 4;
    int sR[2], sC[2]; unsigned voffB[2];
#pragma unroll
    for (int i = 0; i < 2; ++i) { int R, C; stage_rc(tid * 16 + i * 8192, R, C); sR[i] = R; sC[i] = C; const int Rb = Epi::PERM ? ((R & ~31) + perm32(R & 31)) : R; voffB[i] = (unsigned)(Rb * ldb + C) * 2u; }
    const size_t kstep = (size_t)(BK * 2);
    const size_t hstepB = (size_t)HALF * ldb * 2;
    const unsigned ldsw = (unsigned)wid * 1024u;
    const int aoff = lds_byte(wr * 64 + fr, fq * 8), boff = lds_byte(wc * 32 + fr, fq * 8);
#define PG8_SA(b, h) (((b) * 2 + (h)) * HTB)
#define PG8_SB(b, h) ((4 + (b) * 2 + (h)) * HTB)
#define PG8_STAGE(bufoff, gbase, voff) do { _Pragma("unroll") for (int _i = 0; _i < 2; ++_i) \
        __builtin_amdgcn_global_load_lds((const unsigned*)((const char*)(gbase) + (voff)[_i]), (LAS unsigned*)(lds + (bufoff) + ldsw + _i * 8192), 16, 0, 0); } while (0)
#define PG8_LDA(dst, b, h) do { _Pragma("unroll") for (int m = 0; m < 4; ++m) { \
        if constexpr (FP8) { const i32x4_t lo_ = *(const LAS i32x4_t*)(lds + PG8_SA(b, h) + aoff + m * 2048), hi_ = *(const LAS i32x4_t*)(lds + PG8_SA(b, h) + aoff + m * 2048 + 1024); dst##W[m] = __builtin_shufflevector(lo_, hi_, 0, 1, 2, 3, 4, 5, 6, 7); } \
        else { _Pragma("unroll") for (int k = 0; k < 2; ++k) dst[m][k] = *(const LAS bf16x8*)(lds + PG8_SA(b, h) + aoff + m * 2048 + k * 1024); } } } while (0)
#define PG8_LDB(dst, b, h) do { _Pragma("unroll") for (int n = 0; n < 2; ++n) { \
        if constexpr (FP8) { const i32x4_t lo_ = *(const LAS i32x4_t*)(lds + PG8_SB(b, h) + boff + n * 2048), hi_ = *(const LAS i32x4_t*)(lds + PG8_SB(b, h) + boff + n * 2048 + 1024); dst##W[n] = __builtin_shufflevector(lo_, hi_, 0, 1, 2, 3, 4, 5, 6, 7); } \
        else { _Pragma("unroll") for (int k = 0; k < 2; ++k) dst[n][k] = *(const LAS bf16x8*)(lds + PG8_SB(b, h) + boff + n * 2048 + k * 1024); } } } while (0)
#define PG8_MMA(ai, bj, At, Bt) do { __builtin_amdgcn_s_setprio(1); _Pragma("unroll") for (int m = 0; m < 4; ++m) _Pragma("unroll") for (int n = 0; n < 2; ++n) { \
        if constexpr (FP8) asm("v_mfma_scale_f32_16x16x128_f8f6f4 %0, %1, %2, %0, %3, %3 op_sel_hi:[0,0,0]" : "+v"(acc[ai][bj][m][n]) : "v"(Bt##W[n]), "v"(At##W[m]), "v"(one8)); \
        else { _Pragma("unroll") for (int k = 0; k < 2; ++k) acc[ai][bj][m][n] = __builtin_amdgcn_mfma_f32_16x16x32_bf16(Bt[n][k], At[m][k], acc[ai][bj][m][n], 0, 0, 0); } } __builtin_amdgcn_s_setprio(0); } while (0)
#define PG8_WAIT_V(n) asm volatile("s_waitcnt vmcnt(" #n ")" ::: "memory")
#define PG8_WAIT_L(n) asm volatile("s_waitcnt lgkmcnt(" #n ")" ::: "memory")
#define PG8_BAR __builtin_amdgcn_s_barrier()
#define PG8_SCHED __builtin_amdgcn_sched_barrier(0)
#define PG8_BP(u, t) (((t) < (u).ksplit ? (u).B0 : (u).B1) + (size_t)(t) * kstep)
    Unit cur, nxt; int ui = 0;
    if (!S.next(0, cur)) return;
    f32x4 acc[2][2][4][2];
#pragma unroll
    for (int a = 0; a < 2; ++a)
#pragma unroll
        for (int b = 0; b < 2; ++b)
#pragma unroll
            for (int m = 0; m < 4; ++m)
#pragma unroll
                for (int n = 0; n < 2; ++n) acc[a][b][m][n] = (f32x4){0.f, 0.f, 0.f, 0.f};
    bf16x8 At[4][2], B0[2][2], B1[2][2];
    i32x8_t AtW[4], B0W[2], B1W[2];
    const int one8 = 0x7F7F7F7F;
    unsigned vA[2][2], nvA[2][2];
    S.template aoffs<GATHER>(cur, sR, sC, lda, vA);
    const char* cA = cur.A; const char* cB0 = PG8_BP(cur, 0); const char* cB1 = PG8_BP(cur, 1);
    PG8_STAGE(PG8_SB(0, 0), cB0, voffB); PG8_STAGE(PG8_SB(0, 1), cB0 + hstepB, voffB); PG8_STAGE(PG8_SA(0, 0), cA, vA[0]); PG8_STAGE(PG8_SA(0, 1), cA, vA[1]);
    if (wr == 1) PG8_BAR;
    PG8_WAIT_V(2); PG8_BAR;
    PG8_STAGE(PG8_SB(1, 0), cB1, voffB); PG8_STAGE(PG8_SA(1, 0), cA + kstep, vA[0]); PG8_STAGE(PG8_SB(1, 1), cB1 + hstepB, voffB);
    PG8_WAIT_V(6); PG8_BAR;
    for (;;) {
        const bool has_next = S.next(ui + 1, nxt);
        if (!has_next) nxt = cur;
        if constexpr (GATHER) {
            if (has_next) S.template aoffs<GATHER>(nxt, sR, sC, lda, nvA);
            else {
#pragma unroll
                for (int h = 0; h < 2; ++h)
#pragma unroll
                    for (int i = 0; i < 2; ++i) nvA[h][i] = vA[h][i];
            }
        }
        const char* nA = nxt.A;
#pragma unroll 1
        for (int t = 0; t < nt; t += 2) {
            const bool last = (t == nt - 2);
            const char* a1 = cA + (size_t)(t + 1) * kstep;
            const char* a2 = last ? nA : cA + (size_t)(t + 2) * kstep; const char* a3 = a2 + kstep;
            const char* b2 = last ? PG8_BP(nxt, 0) : PG8_BP(cur, t + 2); const char* b3 = last ? PG8_BP(nxt, 1) : PG8_BP(cur, t + 3);
            unsigned wA[2][2];
#pragma unroll
            for (int h = 0; h < 2; ++h)
#pragma unroll
                for (int i = 0; i < 2; ++i) { if constexpr (GATHER) { const unsigned msk = last ? 0xffffffffu : 0u; wA[h][i] = vA[h][i] ^ ((vA[h][i] ^ nvA[h][i]) & msk); } else wA[h][i] = vA[h][i]; }
            PG8_LDB(B0, 0, 0); PG8_LDB(B1, 0, 1); PG8_SCHED; PG8_LDA(At, 0, 0); PG8_STAGE(PG8_SA(1, 1), a1, vA[1]);
            PG8_WAIT_V(8); PG8_WAIT_L(0); PG8_BAR; PG8_MMA(0, 0, At, B0); PG8_MMA(0, 1, At, B1); PG8_BAR; PG8_SCHED;
            PG8_LDA(At, 0, 1); PG8_STAGE(PG8_SB(0, 0), b2, voffB); PG8_STAGE(PG8_SB(0, 1), b2 + hstepB, voffB); PG8_STAGE(PG8_SA(0, 0), a2, wA[0]);
            PG8_WAIT_V(8); PG8_WAIT_L(0); PG8_BAR; PG8_MMA(1, 0, At, B0); PG8_MMA(1, 1, At, B1); PG8_BAR; PG8_SCHED;
            PG8_LDB(B0, 1, 0); PG8_LDB(B1, 1, 1); PG8_SCHED; PG8_LDA(At, 1, 0); PG8_STAGE(PG8_SA(0, 1), a2, wA[1]);
            PG8_WAIT_V(8); PG8_WAIT_L(0); PG8_BAR; PG8_MMA(0, 0, At, B0); PG8_MMA(0, 1, At, B1); PG8_BAR; PG8_SCHED;
            PG8_LDA(At, 1, 1); PG8_STAGE(PG8_SB(1, 0), b3, voffB); PG8_STAGE(PG8_SB(1, 1), b3 + hstepB, voffB); PG8_STAGE(PG8_SA(1, 0), a3, wA[0]);
            PG8_WAIT_V(8); PG8_WAIT_L(0); PG8_BAR; PG8_MMA(1, 0, At, B0); PG8_MMA(1, 1, At, B1); PG8_BAR; PG8_SCHED;
        }
        if constexpr (ALIGN_EPI) { if (wr == 0) PG8_BAR; }
        if constexpr (FP8) asm volatile("s_nop 15\n\ts_nop 15" ::: "memory");
        E(acc, cur, wr, wc, fr, fq);
        if (!has_next) break;
#pragma unroll
        for (int a = 0; a < 2; ++a)
#pragma unroll
            for (int b = 0; b < 2; ++b)
#pragma unroll
                for (int m = 0; m < 4; ++m)
#pragma unroll
                    for (int n = 0; n < 2; ++n) acc[a][b][m][n] = (f32x4){0.f, 0.f, 0.f, 0.f};
        cur = nxt; cA = nA; ++ui;
        if constexpr (GATHER) {
#pragma unroll
            for (int h = 0; h < 2; ++h)
#pragma unroll
                for (int i = 0; i < 2; ++i) vA[h][i] = nvA[h][i];
        }
        if constexpr (ALIGN_EPI) { if (wr == 1) PG8_BAR; }
    }
    PG8_WAIT_V(0);
    if constexpr (!ALIGN_EPI) { if (wr == 0) PG8_BAR; }
    PG8_BAR;
#undef PG8_SA
#undef PG8_SB
#undef PG8_STAGE
#undef PG8_LDA
#undef PG8_LDB
#undef PG8_MMA
#undef PG8_WAIT_V
#undef PG8_WAIT_L
#undef PG8_BAR
#undef PG8_SCHED
#undef PG8_BP
}
}

struct MArgs {
    const float* in[18]; float* out; unsigned char* ws; int ph_lo, ph_hi, var, pad_;
};

__device__ __forceinline__ void p0_transpose_item(const float* W, int N, int k0, int n0, bf16_t* WT, int dst_row0, int ldk, LAS float* scr, int lane, const float* kscale = nullptr, float fp8scale = 0.f) {
    { const int kr = lane >> 3, g = lane & 7;
      const float* src = W + (size_t)(k0 + kr) * N + n0 + 4 * g;
      f32x4 v[8];
#pragma unroll
      for (int i = 0; i < 8; ++i) v[i] = *(const f32x4*)(src + (size_t)(8 * i) * N);
#pragma unroll
      for (int i = 0; i < 8; ++i) { const int kk = kr + 8 * i; *(LAS f32x4*)(scr + kk * 36 + ((g ^ i) << 2)) = v[i]; } }
    const int c = lane & 7;
    float ks[8];
    if (kscale) { const f32x4 s0 = *(const f32x4*)(kscale + k0 + 8 * c), s1 = *(const f32x4*)(kscale + k0 + 8 * c + 4); ks[0] = s0[0]; ks[1] = s0[1]; ks[2] = s0[2]; ks[3] = s0[3]; ks[4] = s1[0]; ks[5] = s1[1]; ks[6] = s1[2]; ks[7] = s1[3]; }
    else {
#pragma unroll
        for (int j = 0; j < 8; ++j) ks[j] = 1.f; }
    asm volatile("s_waitcnt lgkmcnt(0)" ::: "memory");
#pragma unroll
    for (int j = 0; j < 4; ++j) { const int n = (lane >> 3) + 8 * j; const LAS float* sp = scr + (8 * c) * 36 + ((((n >> 2) ^ c) << 2) | (n & 3));
        if (fp8scale != 0.f) {
            u32x2 o; o.x = pk4_fp8(sp[0 * 36] * ks[0] * fp8scale, sp[1 * 36] * ks[1] * fp8scale, sp[2 * 36] * ks[2] * fp8scale, sp[3 * 36] * ks[3] * fp8scale);
            o.y = pk4_fp8(sp[4 * 36] * ks[4] * fp8scale, sp[5 * 36] * ks[5] * fp8scale, sp[6 * 36] * ks[6] * fp8scale, sp[7 * 36] * ks[7] * fp8scale);
            *(u32x2*)((unsigned char*)WT + (size_t)(dst_row0 + n) * ldk + k0 + 8 * c) = o;
        } else {
        u32x4 o; o.x = pk2(sp[0 * 36] * ks[0], sp[1 * 36] * ks[1]); o.y = pk2(sp[2 * 36] * ks[2], sp[3 * 36] * ks[3]); o.z = pk2(sp[4 * 36] * ks[4], sp[5 * 36] * ks[5]); o.w = pk2(sp[6 * 36] * ks[6], sp[7 * 36] * ks[7]);
        *(u32x4*)(WT + (size_t)(dst_row0 + n) * ldk + k0 + 8 * c) = o; } }
    asm volatile("s_waitcnt lgkmcnt(0)" ::: "memory");
}
__device__ __forceinline__ int inproj_pos(int n) { const int l = n & 255; return (n & ~255) + 128 * ((l >> 5) & 1) + 32 * (l >> 6) + (l & 31); }

__device__ __forceinline__ void phase0(const MArgs& a, LAS unsigned char* lds, int vcu, int G) {
    const int tid = threadIdx.x, lane = tid & 63, wave = __builtin_amdgcn_readfirstlane(tid >> 6);
    unsigned char* ws = a.ws;
    LAS float* scr = (LAS float*)(lds + wave * 16384);
    const int gw = vcu * NWAVES + wave, NGW = G * NWAVES;
    constexpr int I_IN = 16 * 128, I_MK = 16 * 16, I_O = 16 * 32, I_W1 = 32 * 16 * 16, I_W2 = 32 * 8 * 32;
    constexpr int NITEMS = I_IN + I_MK + I_O + 2 * I_W1 + I_W2;
    bf16_t* WinT = (bf16_t*)(ws + WS_WINT); bf16_t* WoT = (bf16_t*)(ws + WS_WOT); bf16_t* W13T = (bf16_t*)(ws + WS_W13T); bf16_t* W2T = (bf16_t*)(ws + WS_W2T);
    for (int it = gw; it < NITEMS; it += NGW) {
        int r = it;
        if (r < I_IN) { const int kb = r / 128, nb = r % 128; p0_transpose_item(a.in[3], IN_COLS, kb * 64, nb * 32, WinT, inproj_pos(nb * 32), DM, scr, lane, a.in[2]); continue; } r -= I_IN;
        if (r < I_MK) { const int kb = r / 16, nb = r % 16; p0_transpose_item(a.in[8], 512, kb * 64, nb * 32, WinT, 4096 + inproj_pos(nb * 32), DM, scr, lane); continue; } r -= I_MK;
        if (r < I_O) { const int kb = r / 32, nb = r % 32; p0_transpose_item(a.in[9], DM, kb * 64, nb * 32, WoT, nb * 32, DM, scr, lane, nullptr, SC_WO); continue; } r -= I_O;
        if (r < 2 * I_W1) { const int which = r / I_W1; r %= I_W1; const int e = r / 256, kb = (r % 256) / 16, nb = r % 16; const int n0 = nb * 32;
            p0_transpose_item(a.in[15 + which] + (size_t)e * DM * DEXP, DEXP, kb * 64, n0, W13T, e * 1024 + 256 * (n0 >> 7) + 128 * which + (n0 & 127), DM, scr, lane, a.in[10], SC_W13); continue; } r -= 2 * I_W1;
        { const int e = r / 256, kb = (r % 256) / 32, nb = r % 32; p0_transpose_item(a.in[17] + (size_t)e * DEXP * DM, DM, kb * 64, nb * 32, W2T, e * 1024 + nb * 32, DEXP, scr, lane, nullptr, SC_W2); }
    }
    bf16_t* XN = (bf16_t*)(ws + WS_XN); float* rstdx = (float*)(ws + WS_RSTDX);
    for (int r = gw; r < MROWS; r += NGW) {
        const bool isx = r < NTOK;
        const float* src = isx ? a.in[0] + (size_t)r * DM : a.in[1] + (size_t)(r - NTOK) * DM;
        const float4* xr = (const float4*)src;
        float4 v[4]; float s = 0.f;
#pragma unroll
        for (int j = 0; j < 4; ++j) { v[j] = xr[lane + 64 * j]; s += v[j].x * v[j].x + v[j].y * v[j].y + v[j].z * v[j].z + v[j].w * v[j].w; }
        s = wave_sum(s);
        const float rstd = rsqrtf(s * (1.f / DM) + EPS);
        if (isx) { if (lane == 0) rstdx[r] = rstd; }
        const float sc = isx ? 1.f : rstd;
#pragma unroll
        for (int j = 0; j < 4; ++j) {
            float4 gg = (float4){1.f, 1.f, 1.f, 1.f}; if (!isx) gg = ((const float4*)a.in[7])[lane + 64 * j];
            u32x2 o; o.x = pk2(v[j].x * sc * gg.x, v[j].y * sc * gg.y); o.y = pk2(v[j].z * sc * gg.z, v[j].w * sc * gg.w);
            ((u32x2*)(XN + (size_t)r * DM))[lane + 64 * j] = o;
        }
    }
    { bf16_t* WfH = (bf16_t*)(ws + WS_WRF); bf16_t* WfL = WfH + 32 * 3 * 64 * 8; float* b48 = (float*)(ws + WS_WRF + 2 * 32 * 3 * 64 * 8 * 2);
      for (int t = vcu * NTHREADS + tid; t < 32 * 3 * 64 * 8 + 48; t += G * NTHREADS) {
          if (t < 32 * 3 * 64 * 8) { const int j = t & 7, ln = (t >> 3) & 63, sc = t >> 9, ct = sc % 3, st = sc / 3; const int k = 32 * st + 8 * (ln >> 4) + j, col = 16 * ct + (ln & 15);
              const float w = (col < 4 ? a.in[11][k * 4 + col] : (col < 36 ? a.in[13][k * 32 + col - 4] : 0.f)) * a.in[10][k];
              const bf16_t hi = f2bf(w); WfH[t] = hi; WfL[t] = f2bf(w - bf2f(hi)); }
          else { const int col = t - 32 * 3 * 64 * 8; b48[col] = col < 4 ? a.in[12][col] : (col < 36 ? a.in[14][col - 4] : 0.f); }
      } }
    float* biasD = (float*)(ws + WS_BIASD); float* rpb = (float*)(ws + WS_RPB);
    for (int t = vcu * NTHREADS + tid; t < 8 * 15 * 31; t += G * NTHREADS) {
        if (t < 3 * 4 * 129) { const int j = t % 129, hh = (t / 129) % 4, g = t / (129 * 4); const int dil = g == 0 ? 1 : (g == 1 ? 4 : 16);
            biasD[t] = a.in[6][t5_bucket((j - 64) * dil) * 12 + g * 4 + hh] * LOG2E; }
        rpb[t] = a.in[5][t] * LOG2E;
    }
}

struct SchedInProj {
    const char* A; const char* B; int G, c;
    __device__ __forceinline__ bool next(int i, pg8::Unit& u) const {
        const int L = i * G + c; constexpr int NW = 256 * 16;
        int pm, pn;
        if (L < NW) { const int wgid = pg8::xcd_remap(L, NW); const int nig = pg8::WGM * 16, gid = wgid / nig, fm = gid * pg8::WGM; pm = fm + ((wgid % nig) % pg8::WGM); pn = (wgid % nig) / pg8::WGM; }
        else return false;
        u.A = A + (size_t)pm * 256 * DM * 2; u.B0 = B + (size_t)pn * 256 * DM * 2; u.B1 = u.B0; u.ksplit = 1 << 30; u.e0 = pm; u.e1 = pn; u.e2 = 0; u.e3 = 0;
        return true;
    }
    template <bool GATHER> __device__ __forceinline__ void aoffs(const pg8::Unit&, const int (&sR)[2], const int (&sC)[2], int lda, unsigned (&v)[2][2]) const {
#pragma unroll
        for (int h = 0; h < 2; ++h)
#pragma unroll
            for (int i = 0; i < 2; ++i) v[h][i] = (unsigned)((sR[i] + 128 * h) * lda + sC[i]) * 2u;
    }
};
struct EpiInProj {
    static constexpr bool PERM = true;
    bf16_t* QKV; bf16_t* KVM; const float* gain; const float* rstdx;
    __device__ __forceinline__ void operator()(const f32x4 (&acc)[2][2][4][2], const pg8::Unit& u, int wr, int wc, int fr, int fq) const {
        const int pm = u.e0, pn = u.e1;
        int gi = -1; float sc = 1.f; bf16_t* base; int hplane, nrows, rowt;
        if (pn < 16) { base = QKV; hplane = 4 * pn; nrows = NTOK; rowt = pm * 256;
            if (pn < 2) { gi = 0; sc = QSCALE; } else if (pn < 4) gi = 1; else if (pn < 6) gi = -1; else if (pn < 9) { gi = 2; sc = QSCALE; } else if (pn < 12) gi = 3; else if (pn < 15) gi = -1; else { gi = 4; sc = QSCALE; } }
        else { base = KVM; hplane = 4 * (pn - 16); nrows = BATCH * MEM_LEN; rowt = (pm - 256) * 256; gi = pn == 16 ? 5 : -1; }
        float gv[2][2][4];
#pragma unroll
        for (int bj = 0; bj < 2; ++bj)
#pragma unroll
            for (int n = 0; n < 2; ++n)
#pragma unroll
                for (int j = 0; j < 4; ++j) gv[bj][n][j] = gi >= 0 ? gain[gi * 64 + 32 * bj + 8 * fq + 4 * n + j] * sc : 1.f;
#pragma unroll
        for (int ai = 0; ai < 2; ++ai)
#pragma unroll
            for (int m = 0; m < 4; ++m) {
                const float rx = pn < 16 ? rstdx[rowt + ai * 128 + wr * 64 + m * 16 + fr] : 1.f;
                float ss = 0.f;
#pragma unroll
                for (int bj = 0; bj < 2; ++bj)
#pragma unroll
                    for (int n = 0; n < 2; ++n) { const f32x4 x = acc[ai][bj][m][n]; ss += (x[0] * x[0] + x[1] * x[1]) + (x[2] * x[2] + x[3] * x[3]); }
                ss += __shfl_xor(ss, 16); ss += __shfl_xor(ss, 32);
                const float r = (gi >= 0 ? rsqrtf(ss * (rx * rx) * (1.f / 64.f) + EPS) : 1.f) * rx;
                bf16_t* rowp = base + ((size_t)(hplane + wc) * nrows + (rowt + ai * 128 + wr * 64 + m * 16 + fr)) * 64 + 8 * fq;
#pragma unroll
                for (int bj = 0; bj < 2; ++bj) {
                    const f32x4 v0 = acc[ai][bj][m][0], v1 = acc[ai][bj][m][1];
                    u32x4 w;
                    w.x = cvt_pk_bf16(v0[0] * r * gv[bj][0][0], v0[1] * r * gv[bj][0][1]); w.y = cvt_pk_bf16(v0[2] * r * gv[bj][0][2], v0[3] * r * gv[bj][0][3]);
                    w.z = cvt_pk_bf16(v1[0] * r * gv[bj][1][0], v1[1] * r * gv[bj][1][1]); w.w = cvt_pk_bf16(v1[2] * r * gv[bj][1][2], v1[3] * r * gv[bj][1][3]);
                    *(u32x4*)(rowp + 32 * bj) = w;
                }
            }
    }
};


struct SchedOutProj {
    const char* A; const char* B; int G, c;
    __device__ __forceinline__ bool next(int i, pg8::Unit& u) const {
        const int L = i * G + c; constexpr int NW = 256 * 4;
        if (L >= NW) return false;
        const int wgid = pg8::xcd_remap(L, NW); const int nig = pg8::WGM * 4, gid = wgid / nig, fm = gid * pg8::WGM; const int pm = fm + ((wgid % nig) % pg8::WGM), pn = (wgid % nig) / pg8::WGM;
        u.A = A + (size_t)pm * 256 * DM; u.B0 = B + (size_t)pn * 256 * DM; u.B1 = u.B0; u.ksplit = 1 << 30; u.e0 = pm; u.e1 = pn; u.e2 = 0; u.e3 = 0;
        return true;
    }
    template <bool GATHER> __device__ __forceinline__ void aoffs(const pg8::Unit&, const int (&sR)[2], const int (&sC)[2], int lda, unsigned (&v)[2][2]) const {
#pragma unroll
        for (int h = 0; h < 2; ++h)
#pragma unroll
            for (int i = 0; i < 2; ++i) v[h][i] = (unsigned)((sR[i] + 128 * h) * lda + sC[i]) * 2u;
    }
};
struct EpiOutProj {
    static constexpr bool PERM = true;
    const bf16_t* X; bf16_t* O; unsigned char* Q8;
    __device__ __forceinline__ void operator()(const f32x4 (&acc)[2][2][4][2], const pg8::Unit& u, int wr, int wc, int fr, int fq) const {
        const int row0 = u.e0 * 256 + wr * 64 + fr, col0 = u.e1 * 256 + wc * 32 + 8 * fq;
        u32x4 xv[2][4][2];
#pragma unroll
        for (int ai = 0; ai < 2; ++ai)
#pragma unroll
            for (int m = 0; m < 4; ++m) { const size_t off = (size_t)(row0 + ai * 128 + m * 16) * DM + col0;
#pragma unroll
                for (int bj = 0; bj < 2; ++bj) xv[ai][m][bj] = *(const u32x4*)(X + off + bj * 128); }
#pragma unroll
        for (int ai = 0; ai < 2; ++ai)
#pragma unroll
            for (int m = 0; m < 4; ++m) { const size_t off = (size_t)(row0 + ai * 128 + m * 16) * DM + col0;
#pragma unroll
                for (int bj = 0; bj < 2; ++bj) { const u32x4 w0 = xv[ai][m][bj];
                    const f32x4 x0 = (f32x4){__uint_as_float(w0.x << 16), __uint_as_float(w0.x & 0xffff0000u), __uint_as_float(w0.y << 16), __uint_as_float(w0.y & 0xffff0000u)};
                    const f32x4 x1v = (f32x4){__uint_as_float(w0.z << 16), __uint_as_float(w0.z & 0xffff0000u), __uint_as_float(w0.w << 16), __uint_as_float(w0.w & 0xffff0000u)};
                    const f32x4 v0 = x0 + acc[ai][bj][m][0] * (1.f / (SC_MIX * SC_WO)), v1 = x1v + acc[ai][bj][m][1] * (1.f / (SC_MIX * SC_WO));
                    u32x4 w; w.x = cvt_pk_bf16(v0[0], v0[1]); w.y = cvt_pk_bf16(v0[2], v0[3]); w.z = cvt_pk_bf16(v1[0], v1[1]); w.w = cvt_pk_bf16(v1[2], v1[3]);
                    *(u32x4*)(O + off + bj * 128) = w;
                    u32x2 q; q.x = pk4_fp8(v0[0] * SC_X1, v0[1] * SC_X1, v0[2] * SC_X1, v0[3] * SC_X1); q.y = pk4_fp8(v1[0] * SC_X1, v1[1] * SC_X1, v1[2] * SC_X1, v1[3] * SC_X1);
                    *(u32x2*)(Q8 + off + bj * 128) = q; } }
    }
};

constexpr int TT_OFF = RING_BYTES;
constexpr int TT_PBASE = 1 + 2 * MAXTILES, TT_E = TT_PBASE + NPAIR;
static_assert((TT_E + 1 + 2 * MAXETILES) * 4 <= 16384, "tile tables fit the spare LDS");
__device__ __forceinline__ int moe_build_tiles(LAS unsigned char* lds, const unsigned* count, const unsigned* ecount) {
    LAS int* tt = (LAS int*)(lds + TT_OFF);
    __syncthreads();
    if (threadIdx.x == 0) {
        int nt = 0;
        for (int L = 0; L < NPAIR; ++L) { tt[TT_PBASE + L] = nt; const int c = (int)__hip_atomic_load(count + L, __ATOMIC_RELAXED, __HIP_MEMORY_SCOPE_AGENT); for (int r = 0; r < c; r += 256) { tt[1 + nt] = L; tt[1 + MAXTILES + nt] = r; ++nt; } }
        tt[0] = nt;
    }
    if (threadIdx.x == 64) {
        int ne = 0;
        for (int e = 0; e < NEXP; ++e) { const int c = (int)__hip_atomic_load(ecount + e, __ATOMIC_RELAXED, __HIP_MEMORY_SCOPE_AGENT); for (int r = 0; r < c; r += 256) { tt[TT_E + 1 + ne] = e; tt[TT_E + 1 + MAXETILES + ne] = r; ++ne; } }
        tt[TT_E] = ne;
    }
    __syncthreads();
    return tt[0];
}
struct SchedMoe1 {
    const char* Hb; const char* W13T; const int* elists; const unsigned* ecount; const LAS int* tt; int netiles, G, c;
    __device__ __forceinline__ bool next(int i, pg8::Unit& u) const {
        const int L = i * G + c, nwg = netiles * 4;
        if (L >= nwg) return false;
        const int U = pg8::xcd_remap(L, nwg), T = U >> 2, pn = U & 3;
        const int e = tt[TT_E + 1 + T], row0 = tt[TT_E + 1 + MAXETILES + T];
        u.A = Hb; u.B0 = W13T + ((size_t)e * 1024 + pn * 256) * DM; u.B1 = u.B0; u.ksplit = 1 << 30; u.e0 = T; u.e1 = pn; u.e2 = e; u.e3 = row0;
        return true;
    }
    template <bool GATHER> __device__ __forceinline__ void aoffs(const pg8::Unit& u, const int (&sR)[2], const int (&sC)[2], int lda, unsigned (&v)[2][2]) const {
        const int cnt = (int)ecount[u.e2]; const int* lp = elists + (size_t)u.e2 * NTOK;
#pragma unroll
        for (int h = 0; h < 2; ++h)
#pragma unroll
            for (int i = 0; i < 2; ++i) { int p = u.e3 + 128 * h + sR[i]; p = p < cnt ? p : cnt - 1; const int tok = lp[p] >> 1; v[h][i] = (unsigned)(tok * lda + sC[i]) * 2u; }
    }
};
struct EpiMoe1 {
    static constexpr bool PERM = true;
    bf16_t* ACT; const int* elists; const unsigned* ecount; const float* tokg; const float* trstd; const int* tokP; const LAS int* tt;
    __device__ __forceinline__ void operator()(const f32x4 (&acc)[2][2][4][2], const pg8::Unit& u, int wr, int wc, int fr, int fq) const {
        const int pn = u.e1, e = u.e2, row0 = u.e3;
        const int cnt = (int)ecount[e]; const int* lp = elists + (size_t)e * NTOK;
#pragma unroll
        for (int ai = 0; ai < 2; ++ai)
#pragma unroll
            for (int m = 0; m < 4; ++m) {
                const int p = row0 + ai * 128 + wr * 64 + m * 16 + fr;
                if (p < cnt) {
                    const int ent = lp[p], tok = ent >> 1, role = ent & 1;
                    const float g = tokg[tok * 2 + role] * SC_ACT; const float rs = trstd[tok] * (1.f / (SC_X1 * SC_W13)); const int tp = tokP[tok];
                    const int drow = tt[TT_PBASE + (tp >> 16)] * 256 + (tp & 0xffff);
                    const f32x4 a0 = acc[ai][0][m][0], a1 = acc[ai][0][m][1], b0 = acc[ai][1][m][0], b1 = acc[ai][1][m][1];
                    float o[8];
#pragma unroll
                    for (int j = 0; j < 4; ++j) { const float x0 = a0[j] * rs, x1v = a1[j] * rs; o[j] = x0 / (1.f + __expf(-x0)) * (b0[j] * rs) * g; o[4 + j] = x1v / (1.f + __expf(-x1v)) * (b1[j] * rs) * g; }
#pragma unroll
                    for (int j = 0; j < 8; ++j) o[j] = __builtin_fminf(__builtin_fmaxf(o[j], -448.f), 448.f);
                    u32x2 w; w.x = pk4_fp8(o[0], o[1], o[2], o[3]); w.y = pk4_fp8(o[4], o[5], o[6], o[7]);
                    *(u32x2*)((unsigned char*)ACT + (size_t)drow * DM + 512 * role + 128 * pn + 32 * wc + 8 * fq) = w;
                }
            }
    }
};
struct SchedMoe2 {
    const char* ACTb; const char* W2T; const LAS int* tt; int ntiles, G, c;
    __device__ __forceinline__ bool next(int i, pg8::Unit& u) const {
        const int L = i * G + c, nwg = ntiles * 4;
        if (L >= nwg) return false;
        const int U = pg8::xcd_remap(L, nwg), T = U >> 2, pn = U & 3;
        const int list = tt[1 + T], row0 = tt[1 + MAXTILES + T];
        int ea, eb; pair_experts(list, ea, eb);
        u.A = ACTb + (size_t)T * 256 * DM; u.B0 = W2T + ((size_t)ea * 1024 + pn * 256) * DEXP; u.B1 = W2T + ((size_t)eb * 1024 + pn * 256) * DEXP - 4 * 128; u.ksplit = 4;
        u.e0 = T; u.e1 = pn; u.e2 = list; u.e3 = row0;
        return true;
    }
    template <bool GATHER> __device__ __forceinline__ void aoffs(const pg8::Unit&, const int (&sR)[2], const int (&sC)[2], int lda, unsigned (&v)[2][2]) const {
#pragma unroll
        for (int h = 0; h < 2; ++h)
#pragma unroll
            for (int i = 0; i < 2; ++i) v[h][i] = (unsigned)((sR[i] + 128 * h) * lda + sC[i]) * 2u;
    }
};
struct EpiMoe2 {
    static constexpr bool PERM = true;
    float* O; const bf16_t* X1; const int* lists; const unsigned* count; float scale; int var;
    __device__ __forceinline__ void operator()(const f32x4 (&acc)[2][2][4][2], const pg8::Unit& u, int wr, int wc, int fr, int fq) const {
        if (!MK_ONE_LAUNCH && var == 1) return;
        const int pn = u.e1, list = u.e2, row0 = u.e3;
        const int cnt = (int)count[list]; const int* lp = lists + (size_t)list * NTOK;
        const int col0 = pn * 256 + wc * 32 + 8 * fq;
        int tok[2][4];
#pragma unroll
        for (int ai = 0; ai < 2; ++ai)
#pragma unroll
            for (int m = 0; m < 4; ++m) { const int p = row0 + ai * 128 + wr * 64 + m * 16 + fr; tok[ai][m] = p < cnt ? lp[p] : -1; }
#pragma unroll
        for (int ai = 0; ai < 2; ++ai) {
            u32x4 xv[4][2];
#pragma unroll
            for (int m = 0; m < 4; ++m) { const bf16_t* rowp = X1 + (size_t)(tok[ai][m] < 0 ? 0 : tok[ai][m]) * DM + col0;
#pragma unroll
                for (int bj = 0; bj < 2; ++bj) xv[m][bj] = (!MK_ONE_LAUNCH && var == 3) ? (u32x4){0u, 0u, 0u, 0u} : *(const u32x4*)(rowp + bj * 128); }
            if (!MK_ONE_LAUNCH && var == 2) { unsigned t = 0;
#pragma unroll
                for (int m = 0; m < 4; ++m) t |= xv[m][0].x ^ xv[m][1].y ^ xv[m][0].z ^ xv[m][1].w;
                if (t == 0x12345678u) O[0] = 0.f; continue; }
#pragma unroll
            for (int m = 0; m < 4; ++m) if (tok[ai][m] >= 0) { float* rowp = O + (size_t)tok[ai][m] * DM + col0;
#pragma unroll
                for (int bj = 0; bj < 2; ++bj) { const u32x4 w = xv[m][bj];
                    const f32x4 x0 = (f32x4){__uint_as_float(w.x << 16), __uint_as_float(w.x & 0xffff0000u), __uint_as_float(w.y << 16), __uint_as_float(w.y & 0xffff0000u)};
                    const f32x4 x1v = (f32x4){__uint_as_float(w.z << 16), __uint_as_float(w.z & 0xffff0000u), __uint_as_float(w.w << 16), __uint_as_float(w.w & 0xffff0000u)};
                    *(f32x4*)(rowp + bj * 128) = x0 + acc[ai][bj][m][0] * scale; *(f32x4*)(rowp + bj * 128 + 4) = x1v + acc[ai][bj][m][1] * scale; } }
            asm volatile("" ::: "memory");
        }
    }
};


namespace att {
typedef short v4i16_t __attribute__((ext_vector_type(4)));
typedef short s16x4 __attribute__((ext_vector_type(4)));
typedef float f32x2_t __attribute__((ext_vector_type(2)));
typedef __bf16 bf16x2_t __attribute__((ext_vector_type(2)));
__device__ __forceinline__ unsigned cvtpk(float lo, float hi) { f32x2_t v = {lo, hi}; bf16x2_t b = __builtin_convertvector(v, bf16x2_t); return __builtin_bit_cast(unsigned, b); }
__device__ __forceinline__ s16x4 vtr(const LAS unsigned char* p) { return __builtin_bit_cast(s16x4, __builtin_amdgcn_ds_read_tr16_b64_v4i16((LAS v4i16_t*)p)); }
__device__ __forceinline__ constexpr int crow0(int r) { return (r & 3) + 8 * (r >> 2); }
constexpr float NEG_INF = -__builtin_huge_valf();

constexpr int L_V = 0;
constexpr int L_SO = 65536, SO_PITCH = 136;
constexpr int L_SM = L_SO + 512 * SO_PITCH;
constexpr int L_SL = L_SM + 2048;
constexpr int L_BIAS = L_SL + 2048;
constexpr int L_NATAB = L_SO;
static_assert(L_BIAS + 4096 <= LDS_BYTES - 256 && 8 * 576 * 4 <= 512 * SO_PITCH, "attention LDS map");

struct Ctx {
    int lane, q, h;
    LAS unsigned char* vl;
    unsigned vw, vr0, vr1;
    unsigned kw, kr;
};
__device__ __forceinline__ Ctx make_ctx(LAS unsigned char* lds, int wave, int lane) {
    Ctx c; c.lane = lane; c.q = lane & 31; c.h = lane >> 5; c.vl = lds + L_V + wave * 8192;
    { const int key = lane >> 3, ch = lane & 7, swz = ((key >> 1) & 1) << 2; c.vw = (unsigned)(key * 128 + ((ch ^ swz) << 4)); }
    { const int qp = (lane & 15) >> 2, p = lane & 3, sub = (lane >> 4) & 1, swz = ((qp >> 1) & 1) << 2, x = 2 * sub + (p >> 1);
      c.vr0 = (unsigned)((4 * c.h + qp) * 128 + (((0 ^ swz) + x) << 4) + (p & 1) * 8);
      c.vr1 = (unsigned)((4 * c.h + qp) * 128 + (((4 ^ swz) + x) << 4) + (p & 1) * 8); }
    c.kw = (unsigned)((lane >> 3) * 128);
    c.kr = (unsigned)((lane & 31) * 128);
    return c;
}

template <class Spec>
__device__ __forceinline__ void tile_core(const Spec& sp, const Ctx& c, int t, const LAS unsigned char* vt, const LAS unsigned char* kt, const bf16x8 (&qf)[4], float& m, float& l, f32x16& o0, f32x16& o1);
template <bool LOAD, class Spec>
__device__ __forceinline__ void tile_step(const Spec& sp, const Ctx& c, int t, int tnext, u32x4 (&kreg)[4], u32x4 (&vreg)[4], const bf16x8 (&qf)[4], float& m, float& l, f32x16& o0, f32x16& o1) {
    const int key_lo = c.lane >> 3, chn = c.lane & 7;
#pragma unroll
    for (int i = 0; i < 4; ++i) {
        *(LAS u32x4*)(c.vl + c.vw + i * 1024) = vreg[i];
        const int ksw = ((key_lo >> 1) + 4 * i) & 7;
        *(LAS u32x4*)(c.vl + 4096 + c.kw + i * 1024 + ((chn ^ ksw) << 4)) = kreg[i];
    }
    if constexpr (LOAD) { sp.loadKV(tnext, kreg, vreg); __builtin_amdgcn_sched_barrier(0); }
    tile_core(sp, c, t, c.vl, c.vl + 4096, qf, m, l, o0, o1);
}
template <class Spec>
__device__ __forceinline__ void tile_core(const Spec& sp, const Ctx& c, int t, const LAS unsigned char* vt, const LAS unsigned char* kt, const bf16x8 (&qf)[4], float& m, float& l, f32x16& o0, f32x16& o1) {
    bf16x8 kf[4];
    { const int ksw = ((c.lane & 31) >> 1) & 7;
#pragma unroll
      for (int ks = 0; ks < 4; ++ks) kf[ks] = *(const LAS bf16x8*)(kt + c.kr + (((2 * ks + c.h) ^ ksw) << 4)); }
    f32x16 s;
#pragma unroll
    for (int r = 0; r < 16; ++r) s[r] = 0.f;
#pragma unroll
    for (int ks = 0; ks < 4; ++ks) s = __builtin_amdgcn_mfma_f32_32x32x16_bf16(kf[ks], qf[ks], s, 0, 0, 0);
    sp.bias(t, s);
    float mx = s[0];
#pragma unroll
    for (int r = 1; r < 16; ++r) mx = fmaxf(mx, s[r]);
    { auto rr = __builtin_amdgcn_permlane32_swap(__float_as_uint(mx), __float_as_uint(mx), false, false); mx = fmaxf(__uint_as_float(rr[0]), __uint_as_float(rr[1])); }
    const float mn = fmaxf(m, mx);
    if (__any(mn > m)) {
        const float al = __builtin_amdgcn_exp2f(m - mn);
        l *= al;
#pragma unroll
        for (int r = 0; r < 16; ++r) { o0[r] *= al; o1[r] *= al; }
        m = mn;
    }
    float ps = 0.f;
#pragma unroll
    for (int r = 0; r < 16; ++r) { s[r] = __builtin_amdgcn_exp2f(s[r] - m); ps += s[r]; }
    l += ps;
    bf16x8 pf[2];
#pragma unroll
    for (int s2 = 0; s2 < 2; ++s2) { u32x4 w; w.x = cvtpk(s[8 * s2 + 0], s[8 * s2 + 1]); w.y = cvtpk(s[8 * s2 + 2], s[8 * s2 + 3]); w.z = cvtpk(s[8 * s2 + 4], s[8 * s2 + 5]); w.w = cvtpk(s[8 * s2 + 6], s[8 * s2 + 7]); pf[s2] = __builtin_bit_cast(bf16x8, w); }
#pragma unroll
    for (int s2 = 0; s2 < 2; ++s2) {
        const s16x4 a0 = vtr(vt + c.vr0 + s2 * 2048), a1 = vtr(vt + c.vr0 + s2 * 2048 + 1024);
        const s16x4 b0 = vtr(vt + c.vr1 + s2 * 2048), b1 = vtr(vt + c.vr1 + s2 * 2048 + 1024);
        const bf16x8 v0 = (bf16x8){a0[0], a0[1], a0[2], a0[3], a1[0], a1[1], a1[2], a1[3]};
        const bf16x8 v1 = (bf16x8){b0[0], b0[1], b0[2], b0[3], b1[0], b1[1], b1[2], b1[3]};
        o0 = __builtin_amdgcn_mfma_f32_32x32x16_bf16(v0, pf[s2], o0, 0, 0, 0);
        o1 = __builtin_amdgcn_mfma_f32_32x32x16_bf16(v1, pf[s2], o1, 0, 0, 0);
    }
}

struct QState { float m, l; f32x16 o0, o1; };
__device__ __forceinline__ void softmax_tile(f32x16& s, QState& st, bf16x8 (&pf)[2]) {
    float mx = s[0];
#pragma unroll
    for (int r = 1; r < 16; ++r) mx = fmaxf(mx, s[r]);
    { auto rr = __builtin_amdgcn_permlane32_swap(__float_as_uint(mx), __float_as_uint(mx), false, false); mx = fmaxf(__uint_as_float(rr[0]), __uint_as_float(rr[1])); }
    const float mn = fmaxf(st.m, mx);
    if (__any(mn > st.m)) {
        const float al = __builtin_amdgcn_exp2f(st.m - mn);
        st.l *= al;
#pragma unroll
        for (int r = 0; r < 16; ++r) { st.o0[r] *= al; st.o1[r] *= al; }
        st.m = mn;
    }
    float ps = 0.f;
#pragma unroll
    for (int r = 0; r < 16; ++r) { s[r] = __builtin_amdgcn_exp2f(s[r] - st.m); ps += s[r]; }
    st.l += ps;
#pragma unroll
    for (int s2 = 0; s2 < 2; ++s2) { u32x4 w; w.x = cvtpk(s[8 * s2 + 0], s[8 * s2 + 1]); w.y = cvtpk(s[8 * s2 + 2], s[8 * s2 + 3]); w.z = cvtpk(s[8 * s2 + 4], s[8 * s2 + 5]); w.w = cvtpk(s[8 * s2 + 6], s[8 * s2 + 7]); pf[s2] = __builtin_bit_cast(bf16x8, w); }
}
__device__ __forceinline__ void tile_core2(const Ctx& c, const LAS unsigned char* vt, const LAS unsigned char* kt, const bf16x8 (&qa)[4], const bf16x8 (&qb)[4], QState& A, QState& B) {
    bf16x8 kf[4];
    { const int ksw = ((c.lane & 31) >> 1) & 7;
#pragma unroll
      for (int ks = 0; ks < 4; ++ks) kf[ks] = *(const LAS bf16x8*)(kt + c.kr + (((2 * ks + c.h) ^ ksw) << 4)); }
    f32x16 sa, sb;
#pragma unroll
    for (int r = 0; r < 16; ++r) { sa[r] = 0.f; sb[r] = 0.f; }
#pragma unroll
    for (int ks = 0; ks < 4; ++ks) { sa = __builtin_amdgcn_mfma_f32_32x32x16_bf16(kf[ks], qa[ks], sa, 0, 0, 0); sb = __builtin_amdgcn_mfma_f32_32x32x16_bf16(kf[ks], qb[ks], sb, 0, 0, 0); }
    bf16x8 pa[2], pb[2];
    softmax_tile(sa, A, pa); softmax_tile(sb, B, pb);
#pragma unroll
    for (int s2 = 0; s2 < 2; ++s2) {
        const s16x4 a0 = vtr(vt + c.vr0 + s2 * 2048), a1 = vtr(vt + c.vr0 + s2 * 2048 + 1024);
        const s16x4 b0 = vtr(vt + c.vr1 + s2 * 2048), b1 = vtr(vt + c.vr1 + s2 * 2048 + 1024);
        const bf16x8 v0 = (bf16x8){a0[0], a0[1], a0[2], a0[3], a1[0], a1[1], a1[2], a1[3]};
        const bf16x8 v1 = (bf16x8){b0[0], b0[1], b0[2], b0[3], b1[0], b1[1], b1[2], b1[3]};
        A.o0 = __builtin_amdgcn_mfma_f32_32x32x16_bf16(v0, pa[s2], A.o0, 0, 0, 0); A.o1 = __builtin_amdgcn_mfma_f32_32x32x16_bf16(v1, pa[s2], A.o1, 0, 0, 0);
        B.o0 = __builtin_amdgcn_mfma_f32_32x32x16_bf16(v0, pb[s2], B.o0, 0, 0, 0); B.o1 = __builtin_amdgcn_mfma_f32_32x32x16_bf16(v1, pb[s2], B.o1, 0, 0, 0);
    }
}

__device__ __forceinline__ void dma16(__amdgpu_buffer_rsrc_t rs, LAS unsigned char* dst, int vo, int so) { __builtin_amdgcn_raw_ptr_buffer_load_lds(rs, (LAS void*)dst, 16, vo, so, 0, 0); }
__device__ __forceinline__ unsigned lds_u32(const LAS unsigned char* p) { return (unsigned)(uintptr_t)p; }
template <class Spec>
__device__ __forceinline__ void run_dma(const Spec& sp, const Ctx& c, const bf16x8 (&qf)[4], float& m, float& l, f32x16& o0, f32x16& o1) {
    constexpr int NT = Spec::NT;
    LAS unsigned char* vt = c.vl; LAS unsigned char* kt = c.vl + 4096;
    unsigned ka[4];
    { const int ksw = ((c.lane & 31) >> 1) & 7;
#pragma unroll
      for (int ks = 0; ks < 4; ++ks) ka[ks] = lds_u32(kt) + c.kr + (((2 * ks + c.h) ^ ksw) << 4); }
    const unsigned va0 = lds_u32(vt) + c.vr0, va1 = lds_u32(vt) + c.vr1;
    asm volatile("s_waitcnt vmcnt(0) lgkmcnt(0)" ::: "memory");
    sp.dmaK(0, kt); sp.dmaV(0, vt);
    __builtin_amdgcn_sched_barrier(0);
#pragma unroll 1
    for (int t = 0; t < NT; ++t) {
        const bool more = t + 1 < NT;
        asm volatile("s_waitcnt vmcnt(4)" ::: "memory");
        bf16x8 kf0, kf1, kf2, kf3;
        asm volatile("ds_read_b128 %0, %1" : "=v"(kf0) : "v"(ka[0]) : "memory");
        asm volatile("ds_read_b128 %0, %1" : "=v"(kf1) : "v"(ka[1]) : "memory");
        asm volatile("ds_read_b128 %0, %1" : "=v"(kf2) : "v"(ka[2]) : "memory");
        asm volatile("ds_read_b128 %0, %1" : "=v"(kf3) : "v"(ka[3]) : "memory");
        asm volatile("s_waitcnt lgkmcnt(0)" : "+v"(kf0), "+v"(kf1), "+v"(kf2), "+v"(kf3) :: "memory");
        __builtin_amdgcn_sched_barrier(0);
        if (more) sp.dmaK(t + 1, kt);
        __builtin_amdgcn_sched_barrier(0);
        f32x16 s;
#pragma unroll
        for (int r = 0; r < 16; ++r) s[r] = 0.f;
        s = __builtin_amdgcn_mfma_f32_32x32x16_bf16(kf0, qf[0], s, 0, 0, 0); s = __builtin_amdgcn_mfma_f32_32x32x16_bf16(kf1, qf[1], s, 0, 0, 0);
        s = __builtin_amdgcn_mfma_f32_32x32x16_bf16(kf2, qf[2], s, 0, 0, 0); s = __builtin_amdgcn_mfma_f32_32x32x16_bf16(kf3, qf[3], s, 0, 0, 0);
        sp.bias(t, s);
        QState st; bf16x8 pf[2];
        st.m = m; st.l = l; st.o0 = o0; st.o1 = o1;
        softmax_tile(s, st, pf);
        m = st.m; l = st.l; o0 = st.o0; o1 = st.o1;
        __builtin_amdgcn_sched_barrier(0);
        if (more) asm volatile("s_waitcnt vmcnt(4)" ::: "memory"); else asm volatile("s_waitcnt vmcnt(0)" ::: "memory");
        s16x4 a0, a1, a2, a3, b0, b1, b2, b3;
        asm volatile("ds_read_b64_tr_b16 %0, %1" : "=v"(a0) : "v"(va0) : "memory");
        asm volatile("ds_read_b64_tr_b16 %0, %1 offset:1024" : "=v"(a1) : "v"(va0) : "memory");
        asm volatile("ds_read_b64_tr_b16 %0, %1 offset:2048" : "=v"(a2) : "v"(va0) : "memory");
        asm volatile("ds_read_b64_tr_b16 %0, %1 offset:3072" : "=v"(a3) : "v"(va0) : "memory");
        asm volatile("ds_read_b64_tr_b16 %0, %1" : "=v"(b0) : "v"(va1) : "memory");
        asm volatile("ds_read_b64_tr_b16 %0, %1 offset:1024" : "=v"(b1) : "v"(va1) : "memory");
        asm volatile("ds_read_b64_tr_b16 %0, %1 offset:2048" : "=v"(b2) : "v"(va1) : "memory");
        asm volatile("ds_read_b64_tr_b16 %0, %1 offset:3072" : "=v"(b3) : "v"(va1) : "memory");
        asm volatile("s_waitcnt lgkmcnt(0)" : "+v"(a0), "+v"(a1), "+v"(a2), "+v"(a3), "+v"(b0), "+v"(b1), "+v"(b2), "+v"(b3) :: "memory");
        __builtin_amdgcn_sched_barrier(0);
        if (more) sp.dmaV(t + 1, vt);
        __builtin_amdgcn_sched_barrier(0);
        const bf16x8 v00 = (bf16x8){a0[0], a0[1], a0[2], a0[3], a1[0], a1[1], a1[2], a1[3]}, v01 = (bf16x8){a2[0], a2[1], a2[2], a2[3], a3[0], a3[1], a3[2], a3[3]};
        const bf16x8 v10 = (bf16x8){b0[0], b0[1], b0[2], b0[3], b1[0], b1[1], b1[2], b1[3]}, v11 = (bf16x8){b2[0], b2[1], b2[2], b2[3], b3[0], b3[1], b3[2], b3[3]};
        o0 = __builtin_amdgcn_mfma_f32_32x32x16_bf16(v00, pf[0], o0, 0, 0, 0); o1 = __builtin_amdgcn_mfma_f32_32x32x16_bf16(v10, pf[0], o1, 0, 0, 0);
        o0 = __builtin_amdgcn_mfma_f32_32x32x16_bf16(v01, pf[1], o0, 0, 0, 0); o1 = __builtin_amdgcn_mfma_f32_32x32x16_bf16(v11, pf[1], o1, 0, 0, 0);
    }
}

__device__ __forceinline__ void load_q_asm(const unsigned char* qrow, int h, bf16x8& q0, bf16x8& q1, bf16x8& q2, bf16x8& q3) {
    const unsigned char* p = qrow + 16 * h;
    asm volatile("global_load_dwordx4 %0, %1, off" : "=v"(q0) : "v"(p) : "memory");
    asm volatile("global_load_dwordx4 %0, %1, off offset:32" : "=v"(q1) : "v"(p) : "memory");
    asm volatile("global_load_dwordx4 %0, %1, off offset:64" : "=v"(q2) : "v"(p) : "memory");
    asm volatile("global_load_dwordx4 %0, %1, off offset:96" : "=v"(q3) : "v"(p) : "memory");
}
template <class Spec>
__device__ __forceinline__ void run_dma_x(const Spec& sp, const Ctx& c, bf16x8& q0, bf16x8& q1, bf16x8& q2, bf16x8& q3, QState& st,
                                          bool first, bool hn, __amdgpu_buffer_rsrc_t rsn, int rw0n, const unsigned char* qrow_n) {
    constexpr int NT = Spec::NT;
    LAS unsigned char* vt = c.vl; LAS unsigned char* kt = c.vl + 4096;
    unsigned ka[4];
    { const int ksw = ((c.lane & 31) >> 1) & 7;
#pragma unroll
      for (int ks = 0; ks < 4; ++ks) ka[ks] = lds_u32(kt) + c.kr + (((2 * ks + c.h) ^ ksw) << 4); }
    const unsigned va0 = lds_u32(vt) + c.vr0, va1 = lds_u32(vt) + c.vr1;
#pragma unroll 1
    for (int t = 0; t < NT; ++t) {
        const bool lastt = t + 1 == NT;
        if (t == 0 && !first) asm volatile("s_waitcnt vmcnt(6)" ::: "memory"); else asm volatile("s_waitcnt vmcnt(4)" ::: "memory");
        bf16x8 kf0, kf1, kf2, kf3;
        asm volatile("ds_read_b128 %0, %1" : "=v"(kf0) : "v"(ka[0]) : "memory");
        asm volatile("ds_read_b128 %0, %1" : "=v"(kf1) : "v"(ka[1]) : "memory");
        asm volatile("ds_read_b128 %0, %1" : "=v"(kf2) : "v"(ka[2]) : "memory");
        asm volatile("ds_read_b128 %0, %1" : "=v"(kf3) : "v"(ka[3]) : "memory");
        asm volatile("s_waitcnt lgkmcnt(0)" : "+v"(kf0), "+v"(kf1), "+v"(kf2), "+v"(kf3) :: "memory");
        __builtin_amdgcn_sched_barrier(0);
        if (!lastt) sp.dmaK(t + 1, kt);
        __builtin_amdgcn_sched_barrier(0);
        f32x16 s;
#pragma unroll
        for (int r = 0; r < 16; ++r) s[r] = 0.f;
        s = __builtin_amdgcn_mfma_f32_32x32x16_bf16(kf0, q0, s, 0, 0, 0); s = __builtin_amdgcn_mfma_f32_32x32x16_bf16(kf1, q1, s, 0, 0, 0);
        s = __builtin_amdgcn_mfma_f32_32x32x16_bf16(kf2, q2, s, 0, 0, 0); s = __builtin_amdgcn_mfma_f32_32x32x16_bf16(kf3, q3, s, 0, 0, 0);
        if (lastt && hn) {
            __builtin_amdgcn_sched_barrier(0);
            load_q_asm(qrow_n, c.h, q0, q1, q2, q3); sp.dmaK_n(rsn, rw0n, kt);
            __builtin_amdgcn_sched_barrier(0);
        }
        sp.bias(t, s);
        bf16x8 pf[2];
        softmax_tile(s, st, pf);
        __builtin_amdgcn_sched_barrier(0);
        if (t == 0 && !first) asm volatile("s_waitcnt vmcnt(6)" ::: "memory");
        else if (lastt) { if (hn) asm volatile("s_waitcnt vmcnt(8)" ::: "memory"); else asm volatile("s_waitcnt vmcnt(0)" ::: "memory"); }
        else asm volatile("s_waitcnt vmcnt(4)" ::: "memory");
        s16x4 a0, a1, a2, a3, b0, b1, b2, b3;
        asm volatile("ds_read_b64_tr_b16 %0, %1" : "=v"(a0) : "v"(va0) : "memory");
        asm volatile("ds_read_b64_tr_b16 %0, %1 offset:1024" : "=v"(a1) : "v"(va0) : "memory");
        asm volatile("ds_read_b64_tr_b16 %0, %1 offset:2048" : "=v"(a2) : "v"(va0) : "memory");
        asm volatile("ds_read_b64_tr_b16 %0, %1 offset:3072" : "=v"(a3) : "v"(va0) : "memory");
        asm volatile("ds_read_b64_tr_b16 %0, %1" : "=v"(b0) : "v"(va1) : "memory");
        asm volatile("ds_read_b64_tr_b16 %0, %1 offset:1024" : "=v"(b1) : "v"(va1) : "memory");
        asm volatile("ds_read_b64_tr_b16 %0, %1 offset:2048" : "=v"(b2) : "v"(va1) : "memory");
        asm volatile("ds_read_b64_tr_b16 %0, %1 offset:3072" : "=v"(b3) : "v"(va1) : "memory");
        asm volatile("s_waitcnt lgkmcnt(0)" : "+v"(a0), "+v"(a1), "+v"(a2), "+v"(a3), "+v"(b0), "+v"(b1), "+v"(b2), "+v"(b3) :: "memory");
        __builtin_amdgcn_sched_barrier(0);
        if (!lastt) sp.dmaV(t + 1, vt); else if (hn) sp.dmaV_n(rsn, rw0n, vt);
        __builtin_amdgcn_sched_barrier(0);
        const bf16x8 v00 = (bf16x8){a0[0], a0[1], a0[2], a0[3], a1[0], a1[1], a1[2], a1[3]}, v01 = (bf16x8){a2[0], a2[1], a2[2], a2[3], a3[0], a3[1], a3[2], a3[3]};
        const bf16x8 v10 = (bf16x8){b0[0], b0[1], b0[2], b0[3], b1[0], b1[1], b1[2], b1[3]}, v11 = (bf16x8){b2[0], b2[1], b2[2], b2[3], b3[0], b3[1], b3[2], b3[3]};
        st.o0 = __builtin_amdgcn_mfma_f32_32x32x16_bf16(v00, pf[0], st.o0, 0, 0, 0); st.o1 = __builtin_amdgcn_mfma_f32_32x32x16_bf16(v10, pf[0], st.o1, 0, 0, 0);
        st.o0 = __builtin_amdgcn_mfma_f32_32x32x16_bf16(v01, pf[1], st.o0, 0, 0, 0); st.o1 = __builtin_amdgcn_mfma_f32_32x32x16_bf16(v11, pf[1], st.o1, 0, 0, 0);
    }
}
template <class Spec>
__device__ __forceinline__ void run(const Spec& sp, const Ctx& c, const bf16x8 (&qf)[4], float& m, float& l, f32x16& o0, f32x16& o1) {
    constexpr int NT = Spec::NT;
    static_assert(NT >= 4, "tile loop is peeled for NT >= 4");
    u32x4 kA[4], vA[4], kB[4], vB[4];
    sp.loadKV(0, kA, vA); sp.loadKV(1, kB, vB);
    int t = 0;
#pragma unroll 1
    for (; t + 3 < NT; t += 2) {
        tile_step<true>(sp, c, t, t + 2, kA, vA, qf, m, l, o0, o1);
        tile_step<true>(sp, c, t + 1, t + 3, kB, vB, qf, m, l, o0, o1);
    }
    if constexpr ((NT & 1) == 0) {
        tile_step<false>(sp, c, NT - 2, 0, kA, vA, qf, m, l, o0, o1);
        tile_step<false>(sp, c, NT - 1, 0, kB, vB, qf, m, l, o0, o1);
    } else {
        tile_step<true>(sp, c, NT - 3, NT - 1, kA, vA, qf, m, l, o0, o1);
        tile_step<false>(sp, c, NT - 2, 0, kB, vB, qf, m, l, o0, o1);
        tile_step<false>(sp, c, NT - 1, 0, kA, vA, qf, m, l, o0, o1);
    }
}
__device__ __forceinline__ float pair_sum(float v) { auto rr = __builtin_amdgcn_permlane32_swap(__float_as_uint(v), __float_as_uint(v), false, false); return __uint_as_float(rr[0]) + __uint_as_float(rr[1]); }
template <class P> __device__ __forceinline__ void store_o(P rowp, const f32x16& o0, const f32x16& o1, float inv, int h) {
#pragma unroll
    for (int g4 = 0; g4 < 4; ++g4) {
        u32x2 w0, w1; w0.x = cvtpk(o0[4 * g4] * inv, o0[4 * g4 + 1] * inv); w0.y = cvtpk(o0[4 * g4 + 2] * inv, o0[4 * g4 + 3] * inv);
        w1.x = cvtpk(o1[4 * g4] * inv, o1[4 * g4 + 1] * inv); w1.y = cvtpk(o1[4 * g4 + 2] * inv, o1[4 * g4 + 3] * inv);
        *(u32x2*)(rowp + (8 * g4 + 4 * h) * 2) = w0; *(u32x2*)(rowp + (32 + 8 * g4 + 4 * h) * 2) = w1;
    }
}
__device__ __forceinline__ void store_o8(unsigned char* rowp, const f32x16& o0, const f32x16& o1, float inv, int h) {
    const float sc = inv * SC_MIX;
    unsigned w[8];
#pragma unroll
    for (int g4 = 0; g4 < 4; ++g4) {
        const unsigned a = pk4_fp8(o0[4 * g4] * sc, o0[4 * g4 + 1] * sc, o0[4 * g4 + 2] * sc, o0[4 * g4 + 3] * sc);
        const unsigned b = pk4_fp8(o1[4 * g4] * sc, o1[4 * g4 + 1] * sc, o1[4 * g4 + 2] * sc, o1[4 * g4 + 3] * sc);
        auto rr = __builtin_amdgcn_permlane32_swap(a, b, false, false);
        w[2 * g4] = rr[0]; w[2 * g4 + 1] = rr[1];
    }
    *(u32x4*)(rowp + 32 * h) = (u32x4){w[0], w[1], w[2], w[3]}; *(u32x4*)(rowp + 32 * h + 16) = (u32x4){w[4], w[5], w[6], w[7]};
}
__device__ __forceinline__ void load_q(const unsigned char* qrow, int h, bf16x8 (&qf)[4]) {
#pragma unroll
    for (int ks = 0; ks < 4; ++ks) qf[ks] = *(const bf16x8*)(qrow + (16 * ks + 8 * h) * 2);
}

__device__ __forceinline__ u32x4 bload(__amdgpu_buffer_rsrc_t rs, int vo, int so) { return __builtin_amdgcn_raw_buffer_load_b128(rs, vo, so, 0); }
constexpr int NA_NEGIDX = 544;
struct SpecNA {
    static constexpr int NT = 9;
    __amdgpu_buffer_rsrc_t rs; int vo[4]; int rw0, kcolK, kcolV;
    int qr, r0q, bidx; const LAS float* btab; f32x16 madd;
    int dk0, dk1, dv0;
    __device__ __forceinline__ void dmaK(int t, LAS unsigned char* kt) const { int row = rw0 + t; row = row > GRID_R - 1 ? GRID_R - 1 : row; const int so = row * (GRID_W * 128) + kcolK;
        dma16(rs, kt, dk0, so); dma16(rs, kt + 1024, dk1, so + 1024); dma16(rs, kt + 2048, dk0, so + 2048); dma16(rs, kt + 3072, dk1, so + 3072); }
    __device__ __forceinline__ void dmaV(int t, LAS unsigned char* vt) const { int row = rw0 + t; row = row > GRID_R - 1 ? GRID_R - 1 : row; const int so = row * (GRID_W * 128) + kcolV;
        dma16(rs, vt, dv0, so); dma16(rs, vt + 1024, dv0, so + 1024); dma16(rs, vt + 2048, dv0, so + 2048); dma16(rs, vt + 3072, dv0, so + 3072); }
    __device__ __forceinline__ void dmaK_n(__amdgpu_buffer_rsrc_t rsn, int rw0n, LAS unsigned char* kt) const { const int so = rw0n * (GRID_W * 128) + kcolK;
        dma16(rsn, kt, dk0, so); dma16(rsn, kt + 1024, dk1, so + 1024); dma16(rsn, kt + 2048, dk0, so + 2048); dma16(rsn, kt + 3072, dk1, so + 3072); }
    __device__ __forceinline__ void dmaV_n(__amdgpu_buffer_rsrc_t rsn, int rw0n, LAS unsigned char* vt) const { const int so = rw0n * (GRID_W * 128) + kcolV;
        dma16(rsn, vt, dv0, so); dma16(rsn, vt + 1024, dv0, so + 1024); dma16(rsn, vt + 2048, dv0, so + 2048); dma16(rsn, vt + 3072, dv0, so + 3072); }
    __device__ __forceinline__ void loadKV(int t, u32x4 (&kr)[4], u32x4 (&vr)[4]) const {
        int row = rw0 + t; row = row > GRID_R - 1 ? GRID_R - 1 : row; const int so = row * (GRID_W * 128);
#pragma unroll
        for (int i = 0; i < 4; ++i) { kr[i] = bload(rs, vo[i], so + kcolK); vr[i] = bload(rs, vo[i], so + kcolV); } }
    __device__ __forceinline__ void bias(int t, f32x16& s) const {
        const int row = rw0 + t; const bool rv = (unsigned)(row - r0q) < 8u;
        const int idx = rv ? bidx + (row - qr + 7) * 31 : NA_NEGIDX;
        float bv[16];
#pragma unroll
        for (int rg = 0; rg < 16; ++rg) bv[rg] = btab[idx + crow0(rg)];
#pragma unroll
        for (int rg = 0; rg < 16; ++rg) asm volatile("" : "+v"(bv[rg]));
#pragma unroll
        for (int rg = 0; rg < 16; ++rg) s[rg] = (s[rg] + bv[rg]) + madd[rg];
    }
};
struct SpecDil {
    static constexpr int NT = 5;
    __amdgpu_buffer_rsrc_t rs; int pi[4]; int cb, kcolK, kcolV;
    int pos0, dil, q, h; const LAS float* btab;
    int ck0, ck1, cv0;
    __device__ __forceinline__ int cl(int p) const { return p < 0 ? 0 : (p > SEQ - 1 ? SEQ - 1 : p); }
    __device__ __forceinline__ void dmaK(int t, LAS unsigned char* kt) const { const int d = 32 * dil * t;
        dma16(rs, kt, cl(pi[0] + d) * 128 + ck0, kcolK); dma16(rs, kt + 1024, cl(pi[1] + d) * 128 + ck1, kcolK); dma16(rs, kt + 2048, cl(pi[2] + d) * 128 + ck0, kcolK); dma16(rs, kt + 3072, cl(pi[3] + d) * 128 + ck1, kcolK); }
    __device__ __forceinline__ void dmaV(int t, LAS unsigned char* vt) const { const int d = 32 * dil * t;
        dma16(rs, vt, cl(pi[0] + d) * 128 + cv0, kcolV); dma16(rs, vt + 1024, cl(pi[1] + d) * 128 + cv0, kcolV); dma16(rs, vt + 2048, cl(pi[2] + d) * 128 + cv0, kcolV); dma16(rs, vt + 3072, cl(pi[3] + d) * 128 + cv0, kcolV); }
    __device__ __forceinline__ void loadKV(int t, u32x4 (&kr)[4], u32x4 (&vr)[4]) const {
#pragma unroll
        for (int i = 0; i < 4; ++i) { int p = pi[i] + 32 * dil * t; p = p < 0 ? 0 : (p > SEQ - 1 ? SEQ - 1 : p); const int vo = p * 128 + cb; kr[i] = bload(rs, vo, kcolK); vr[i] = bload(rs, vo, kcolV); } }
    __device__ __forceinline__ void bias(int t, f32x16& s) const {
        const int idx = 32 + 32 * t + 4 * h - q;
        float bv[16];
#pragma unroll
        for (int rg = 0; rg < 16; ++rg) bv[rg] = btab[idx + crow0(rg)];
#pragma unroll
        for (int rg = 0; rg < 16; ++rg) asm volatile("" : "+v"(bv[rg]));
#pragma unroll
        for (int rg = 0; rg < 16; ++rg) s[rg] += bv[rg];
        const int lo = pos0 + dil * (-64 + 32 * t);
        if (lo < 0 || lo + 31 * dil >= SEQ) {
            const int pb = lo + dil * 4 * h;
#pragma unroll
            for (int rg = 0; rg < 16; ++rg) { const int pk = pb + dil * crow0(rg); s[rg] = ((unsigned)pk < (unsigned)SEQ) ? s[rg] : NEG_INF; }
        }
    }
};
struct SpecMem {
    static constexpr int NT = 8;
    __amdgpu_buffer_rsrc_t rs; int vo[4];
    __device__ __forceinline__ void loadKV(int t, u32x4 (&kr)[4], u32x4 (&vr)[4]) const {
        const int so = t * 32 * 128;
#pragma unroll
        for (int i = 0; i < 4; ++i) { kr[i] = bload(rs, vo[i], so); vr[i] = bload(rs, vo[i], so + 4 * BATCH * MEM_LEN * 128); } }
    __device__ __forceinline__ void bias(int, f32x16&) const {}
};

__device__ __forceinline__ void phase2(const MArgs& a, LAS unsigned char* lds, int vcu, int G) {
    const int tid = threadIdx.x, lane = tid & 63, wave = __builtin_amdgcn_readfirstlane(tid >> 6);
    const Ctx c = make_ctx(lds, wave, lane);
    const unsigned char* QKV = a.ws + WS_QKV; const unsigned char* KVM = a.ws + WS_KVM; unsigned char* MIX = a.ws + WS_MIX;
    const float* rpb = (const float*)(a.ws + WS_RPB); const float* biasD = (const float*)(a.ws + WS_BIASD);
    LAS float* lb = (LAS float*)(lds + L_BIAS);
    const int key_lo = lane >> 3, chunk16 = (lane & 7) * 16;
    const int parts = (!MK_ONE_LAUNCH && a.ph_lo >= 20) ? 1 << (a.ph_lo - 20) : 7;
    if (parts & 1) { LAS float* nt = (LAS float*)(lds + L_NATAB);
      __syncthreads();
      for (int i = tid; i < 8 * 576; i += NTHREADS) { const int hd = i / 576, j = i - 576 * hd; nt[i] = (j >= 32 && j < 32 + 465) ? rpb[hd * 465 + j - 32] : (j >= NA_NEGIDX ? NEG_INF : 0.f); }
      __syncthreads(); }
    if (parts & 1) {
        constexpr int NU = BATCH * NA_HEADS * (GRID_R / 4);
        const int I_ = wave & 3, cq_ = 16 * I_ + (c.q & 15);
        const int sc_ = 16 * I_ - 8 < 0 ? 0 : (16 * I_ - 8 > 32 ? 32 : 16 * I_ - 8); const int c0_ = cq_ - 8 < 0 ? 0 : (cq_ - 8 > GRID_W - 16 ? GRID_W - 16 : cq_ - 8);
        SpecNA sp;
        { const int chn_ = lane & 7, g16_ = lane >> 4; sp.dk0 = (sc_ + key_lo) * 128 + ((chn_ ^ (g16_ & 7)) << 4); sp.dk1 = (sc_ + key_lo) * 128 + ((chn_ ^ ((g16_ + 4) & 7)) << 4); sp.dv0 = (sc_ + key_lo) * 128 + ((chn_ ^ ((g16_ & 1) << 2)) << 4); }
        sp.kcolK = 0; sp.kcolV = ((C_VA - C_KA) / 64) * NTOK * 128; sp.bidx = 32 + (sc_ - cq_ + 15) + 4 * c.h;
#pragma unroll
        for (int r2 = 0; r2 < 16; ++r2) sp.madd[r2] = ((unsigned)(sc_ + crow0(r2) + 4 * c.h - c0_) < 16u) ? 0.f : NEG_INF;
#define NA_UNIT(u_, RS, RW0, QR, TQ, HEAD) do { const int rg_ = (u_) & 31, head_ = ((u_) >> 5) & 7, b_ = (u_) >> 8; const int rp_ = 2 * rg_ + (wave >> 2); \
            RS = __builtin_amdgcn_make_buffer_rsrc((void*)(QKV + ((size_t)(C_KA / 64 + head_) * NTOK + (size_t)b_ * SEQ) * 128), 0, 0x7fffffff, 0x00020000); \
            RW0 = 2 * rp_ - 4 < 0 ? 0 : (2 * rp_ - 4 > GRID_R - 8 ? GRID_R - 8 : 2 * rp_ - 4); QR = 2 * rp_ + (c.q >> 4); TQ = b_ * SEQ + QR * GRID_W + cq_; HEAD = head_; } while (0)
        int u = vcu; bool have = u < NU, first = true;
        int tq = 0, head = 0, qr = 0, rw0 = 0; __amdgpu_buffer_rsrc_t rs = __builtin_amdgcn_make_buffer_rsrc((void*)QKV, 0, 0x7fffffff, 0x00020000);
        bf16x8 q0, q1, q2, q3;
        if (have) {
            NA_UNIT(u, rs, rw0, qr, tq, head);
            sp.rs = rs; sp.rw0 = rw0;
            asm volatile("s_waitcnt vmcnt(0) lgkmcnt(0)" ::: "memory");
            load_q_asm(QKV + ((size_t)(C_QA / 64 + head) * NTOK + tq) * 128, c.h, q0, q1, q2, q3);
            sp.dmaK(0, c.vl + 4096); sp.dmaV(0, c.vl);
            asm volatile("s_waitcnt vmcnt(8)" : "+v"(q0), "+v"(q1), "+v"(q2), "+v"(q3) :: "memory");
            __builtin_amdgcn_sched_barrier(0);
        }
        while (have) {
            __builtin_amdgcn_s_barrier();
            const int un = u + G; const bool hn = un < NU;
            int tqn = tq, headn = head, qrn = qr, rw0n = rw0; __amdgpu_buffer_rsrc_t rsn = rs;
            if (hn) NA_UNIT(un, rsn, rw0n, qrn, tqn, headn);
            sp.rs = rs; sp.rw0 = rw0; sp.qr = qr; sp.r0q = qr - 4 < 0 ? 0 : (qr - 4 > GRID_R - 8 ? GRID_R - 8 : qr - 4); sp.btab = (const LAS float*)(lds + L_NATAB) + head * 576;
            QState st; st.m = -1e30f; st.l = 0.f;
#pragma unroll
            for (int i = 0; i < 16; ++i) { st.o0[i] = 0.f; st.o1[i] = 0.f; }
            run_dma_x(sp, c, q0, q1, q2, q3, st, first, hn, rsn, rw0n, QKV + ((size_t)(C_QA / 64 + headn) * NTOK + tqn) * 128);
            const float inv = 1.f / pair_sum(st.l);
            store_o8(MIX + (size_t)tq * DM + head * 64, st.o0, st.o1, inv, c.h);
            if (hn) { asm volatile("s_waitcnt vmcnt(10)" : "+v"(q0), "+v"(q1), "+v"(q2), "+v"(q3) :: "memory");
                      __builtin_amdgcn_sched_barrier(0); }
            rs = rsn; rw0 = rw0n; qr = qrn; tq = tqn; head = headn; u = un; have = hn; first = false;
        }
#undef NA_UNIT
        asm volatile("s_waitcnt vmcnt(0)" ::: "memory");
    }
    if (parts & 2) {
        struct NoBias { __device__ __forceinline__ void bias(int, f32x16&) const {} } nb;
        const int nqb = SEQ / 256;
        for (int u = vcu; u < BATCH * MEM_HEADS * 8; u += G) {
            const int pair = u >> 3, head = pair & 3, b = pair >> 2;
            __syncthreads();
            { const unsigned char* kb = KVM + ((size_t)head * BATCH * MEM_LEN + (size_t)b * MEM_LEN) * 128; const unsigned char* vb = kb + (size_t)4 * BATCH * MEM_LEN * 128;
#pragma unroll
              for (int i = 0; i < 4; ++i) { const int idx = tid + NTHREADS * i, key = idx >> 3, ch = idx & 7;
                  const u32x4 kv = *(const u32x4*)(kb + (size_t)key * 128 + ch * 16), vv = *(const u32x4*)(vb + (size_t)key * 128 + ch * 16);
                  *(LAS u32x4*)(lds + key * 128 + ((ch ^ ((key >> 1) & 7)) << 4)) = kv;
                  *(LAS u32x4*)(lds + 32768 + key * 128 + ((ch ^ (((key >> 1) & 1) << 2)) << 4)) = vv; } }
            __syncthreads();
#pragma unroll 1
            for (int qq = 0; qq < 2; ++qq) {
                const int q0 = (4 * (u & 7) + 2 * qq) * 256 + wave * 64; if (q0 >= SEQ) break;
                const int tqa = b * SEQ + q0 + c.q, tqb = tqa + 32;
                bf16x8 qa[4], qbf[4]; load_q(QKV + ((size_t)(C_QM / 64 + head) * NTOK + tqa) * 128, c.h, qa); load_q(QKV + ((size_t)(C_QM / 64 + head) * NTOK + tqb) * 128, c.h, qbf);
                QState A, B; A.m = -1e30f; A.l = 0.f; B.m = -1e30f; B.l = 0.f;
#pragma unroll
                for (int i = 0; i < 16; ++i) { A.o0[i] = 0.f; A.o1[i] = 0.f; B.o0[i] = 0.f; B.o1[i] = 0.f; }
#pragma unroll 1
                for (int t = 0; t < 8; ++t) tile_core2(c, lds + 32768 + t * 4096, lds + t * 4096, qa, qbf, A, B);
                store_o8(MIX + (size_t)tqa * DM + NA_W + 256 + head * 64, A.o0, A.o1, 1.f / pair_sum(A.l), c.h);
                store_o8(MIX + (size_t)tqb * DM + NA_W + 256 + head * 64, B.o0, B.o1, 1.f / pair_sum(B.l), c.h);
            }
        }
        __syncthreads();
    }
    LAS unsigned char* so = lds + L_SO; LAS float* sm = (LAS float*)(lds + L_SM); LAS float* sl = (LAS float*)(lds + L_SL);
    if (parts & 4) for (int u = vcu; u < BATCH * 4 * (SEQ / 512); u += G) {
        const int blk = u & 15, hh = (u >> 4) & 3, b = u >> 6;
        __syncthreads();
        for (int i = tid; i < 3 * 192; i += NTHREADS) { const int g = i / 192, j = i - 192 * g - 32; lb[i] = (j >= 0 && j <= 128) ? biasD[(g * 4 + hh) * 129 + j] : NEG_INF; }
        __syncthreads();
#pragma unroll 1
        for (int g = 0; g < 3; ++g) {
            const int dil = g == 0 ? 1 : (g == 1 ? 4 : 16), head = g * 4 + hh;
#pragma unroll 1
            for (int k = 0; k < 2; ++k) {
                const int tl = wave * 2 + k;
                const int base = g == 0 ? 32 * tl : (g == 1 ? (tl & 3) + 128 * (tl >> 2) : tl);
                const int tql = base + dil * c.q;
                const int tq = b * SEQ + blk * 512 + tql;
                SpecDil sp; sp.rs = __builtin_amdgcn_make_buffer_rsrc((void*)(QKV + ((size_t)(C_KD / 64 + head) * NTOK + (size_t)b * SEQ) * 128), 0, 0x7fffffff, 0x00020000); sp.pos0 = blk * 512 + base; sp.dil = dil; sp.q = c.q; sp.h = c.h; sp.btab = lb + g * 192; sp.cb = chunk16;
#pragma unroll
                for (int i = 0; i < 4; ++i) sp.pi[i] = sp.pos0 + dil * (-64 + key_lo + 8 * i);
                sp.kcolK = 0; sp.kcolV = ((C_VD - C_KD) / 64) * NTOK * 128;
                { const int chn = lane & 7, g16 = lane >> 4; sp.ck0 = (chn ^ (g16 & 7)) << 4; sp.ck1 = (chn ^ ((g16 + 4) & 7)) << 4; sp.cv0 = (chn ^ ((g16 & 1) << 2)) << 4; }
                bf16x8 qf[4]; load_q(QKV + ((size_t)(C_QD / 64 + head) * NTOK + tq) * 128, c.h, qf);
                float m, l; f32x16 o0, o1;
                if (g == 0) { m = -1e30f; l = 0.f;
#pragma unroll
                    for (int i = 0; i < 16; ++i) { o0[i] = 0.f; o1[i] = 0.f; } }
                else {
                    m = sm[tql]; const float lt = sl[tql]; l = c.h == 0 ? lt : 0.f;
                    const LAS unsigned char* rowp = so + tql * SO_PITCH;
#pragma unroll
                    for (int g4 = 0; g4 < 4; ++g4) {
                        const u32x2 w0 = *(const LAS u32x2*)(rowp + (8 * g4 + 4 * c.h) * 2), w1 = *(const LAS u32x2*)(rowp + (32 + 8 * g4 + 4 * c.h) * 2);
                        o0[4 * g4] = __uint_as_float(w0.x << 16) * lt; o0[4 * g4 + 1] = __uint_as_float(w0.x & 0xffff0000u) * lt; o0[4 * g4 + 2] = __uint_as_float(w0.y << 16) * lt; o0[4 * g4 + 3] = __uint_as_float(w0.y & 0xffff0000u) * lt;
                        o1[4 * g4] = __uint_as_float(w1.x << 16) * lt; o1[4 * g4 + 1] = __uint_as_float(w1.x & 0xffff0000u) * lt; o1[4 * g4 + 2] = __uint_as_float(w1.y << 16) * lt; o1[4 * g4 + 3] = __uint_as_float(w1.y & 0xffff0000u) * lt;
                    }
                }
                run_dma(sp, c, qf, m, l, o0, o1);
                const float lt = pair_sum(l); const float inv = 1.f / lt;
                if (g < 2) { store_o(so + tql * SO_PITCH, o0, o1, inv, c.h); if (c.h == 0) { sm[tql] = m; sl[tql] = lt; } }
                else store_o8(MIX + (size_t)tq * DM + NA_W + hh * 64, o0, o1, inv, c.h);
            }
            __syncthreads();
        }
    }
}
}

__device__ __forceinline__ void memkv_mini(const MArgs& a, LAS unsigned char* lds, int u) {
    const int tid = threadIdx.x, lane = tid & 63, wave = __builtin_amdgcn_readfirstlane(tid >> 6);
    const int hd = u & 7, rb = u >> 3, rh = wave & 1, kq = wave >> 1, r = lane & 31, h = lane >> 5;
    const bf16_t* XNm = (const bf16_t*)(a.ws + WS_XN) + (size_t)NTOK * DM;
    const bf16_t* WT = (const bf16_t*)(a.ws + WS_WINT);
    const bf16_t* arow = XNm + (size_t)(rb * 64 + rh * 32 + r) * DM + kq * 256 + 8 * h;
    const int n0 = 64 * hd + r, n1 = n0 + 32;
    const bf16_t* b0 = WT + (size_t)(4096 + inproj_pos(n0)) * DM + kq * 256 + 8 * h;
    const bf16_t* b1 = WT + (size_t)(4096 + inproj_pos(n1)) * DM + kq * 256 + 8 * h;
    f32x16 c0, c1;
#pragma unroll
    for (int i = 0; i < 16; ++i) { c0[i] = 0.f; c1[i] = 0.f; }
#pragma unroll 4
    for (int s2 = 0; s2 < 16; ++s2) {
        const bf16x8 af = *(const bf16x8*)(arow + 16 * s2), bf0 = *(const bf16x8*)(b0 + 16 * s2), bf1 = *(const bf16x8*)(b1 + 16 * s2);
        c0 = __builtin_amdgcn_mfma_f32_32x32x16_bf16(af, bf0, c0, 0, 0, 0);
        c1 = __builtin_amdgcn_mfma_f32_32x32x16_bf16(af, bf1, c1, 0, 0, 0);
    }
    LAS float* part = (LAS float*)lds + ((kq * 2 + rh) * 32) * 64;
#pragma unroll
    for (int i = 0; i < 16; ++i) { const int row = (i & 3) + 8 * (i >> 2) + 4 * h; part[row * 64 + r] = c0[i]; part[row * 64 + 32 + r] = c1[i]; }
    __syncthreads();
    { const int row = tid >> 3, cg = tid & 7; const int rh2 = row >> 5, rr = row & 31;
      float v[8];
#pragma unroll
      for (int j = 0; j < 8; ++j) { float sacc = 0.f;
#pragma unroll
          for (int q = 0; q < 4; ++q) sacc += ((LAS float*)lds)[(((q * 2 + rh2) * 32) + rr) * 64 + cg * 8 + j];
          v[j] = sacc; }
      float ss = 0.f;
#pragma unroll
      for (int j = 0; j < 8; ++j) ss += v[j] * v[j];
      ss += __shfl_xor(ss, 1); ss += __shfl_xor(ss, 2); ss += __shfl_xor(ss, 4);
      const float rn = hd < 4 ? rsqrtf(ss * (1.f / 64.f) + EPS) : 1.f;
      u32x4 w;
      if (hd < 4) { const float* gq = a.in[4] + 5 * 64 + cg * 8;
          w.x = att::cvtpk(v[0] * rn * gq[0], v[1] * rn * gq[1]); w.y = att::cvtpk(v[2] * rn * gq[2], v[3] * rn * gq[3]); w.z = att::cvtpk(v[4] * rn * gq[4], v[5] * rn * gq[5]); w.w = att::cvtpk(v[6] * rn * gq[6], v[7] * rn * gq[7]); }
      else { w.x = att::cvtpk(v[0], v[1]); w.y = att::cvtpk(v[2], v[3]); w.z = att::cvtpk(v[4], v[5]); w.w = att::cvtpk(v[6], v[7]); }
      bf16_t* KVM = (bf16_t*)(a.ws + WS_KVM);
      *(u32x4*)(KVM + ((size_t)hd * (BATCH * MEM_LEN) + rb * 64 + row) * 64 + cg * 8) = w;
    }
    __syncthreads();
}

__device__ __forceinline__ void phase4(const MArgs& a, LAS unsigned char* lds, int vcu, int G, bool dry) {
    const int tid = threadIdx.x, lane = tid & 63, wave = __builtin_amdgcn_readfirstlane(tid >> 6);
    const int r = lane & 15, kq = lane >> 4;
    LAS float* sR = (LAS float*)(lds + wave * 4096);
    LAS float* sLg = sR + 16;
    const bf16_t* x1 = (const bf16_t*)(a.ws + WS_X1B); const float* g_ffn = a.in[10];
    const bf16_t* WfH = (const bf16_t*)(a.ws + WS_WRF); const bf16_t* WfL = WfH + 32 * 3 * 64 * 8; const float* b48 = (const float*)(a.ws + WS_WRF + 2 * 32 * 3 * 64 * 8 * 2);
    constexpr int P4_MAXSLOT = 512;
    LAS int* hP = (LAS int*)(lds + 32768); LAS int* hE = hP + 128; LAS int* bP = hE + 32; LAS int* bE = bP + 128; LAS int* tinfo = bE + 32;
    for (int i = tid; i < 320 + P4_MAXSLOT * 4; i += NTHREADS) hP[i] = i < 320 ? 0 : -1;
    __syncthreads();
    int slot0 = wave * 16;
    bf16_t* H = (bf16_t*)(a.ws + WS_H); float* tokg = (float*)(a.ws + WS_TOKG); float* trstd = (float*)(a.ws + WS_RSTD); int* lists = (int*)(a.ws + WS_LIST); unsigned* count = (unsigned*)(a.ws + WS_CTL) + CW_COUNT;
    int* elists = (int*)(a.ws + WS_ELIST); int* tokP = (int*)(a.ws + WS_TOKP); unsigned* ecount = (unsigned*)(a.ws + WS_CTL) + CW_ECOUNT;
    for (int tile = vcu * NWAVES + wave; tile < NTOK / 16; tile += G * NWAVES) {
        const int tok0 = tile * 16;
        const bf16_t* xr = x1 + (size_t)(tok0 + r) * DM + 8 * kq;
        bf16_t* hr = H + (size_t)(tok0 + r) * DM + 8 * kq;
        f32x4 acc[3]; float ss = 0.f;
#pragma unroll
        for (int ct = 0; ct < 3; ++ct) acc[ct] = (f32x4){0.f, 0.f, 0.f, 0.f};
#pragma unroll 2
        for (int s = 0; s < 32; ++s) {
            const u32x4 xw = *(const u32x4*)(xr + 32 * s);
            const f32x4 xa = (f32x4){__uint_as_float(xw.x << 16), __uint_as_float(xw.x & 0xffff0000u), __uint_as_float(xw.y << 16), __uint_as_float(xw.y & 0xffff0000u)};
            const f32x4 xb = (f32x4){__uint_as_float(xw.z << 16), __uint_as_float(xw.z & 0xffff0000u), __uint_as_float(xw.w << 16), __uint_as_float(xw.w & 0xffff0000u)};
            ss += (xa[0] * xa[0] + xa[1] * xa[1]) + (xa[2] * xa[2] + xa[3] * xa[3]) + (xb[0] * xb[0] + xb[1] * xb[1]) + (xb[2] * xb[2] + xb[3] * xb[3]);
            const bf16x8 ah = __builtin_bit_cast(bf16x8, xw);
#pragma unroll
            for (int ct = 0; ct < 3; ++ct) {
                const bf16x8 wh = *(const bf16x8*)(WfH + ((size_t)(s * 3 + ct) * 64 + lane) * 8), wl = *(const bf16x8*)(WfL + ((size_t)(s * 3 + ct) * 64 + lane) * 8);
                acc[ct] = __builtin_amdgcn_mfma_f32_16x16x32_bf16(ah, wh, acc[ct], 0, 0, 0);
                acc[ct] = __builtin_amdgcn_mfma_f32_16x16x32_bf16(ah, wl, acc[ct], 0, 0, 0);
            }
        }
        ss += __shfl_xor(ss, 16); ss += __shfl_xor(ss, 32);
        const float rstd = rsqrtf(ss * (1.f / DM) + EPS);
        if (kq == 0) { sR[r] = rstd; trstd[tok0 + r] = rstd; }
#pragma unroll
        for (int ct = 0; ct < 3; ++ct) { const float bb = b48[16 * ct + r];
#pragma unroll
            for (int i = 0; i < 4; ++i) { const int tk = 4 * kq + i; sLg[tk * 48 + 16 * ct + r] = acc[ct][i] * sR[tk] + bb; } }
        if (lane < 16) {
            const int tok = tok0 + lane; const LAS float* lg = sLg + lane * 48;
            int gi = 0; float gm = lg[0];
            for (int i = 1; i < 4; ++i) if (lg[i] > gm) { gm = lg[i]; gi = i; }
            float den = 0.f; for (int i = 0; i < 4; ++i) den += __expf(lg[i] - gm);
            const float grp_gate = 1.f / den;
            const LAS float* fl = lg + 4 + gi * 8;
            int i0 = 0; float v0 = fl[0];
            for (int i = 1; i < 8; ++i) if (fl[i] > v0) { v0 = fl[i]; i0 = i; }
            int i1 = -1; float v1 = -3.0e38f;
            for (int i = 0; i < 8; ++i) if (i != i0 && fl[i] > v1) { v1 = fl[i]; i1 = i; }
            const float e1 = __expf(v1 - v0); const float g0 = grp_gate / (1.f + e1), g1 = grp_gate * e1 / (1.f + e1);
            int pa, pb; float ga, gb;
            if (i0 < i1) { pa = i0; pb = i1; ga = g0; gb = g1; } else { pa = i1; pb = i0; ga = g1; gb = g0; }
            const int L = gi * 28 + pa * 8 - pa * (pa + 1) / 2 + (pb - pa - 1);
            tokg[tok * 2] = ga; tokg[tok * 2 + 1] = gb;
            if (!dry) {
                const int ea = gi * 8 + pa, eb = gi * 8 + pb;
                if (slot0 + 16 <= P4_MAXSLOT) {
                    const int rp = __hip_atomic_fetch_add(&hP[L], 1, __ATOMIC_RELAXED, __HIP_MEMORY_SCOPE_WORKGROUP);
                    const int ra = __hip_atomic_fetch_add(&hE[ea], 1, __ATOMIC_RELAXED, __HIP_MEMORY_SCOPE_WORKGROUP);
                    const int rb = __hip_atomic_fetch_add(&hE[eb], 1, __ATOMIC_RELAXED, __HIP_MEMORY_SCOPE_WORKGROUP);
                    LAS int* ti = tinfo + (slot0 + lane) * 4;
                    ti[0] = tok; ti[1] = (L << 16) | rp; ti[2] = (ea << 16) | ra; ti[3] = (eb << 16) | rb;
                } else {
                    const unsigned pos = atomicAdd(&count[L], 1u); lists[(size_t)L * NTOK + pos] = tok; tokP[tok] = (L << 16) | (int)pos;
                    const unsigned qa = atomicAdd(&ecount[ea], 1u); elists[(size_t)ea * NTOK + qa] = tok * 2;
                    const unsigned qb = atomicAdd(&ecount[eb], 1u); elists[(size_t)eb * NTOK + qb] = tok * 2 + 1;
                }
            }
        }
        slot0 += NWAVES * 16;
    }
    if (!dry) {
        __syncthreads();
        const int nslot = slot0 - wave * 16 < P4_MAXSLOT ? slot0 - wave * 16 : P4_MAXSLOT;
        if (tid < NPAIR) { const int h = hP[tid]; bP[tid] = h ? (int)atomicAdd(&count[tid], (unsigned)h) : 0; }
        else if (tid >= 128 && tid < 128 + NEXP) { const int h = hE[tid - 128]; bE[tid - 128] = h ? (int)atomicAdd(&ecount[tid - 128], (unsigned)h) : 0; }
        __syncthreads();
        for (int sidx = tid; sidx < nslot; sidx += NTHREADS) {
            const LAS int* ti = tinfo + sidx * 4; const int tok = ti[0];
            if (tok >= 0) {
                const int L = ti[1] >> 16, pos = bP[L] + (ti[1] & 0xffff); lists[(size_t)L * NTOK + pos] = tok; tokP[tok] = (L << 16) | pos;
                const int ea = ti[2] >> 16, eb = ti[3] >> 16;
                elists[(size_t)ea * NTOK + bE[ea] + (ti[2] & 0xffff)] = tok * 2;
                elists[(size_t)eb * NTOK + bE[eb] + (ti[3] & 0xffff)] = tok * 2 + 1;
            }
        }
    }
}

#define XB_TMO      128
#define XB_XCNT(j)  (256  + 64 * (j))
#define XB_XSUB(j)  (1280 + 64 * (j))
#define XB_XGEN(j)  (2304 + 64 * (j))
#define XB_TOP      3328
#define XB_TOPGEN   3392
#define XCD_BAR_WORDS 3456
#define XB_SPIN_CAP (1u << 18)
__device__ __forceinline__ unsigned xb_ld(unsigned* p)              { return __hip_atomic_load(p, __ATOMIC_RELAXED, __HIP_MEMORY_SCOPE_AGENT); }
__device__ __forceinline__ unsigned xb_add(unsigned* p, unsigned v) { return __hip_atomic_fetch_add(p, v, __ATOMIC_RELAXED, __HIP_MEMORY_SCOPE_AGENT); }
__device__ __forceinline__ unsigned xb_xcc_id() { return (unsigned)__builtin_amdgcn_s_getreg((3 << 11) | 20) & 0xFu; }
#define XB_SPIN(cond, bar) do { unsigned _sp = 0; while (cond) { __builtin_amdgcn_s_sleep(1); \
    if ((++_sp & 255u) == 0u) { if (xb_ld(&(bar)[XB_TMO])) break; if (_sp > XB_SPIN_CAP) { atomicAdd(&(bar)[XB_TMO], 1u); break; } } } } while (0)
struct XcdBarrier { unsigned* bar; unsigned x; volatile LAS unsigned* st; };
__device__ __forceinline__ XcdBarrier xcd_barrier_post(unsigned* bar, volatile LAS unsigned* st) {
    XcdBarrier b; b.bar = bar; b.x = xb_xcc_id(); b.st = st;
    if (threadIdx.x == 0) (void)xb_add(&bar[XB_XCNT(b.x)], 1u);
    return b;
}
__device__ __forceinline__ void xcd_barrier_complete(unsigned* bar, unsigned x, unsigned& nloc, unsigned& nx) {
    const unsigned G = gridDim.x * gridDim.y * gridDim.z;
    unsigned sum, cnt, mine, sp = 0u;
    for (;;) {
        sum = 0u; cnt = 0u; mine = 0u;
#pragma unroll
        for (unsigned j = 0; j < 16; ++j) { const unsigned c = xb_ld(&bar[XB_XCNT(j)]); sum += c; cnt += (c > 0u) ? 1u : 0u; mine = (j == x) ? c : mine; }
        if (sum == G) break;
        __builtin_amdgcn_s_sleep(1);
        if ((++sp & 255u) == 0u) { if (xb_ld(&bar[XB_TMO])) break; if (sp > XB_SPIN_CAP) { atomicAdd(&bar[XB_TMO], 1u); break; } }
    }
    nloc = mine > 0u ? mine : 1u; nx = cnt > 0u ? cnt : 1u;
}
__device__ __forceinline__ void xcd_barrier(const XcdBarrier& b) {
    asm volatile("s_waitcnt vmcnt(0)" ::: "memory");
    __syncthreads();
    if (threadIdx.x == 0) {
        unsigned* bar = b.bar;
        __builtin_amdgcn_s_waitcnt(0);
        unsigned nloc = b.st[0], nx = b.st[1];
        if (nloc == 0u) { xcd_barrier_complete(bar, b.x, nloc, nx); b.st[0] = nloc; b.st[1] = nx; }
        const unsigned old = xb_add(&bar[XB_XSUB(b.x)], 1u);
        const unsigned gen = old / nloc;
        if (old + 1u == (gen + 1u) * nloc) {
            __builtin_amdgcn_fence(__ATOMIC_RELEASE, "agent");
            asm volatile("s_waitcnt vmcnt(0)" ::: "memory");
            const unsigned og = xb_add(&bar[XB_TOP], 1u);
            const unsigned tg = og / nx;
            if (og + 1u == (tg + 1u) * nx) xb_add(&bar[XB_TOPGEN], 1u);
            else XB_SPIN(xb_ld(&bar[XB_TOPGEN]) == tg, bar);
            __builtin_amdgcn_fence(__ATOMIC_ACQUIRE, "agent");
            xb_add(&bar[XB_XGEN(b.x)], 1u);
            asm volatile("s_waitcnt vmcnt(0)" ::: "memory");
        } else {
            XB_SPIN(xb_ld(&bar[XB_XGEN(b.x)]) == gen, bar);
            __builtin_amdgcn_fence(__ATOMIC_ACQUIRE, "agent");
            asm volatile("s_waitcnt vmcnt(0)" ::: "memory");
        }
    }
    __syncthreads();
}
constexpr int CW_BAR = 4096;
constexpr int MISC_OFF = LDS_BYTES - 256;

__global__ void __launch_bounds__(NTHREADS, 2) mega(MArgs a) {
    extern __shared__ __attribute__((aligned(16))) unsigned char lds_raw[];
    LAS unsigned char* lds = (LAS unsigned char*)lds_raw;
    const int G = gridDim.x; const int bx = blockIdx.x; const int vcu = (G % 8 == 0) ? (bx % 8) * (G / 8) + bx / 8 : bx;
    const int lo = a.ph_lo, hi = a.ph_hi;
#define IN_PH(k) (lo <= (k) && (k) < hi)
    volatile LAS unsigned* misc = (volatile LAS unsigned*)(lds + MISC_OFF);
    if (threadIdx.x < 2) misc[threadIdx.x] = 0u;
    __syncthreads();
    XcdBarrier xbar; xbar.bar = (unsigned*)(a.ws + WS_CTL) + CW_BAR; xbar.x = 0; xbar.st = misc;
    if (hi - lo > 1) xbar = xcd_barrier_post((unsigned*)(a.ws + WS_CTL) + CW_BAR, misc);
#define SEAM(k) do { if (IN_PH(k) && IN_PH((k) + 1)) { if ((k) == 0) cg::this_grid().sync(); else xcd_barrier(xbar); } } while (0)
    if (IN_PH(0)) { phase0(a, lds, vcu, G); }
    SEAM(0);
    if (IN_PH(1)) {
        for (int u = bx; u < 256; u += G) memkv_mini(a, lds, u);
        SchedInProj S{(const char*)(a.ws + WS_XN), (const char*)(a.ws + WS_WINT), G, bx};
        EpiInProj E{(bf16_t*)(a.ws + WS_QKV), (bf16_t*)(a.ws + WS_KVM), a.in[4], (const float*)(a.ws + WS_RSTDX)};
        pg8::gemm_phase<EpiInProj, SchedInProj, false, true>(lds, DM / 64, DM, DM, S, E);
    }
    SEAM(1);
    if (IN_PH(2) || (!MK_ONE_LAUNCH && a.ph_lo >= 20 && a.ph_lo < 23)) { att::phase2(a, lds, vcu, G); }
    SEAM(2);
    if (IN_PH(3)) {
        SchedOutProj S{(const char*)(a.ws + WS_MIX), (const char*)(a.ws + WS_WOT), G, bx};
        EpiOutProj E{(const bf16_t*)(a.ws + WS_XN), (bf16_t*)(a.ws + WS_X1B), a.ws + WS_X1Q};
        pg8::gemm_phase<EpiOutProj, SchedOutProj, false, true, true>(lds, DM / 128, DM / 2, DM / 2, S, E);
    }
    SEAM(3);
    if (IN_PH(4) || lo == 7) { phase4(a, lds, vcu, G, lo == 7); }
    SEAM(4);
    if (IN_PH(5)) {
        const unsigned* count = (const unsigned*)(a.ws + WS_CTL) + CW_COUNT; const unsigned* ecount = (const unsigned*)(a.ws + WS_CTL) + CW_ECOUNT;
        moe_build_tiles(lds, count, ecount);
        const LAS int* tt = (const LAS int*)(lds + TT_OFF);
        SchedMoe1 S{(const char*)(a.ws + WS_X1Q), (const char*)(a.ws + WS_W13T), (const int*)(a.ws + WS_ELIST), ecount, tt, tt[TT_E], G, bx};
        EpiMoe1 E{(bf16_t*)(a.ws + WS_ACT), (const int*)(a.ws + WS_ELIST), ecount, (const float*)(a.ws + WS_TOKG), (const float*)(a.ws + WS_RSTD), (const int*)(a.ws + WS_TOKP), tt};
        pg8::gemm_phase<EpiMoe1, SchedMoe1, true, true, true>(lds, DM / 128, DM / 2, DM / 2, S, E);
    }
    SEAM(5);
    if (IN_PH(6) || lo == 8) {
        const unsigned* count = (const unsigned*)(a.ws + WS_CTL) + CW_COUNT;
        const int ntiles = moe_build_tiles(lds, count, (const unsigned*)(a.ws + WS_CTL) + CW_ECOUNT);
        SchedMoe2 S{(const char*)(a.ws + WS_ACT), (const char*)(a.ws + WS_W2T), (const LAS int*)(lds + TT_OFF), ntiles, G, bx};
        EpiMoe2 E{(!MK_ONE_LAUNCH && a.var == 3) ? (float*)(a.ws + WS_XN) : a.out, (const bf16_t*)(a.ws + WS_X1B), (const int*)(a.ws + WS_LIST), count, lo == 8 ? 0.f : 1.f / (SC_ACT * SC_W2), MK_ONE_LAUNCH ? 0 : a.var};
        pg8::gemm_phase<EpiMoe2, SchedMoe2, false, true, true>(lds, DM / 128, DM / 2, DEXP / 2, S, E);
    }
#undef IN_PH
#undef SEAM
}

static void launch_mega(const MArgs& base, int lo, int hi, int grid, hipStream_t stream) {
    MArgs a = base; a.ph_lo = lo; a.ph_hi = hi;
    hipLaunchKernelGGL(mega, dim3(grid), dim3(NTHREADS), LDS_BYTES, stream, a);
}
extern "C" void kernel_launch(void* const* d_in, const int* in_sizes, int n_in, void* d_out, int out_size, void* d_ws, size_t ws_size, hipStream_t stream) {
    if (n_in != 18 || ws_size < WS_END || out_size != NTOK * DM) { fprintf(stderr, "kernel_launch: unexpected sizes n_in %d ws %zu out %d\n", n_in, ws_size, out_size); return; }
    static int grid = 0;
    if (grid == 0) {
        int dev = 0, cus = 0, per_cu = 0;
        if (hipGetDevice(&dev) != hipSuccess || hipDeviceGetAttribute(&cus, hipDeviceAttributeMultiprocessorCount, dev) != hipSuccess) { grid = -1; return; }
        if (hipFuncSetAttribute((const void*)mega, hipFuncAttributeMaxDynamicSharedMemorySize, LDS_BYTES) != hipSuccess) { fprintf(stderr, "hipFuncSetAttribute failed\n"); grid = -1; return; }
        if (hipOccupancyMaxActiveBlocksPerMultiprocessor(&per_cu, (const void*)mega, NTHREADS, LDS_BYTES) != hipSuccess || per_cu < 1) { fprintf(stderr, "occupancy query failed (%d)\n", per_cu); grid = -1; return; }
        grid = cus * per_cu;
    }
    if (grid < 0) return;
    MArgs base; memset(&base, 0, sizeof base);
    for (int i = 0; i < 18; ++i) base.in[i] = (const float*)d_in[i];
    base.out = (float*)d_out; base.ws = (unsigned char*)d_ws;
    static_assert((CW_BAR + XCD_BAR_WORDS) * 4 <= 65536 && (CW_ECOUNT + NEXP) * 4 <= 65536, "control words inside the zeroed region");
    (void)hipMemsetAsync((unsigned char*)d_ws + WS_CTL, 0, 65536, stream);
#if MK_ONE_LAUNCH
    base.ph_lo = 0; base.ph_hi = 7;
    void* args[] = {&base};
    hipError_t e = hipLaunchCooperativeKernel((const void*)mega, dim3(grid), dim3(NTHREADS), args, LDS_BYTES, stream);
    if (e != hipSuccess) fprintf(stderr, "cooperative launch failed: %s (grid %d)\n", hipGetErrorString(e), grid);
#else
    for (int p = 0; p < 7; ++p) { launch_mega(base, p, p + 1, grid, stream); if (p == MK_REP_PHASE) launch_mega(base, p, p + 1, grid, stream); if (p == 4 && MK_REP_PHASE == 7) launch_mega(base, 7, 8, grid, stream); if (p == 6 && MK_REP_PHASE == 8) launch_mega(base, 8, 9, grid, stream);
        if (p == 2 && MK_REP_PHASE >= 20 && MK_REP_PHASE < 30) for (int r = 0; r < 4; ++r) launch_mega(base, MK_REP_PHASE, MK_REP_PHASE + 1, grid, stream);
        if (MK_REP_PHASE >= 100 && p == MK_REP_PHASE % 100) { MArgs b2 = base; b2.var = MK_REP_PHASE / 100; for (int r = 0; r < 2; ++r) launch_mega(b2, p, p + 1, grid, stream); } }
#endif
    (void)in_sizes;
}
```

```cpp
#include <hip/hip_runtime.h>
#include <hip/hip_cooperative_groups.h>
#include <cstdio>
#include <cstdint>
#include <cstring>

constexpr int DM = 1024, BATCH = 8, SEQ = 8192, NTOK = BATCH * SEQ;
constexpr int HD = 64, MEM_LEN = 256, GRID_W = 64, GRID_R = SEQ / GRID_W;
constexpr int NA_HEADS = 8, DIL_HEADS = 12, MEM_HEADS = 4;
constexpr int NA_W = 512, DIL_W = 768, MEM_W = 256, IN_COLS = 4096;
constexpr int C_QA = 0, C_KA = 512, C_VA = 1024, C_QD = 1536, C_KD = 2304, C_VD = 3072, C_QM = 3840;
constexpr int NEXP = 32, DEXP = 512;
constexpr int NPAIR = 112;
constexpr int MROWS = NTOK + MEM_LEN * BATCH;
constexpr float EPS = 1e-6f;
constexpr float LOG2E = 1.4426950408889634f;
constexpr float QSCALE = 0.125f * LOG2E;

typedef unsigned short bf16_t;
namespace cg = cooperative_groups;
#ifndef MK_ONE_LAUNCH
#define MK_ONE_LAUNCH 1
#endif
#ifndef MK_REP_PHASE
#define MK_REP_PHASE -1
#endif

constexpr size_t MiB = 1u << 20;
constexpr size_t WS_CTL = 0;
constexpr size_t WS_BIASD = 1 * MiB;
constexpr size_t WS_RPB = 1 * MiB + 64 * 1024;
constexpr size_t WS_WRF = 1 * MiB + 128 * 1024;
constexpr size_t WS_TOKG = 2 * MiB;
constexpr size_t WS_RSTD = 2 * MiB + 512 * 1024;
constexpr size_t WS_LIST = 4 * MiB;
constexpr size_t WS_KVM = 32 * MiB;
constexpr size_t WS_ELIST = 36 * MiB;
constexpr size_t WS_TOKP = 2 * MiB + 768 * 1024;
constexpr size_t WS_WT = 48 * MiB;
constexpr size_t WS_XN = 160 * MiB;
constexpr size_t WS_QKV = 304 * MiB;
constexpr size_t WS_H = WS_QKV;
constexpr size_t WS_X1Q = WS_QKV;
constexpr float SC_XQ = 16.f, SC_WIN = 512.f;
constexpr float SC_X1 = 16.f, SC_W13 = 512.f, SC_ACT = 8.f, SC_W2 = 256.f, SC_MIX = 32.f, SC_WO = 512.f;
constexpr size_t WS_ACT = WS_QKV + 128 * MiB;
constexpr size_t WS_X1B = 640 * MiB;
constexpr size_t WS_MIX = 816 * MiB;
constexpr size_t WS_XQ = WS_MIX + 64 * MiB;
constexpr size_t WS_RSTDX = 3 * MiB;
constexpr size_t WS_END = 944 * MiB;
constexpr int MAXTILES = NTOK / 256 + NPAIR;
constexpr int CW_COUNT = 64;
constexpr int CW_ECOUNT = 256;
constexpr int MAXETILES = 2 * NTOK / 256 + 32;

__device__ __forceinline__ float bf2f(bf16_t v) { return __uint_as_float((unsigned)v << 16); }
__device__ __forceinline__ bf16_t f2bf(float f) { unsigned u = __float_as_uint(f); return (bf16_t)((u + 0x7fffu + ((u >> 16) & 1u)) >> 16); }
__device__ __forceinline__ float wave_sum(float v) {
#pragma unroll
    for (int o = 1; o < 64; o <<= 1) v += __shfl_xor(v, o);
    return v;
}

__device__ __forceinline__ int t5_bucket(int rel) {
    const int n = rel < 0 ? -rel : rel;
    const int upper = rel > 0 ? 16 : 0;
    const float nf = (float)(n < 1 ? 1 : n);
    int large = 8 + (int)(logf(nf / 8.f) / logf(128.f) * 8.f);
    large = large < 15 ? large : 15;
    return upper + (n < 8 ? n : large);
}
__device__ __forceinline__ void pair_experts(int L, int& ea, int& eb) {
    const int grp = L / 28; int idx = L % 28; int a = 0;
    while (idx >= 7 - a) { idx -= 7 - a; ++a; }
    ea = grp * 8 + a; eb = grp * 8 + a + 1 + idx;
}

#define LAS __attribute__((address_space(3)))
typedef short bf16x8 __attribute__((ext_vector_type(8)));
typedef float f32x4 __attribute__((ext_vector_type(4)));
typedef float f32x16 __attribute__((ext_vector_type(16)));
typedef unsigned u32x4 __attribute__((ext_vector_type(4)));
typedef unsigned u32x2 __attribute__((ext_vector_type(2)));

constexpr int NWAVES = 8, NTHREADS = 512;
constexpr int LDS_BYTES = 163840;
constexpr int RING_BYTES = 131072;

constexpr size_t WS_WINT = WS_WT;
constexpr size_t WS_WOT = WS_WINT + (size_t)4608 * 1024 * 2;
constexpr size_t WS_W13T = WS_WOT + (size_t)1024 * 1024 * 2;
constexpr size_t WS_W2T = WS_W13T + (size_t)32 * 1024 * 1024 * 2;
constexpr size_t WS_WINT8 = WS_W13T + (size_t)32 * 1024 * 1024;
static_assert(WS_W2T + (size_t)32 * 1024 * 512 * 2 <= WS_XN, "weight copies fit");
static_assert(WS_ACT + (size_t)MAXTILES * 256 * 1024 * 2 <= WS_X1B && WS_X1B + (size_t)NTOK * 1024 * 2 <= WS_MIX, "ACT | X1B | MIX do not overlap");

__device__ __forceinline__ unsigned cvt_pk_bf16(float lo, float hi) { unsigned r; asm volatile("v_cvt_pk_bf16_f32 %0, %1, %2" : "=v"(r) : "v"(lo), "v"(hi)); return r; }
__device__ __forceinline__ unsigned pk4_fp8(float a, float b, float c, float d) { int w = 0; w = __builtin_amdgcn_cvt_pk_fp8_f32(a, b, w, false); w = __builtin_amdgcn_cvt_pk_fp8_f32(c, d, w, true); return (unsigned)w; }
__device__ __forceinline__ unsigned pk2(float lo, float hi) { return (unsigned)f2bf(lo) | ((unsigned)f2bf(hi) << 16); }

namespace pg8 {
constexpr int BM = 256, BK = 64, HALF = 128, HTB = HALF * BK * 2, NXCD = 8, WGM = 8;
__device__ __forceinline__ int lds_byte(int r, int c) { const int st = (r >> 4) * 2 + (c >> 5), rr = r & 15, cc = c & 31, ob = rr * 64 + cc * 2; return st * 1024 + (ob ^ (((ob >> 9) & 1) << 5)); }
__device__ __forceinline__ void stage_rc(int b, int& R, int& C) { const int st = b / 1024, sb = b % 1024, swz = sb ^ (((sb >> 9) & 1) << 5); R = (st >> 1) * 16 + swz / 64; C = (st & 1) * 32 + (swz % 64) / 2; }
__device__ __forceinline__ int perm32(int rho) { const int n = rho >> 4, i = rho & 15; return 8 * (i >> 2) + 4 * n + (i & 3); }

typedef short bf16x16_t __attribute__((ext_vector_type(16)));
typedef int i32x4_t __attribute__((ext_vector_type(4)));
typedef int i32x8_t __attribute__((ext_vector_type(8)));
__device__ __forceinline__ f32x4 mfma_fp8(const bf16x8& a0, const bf16x8& a1, const bf16x8& b0, const bf16x8& b1, const f32x4& c) {
    const i32x8_t A = __builtin_shufflevector(__builtin_bit_cast(i32x4_t, a0), __builtin_bit_cast(i32x4_t, a1), 0, 1, 2, 3, 4, 5, 6, 7);
    const i32x8_t B = __builtin_shufflevector(__builtin_bit_cast(i32x4_t, b0), __builtin_bit_cast(i32x4_t, b1), 0, 1, 2, 3, 4, 5, 6, 7);
    return __builtin_amdgcn_mfma_scale_f32_16x16x128_f8f6f4(A, B, c, 0, 0, 0, 0x7F7F7F7F, 0, 0x7F7F7F7F);
}
struct Unit { const char* A; const char* B0; const char* B1; int ksplit; int e0, e1, e2, e3; };

__device__ __forceinline__ int xcd_remap(int L, int nwg) { const int q = nwg / NXCD, r = nwg % NXCD, xcd = L % NXCD, off = L / NXCD; return (xcd < r ? xcd * (q + 1) : r * (q + 1) + (xcd - r) * q) + off; }

template <class Epi, class Sched, bool GATHER, bool ALIGN_EPI, bool FP8 = false>
__device__ __forceinline__ void gemm_phase(LAS unsigned char* lds, const int nt, const int lda, const int ldb, const Sched& S, const Epi& E) {
    const int tid = threadIdx.x, wid = __builtin_amdgcn_readfirstlane(tid >> 6), lane = tid & 63, wr = wid >> 2, wc = wid & 3, fr = lane & 15, fq = lane >> 4;
    int sR[2], sC[2]; unsigned voffB[2];
#pragma unroll
    for (int i = 0; i < 2; ++i) { int R, C; stage_rc(tid * 16 + i * 8192, R, C); sR[i] = R; sC[i] = C; const int Rb = Epi::PERM ? ((R & ~31) + perm32(R & 31)) : R; voffB[i] = (unsigned)(Rb * ldb + C) * 2u; }
    const size_t kstep = (size_t)(BK * 2);
    const size_t hstepB = (size_t)HALF * ldb * 2;
    const unsigned ldsw = (unsigned)wid * 1024u;
    const int aoff = lds_byte(wr * 64 + fr, fq * 8), boff = lds_byte(wc * 32 + fr, fq * 8);
#define PG8_SA(b, h) (((b) * 2 + (h)) * HTB)
#define PG8_SB(b, h) ((4 + (b) * 2 + (h)) * HTB)
#define PG8_STAGE(bufoff, gbase, voff) do { _Pragma("unroll") for (int _i = 0; _i < 2; ++_i) \
        __builtin_amdgcn_global_load_lds((const unsigned*)((const char*)(gbase) + (voff)[_i]), (LAS unsigned*)(lds + (bufoff) + ldsw + _i * 8192), 16, 0, 0); } while (0)
#define PG8_LDA(dst, b, h) do { _Pragma("unroll") for (int m = 0; m < 4; ++m) { \
        if constexpr (FP8) { const i32x4_t lo_ = *(const LAS i32x4_t*)(lds + PG8_SA(b, h) + aoff + m * 2048), hi_ = *(const LAS i32x4_t*)(lds + PG8_SA(b, h) + aoff + m * 2048 + 1024); dst##W[m] = __builtin_shufflevector(lo_, hi_, 0, 1, 2, 3, 4, 5, 6, 7); } \
        else { _Pragma("unroll") for (int k = 0; k < 2; ++k) dst[m][k] = *(const LAS bf16x8*)(lds + PG8_SA(b, h) + aoff + m * 2048 + k * 1024); } } } while (0)
#define PG8_LDB(dst, b, h) do { _Pragma("unroll") for (int n = 0; n < 2; ++n) { \
        if constexpr (FP8) { const i32x4_t lo_ = *(const LAS i32x4_t*)(lds + PG8_SB(b, h) + boff + n * 2048), hi_ = *(const LAS i32x4_t*)(lds + PG8_SB(b, h) + boff + n * 2048 + 1024); dst##W[n] = __builtin_shufflevector(lo_, hi_, 0, 1, 2, 3, 4, 5, 6, 7); } \
        else { _Pragma("unroll") for (int k = 0; k < 2; ++k) dst[n][k] = *(const LAS bf16x8*)(lds + PG8_SB(b, h) + boff + n * 2048 + k * 1024); } } } while (0)
#define PG8_MMA(ai, bj, At, Bt) do { __builtin_amdgcn_s_setprio(1); _Pragma("unroll") for (int m = 0; m < 4; ++m) _Pragma("unroll") for (int n = 0; n < 2; ++n) { \
        if constexpr (FP8) asm("v_mfma_scale_f32_16x16x128_f8f6f4 %0, %1, %2, %0, %3, %3 op_sel_hi:[0,0,0]" : "+v"(acc[ai][bj][m][n]) : "v"(Bt##W[n]), "v"(At##W[m]), "v"(one8)); \
        else { _Pragma("unroll") for (int k = 0; k < 2; ++k) acc[ai][bj][m][n] = __builtin_amdgcn_mfma_f32_16x16x32_bf16(Bt[n][k], At[m][k], acc[ai][bj][m][n], 0, 0, 0); } } __builtin_amdgcn_s_setprio(0); } while (0)
#define PG8_WAIT_V(n) asm volatile("s_waitcnt vmcnt(" #n ")" ::: "memory")
#define PG8_WAIT_L(n) asm volatile("s_waitcnt lgkmcnt(" #n ")" ::: "memory")
#define PG8_BAR __builtin_amdgcn_s_barrier()
#define PG8_SCHED __builtin_amdgcn_sched_barrier(0)
#define PG8_BP(u, t) (((t) < (u).ksplit ? (u).B0 : (u).B1) + (size_t)(t) * kstep)
    Unit cur, nxt; int ui = 0;
    if (!S.next(0, cur)) return;
    f32x4 acc[2][2][4][2];
#pragma unroll
    for (int a = 0; a < 2; ++a)
#pragma unroll
        for (int b = 0; b < 2; ++b)
#pragma unroll
            for (int m = 0; m < 4; ++m)
#pragma unroll
                for (int n = 0; n < 2; ++n) acc[a][b][m][n] = (f32x4){0.f, 0.f, 0.f, 0.f};
    bf16x8 At[4][2], B0[2][2], B1[2][2];
    i32x8_t AtW[4], B0W[2], B1W[2];
    const int one8 = 0x7F7F7F7F;
    unsigned vA[2][2], nvA[2][2];
    S.template aoffs<GATHER>(cur, sR, sC, lda, vA);
    const char* cA = cur.A; const char* cB0 = PG8_BP(cur, 0); const char* cB1 = PG8_BP(cur, 1);
    PG8_STAGE(PG8_SB(0, 0), cB0, voffB); PG8_STAGE(PG8_SB(0, 1), cB0 + hstepB, voffB); PG8_STAGE(PG8_SA(0, 0), cA, vA[0]); PG8_STAGE(PG8_SA(0, 1), cA, vA[1]);
    if (wr == 1) PG8_BAR;
    PG8_WAIT_V(2); PG8_BAR;
    PG8_STAGE(PG8_SB(1, 0), cB1, voffB); PG8_STAGE(PG8_SA(1, 0), cA + kstep, vA[0]); PG8_STAGE(PG8_SB(1, 1), cB1 + hstepB, voffB);
    PG8_WAIT_V(6); PG8_BAR;
    for (;;) {
        const bool has_next = S.next(ui + 1, nxt);
        if (!has_next) nxt = cur;
        if constexpr (GATHER) {
            if (has_next) S.template aoffs<GATHER>(nxt, sR, sC, lda, nvA);
            else {
#pragma unroll
                for (int h = 0; h < 2; ++h)
#pragma unroll
                    for (int i = 0; i < 2; ++i) nvA[h][i] = vA[h][i];
            }
        }
        const char* nA = nxt.A;
#pragma unroll 1
        for (int t = 0; t < nt; t += 2) {
            const bool last = (t == nt - 2);
            const char* a1 = cA + (size_t)(t + 1) * kstep;
            const char* a2 = last ? nA : cA + (size_t)(t + 2) * kstep; const char* a3 = a2 + kstep;
            const char* b2 = last ? PG8_BP(nxt, 0) : PG8_BP(cur, t + 2); const char* b3 = last ? PG8_BP(nxt, 1) : PG8_BP(cur, t + 3);
            unsigned wA[2][2];
#pragma unroll
            for (int h = 0; h < 2; ++h)
#pragma unroll
                for (int i = 0; i < 2; ++i) { if constexpr (GATHER) { const unsigned msk = last ? 0xffffffffu : 0u; wA[h][i] = vA[h][i] ^ ((vA[h][i] ^ nvA[h][i]) & msk); } else wA[h][i] = vA[h][i]; }
            PG8_LDB(B0, 0, 0); PG8_LDB(B1, 0, 1); PG8_SCHED; PG8_LDA(At, 0, 0); PG8_STAGE(PG8_SA(1, 1), a1, vA[1]);
            PG8_WAIT_V(8); PG8_WAIT_L(0); PG8_BAR; PG8_MMA(0, 0, At, B0); PG8_MMA(0, 1, At, B1); PG8_BAR; PG8_SCHED;
            PG8_LDA(At, 0, 1); PG8_STAGE(PG8_SB(0, 0), b2, voffB); PG8_STAGE(PG8_SB(0, 1), b2 + hstepB, voffB); PG8_STAGE(PG8_SA(0, 0), a2, wA[0]);
            PG8_WAIT_V(8); PG8_WAIT_L(0); PG8_BAR; PG8_MMA(1, 0, At, B0); PG8_MMA(1, 1, At, B1); PG8_BAR; PG8_SCHED;
            PG8_LDB(B0, 1, 0); PG8_LDB(B1, 1, 1); PG8_SCHED; PG8_LDA(At, 1, 0); PG8_STAGE(PG8_SA(0, 1), a2, wA[1]);
            PG8_WAIT_V(8); PG8_WAIT_L(0); PG8_BAR; PG8_MMA(0, 0, At, B0); PG8_MMA(0, 1, At, B1); PG8_BAR; PG8_SCHED;
            PG8_LDA(At, 1, 1); PG8_STAGE(PG8_SB(1, 0), b3, voffB); PG8_STAGE(PG8_SB(1, 1), b3 + hstepB, voffB); PG8_STAGE(PG8_SA(1, 0), a3, wA[0]);
            PG8_WAIT_V(8); PG8_WAIT_L(0); PG8_BAR; PG8_MMA(1, 0, At, B0); PG8_MMA(1, 1, At, B1); PG8_BAR; PG8_SCHED;
        }
        if constexpr (ALIGN_EPI) { if (wr == 0) PG8_BAR; }
        if constexpr (FP8) asm volatile("s_nop 15\n\ts_nop 15" ::: "memory");
        E(acc, cur, wr, wc, fr, fq);
        if (!has_next) break;
#pragma unroll
        for (int a = 0; a < 2; ++a)
#pragma unroll
            for (int b = 0; b < 2; ++b)
#pragma unroll
                for (int m = 0; m < 4; ++m)
#pragma unroll
                    for (int n = 0; n < 2; ++n) acc[a][b][m][n] = (f32x4){0.f, 0.f, 0.f, 0.f};
        cur = nxt; cA = nA; ++ui;
        if constexpr (GATHER) {
#pragma unroll
            for (int h = 0; h < 2; ++h)
#pragma unroll
                for (int i = 0; i < 2; ++i) vA[h][i] = nvA[h][i];
        }
        if constexpr (ALIGN_EPI) { if (wr == 1) PG8_BAR; }
    }
    PG8_WAIT_V(0);
    if constexpr (!ALIGN_EPI) { if (wr == 0) PG8_BAR; }
    PG8_BAR;
#undef PG8_SA
#undef PG8_SB
#undef PG8_STAGE
#undef PG8_LDA
#undef PG8_LDB
#undef PG8_MMA
#undef PG8_WAIT_V
#undef PG8_WAIT_L
#undef PG8_BAR
#undef PG8_SCHED
#undef PG8_BP
}
}

struct MArgs {
    const float* in[18]; float* out; unsigned char* ws; int ph_lo, ph_hi, var, pad_;
};

__device__ __forceinline__ void p0_transpose_item(const float* W, int N, int k0, int n0, bf16_t* WT, int dst_row0, int ldk, LAS float* scr, int lane, const float* kscale = nullptr, float fp8scale = 0.f) {
    { const int kr = lane >> 3, g = lane & 7;
      const float* src = W + (size_t)(k0 + kr) * N + n0 + 4 * g;
      f32x4 v[8];
#pragma unroll
      for (int i = 0; i < 8; ++i) v[i] = *(const f32x4*)(src + (size_t)(8 * i) * N);
#pragma unroll
      for (int i = 0; i < 8; ++i) { const int kk = kr + 8 * i; *(LAS f32x4*)(scr + kk * 36 + ((g ^ i) << 2)) = v[i]; } }
    const int c = lane & 7;
    float ks[8];
    if (kscale) { const f32x4 s0 = *(const f32x4*)(kscale + k0 + 8 * c), s1 = *(const f32x4*)(kscale + k0 + 8 * c + 4); ks[0] = s0[0]; ks[1] = s0[1]; ks[2] = s0[2]; ks[3] = s0[3]; ks[4] = s1[0]; ks[5] = s1[1]; ks[6] = s1[2]; ks[7] = s1[3]; }
    else {
#pragma unroll
        for (int j = 0; j < 8; ++j) ks[j] = 1.f; }
    asm volatile("s_waitcnt lgkmcnt(0)" ::: "memory");
#pragma unroll
    for (int j = 0; j < 4; ++j) { const int n = (lane >> 3) + 8 * j; const LAS float* sp = scr + (8 * c) * 36 + ((((n >> 2) ^ c) << 2) | (n & 3));
        if (fp8scale != 0.f) {
            u32x2 o; o.x = pk4_fp8(sp[0 * 36] * ks[0] * fp8scale, sp[1 * 36] * ks[1] * fp8scale, sp[2 * 36] * ks[2] * fp8scale, sp[3 * 36] * ks[3] * fp8scale);
            o.y = pk4_fp8(sp[4 * 36] * ks[4] * fp8scale, sp[5 * 36] * ks[5] * fp8scale, sp[6 * 36] * ks[6] * fp8scale, sp[7 * 36] * ks[7] * fp8scale);
            *(u32x2*)((unsigned char*)WT + (size_t)(dst_row0 + n) * ldk + k0 + 8 * c) = o;
        } else {
        u32x4 o; o.x = pk2(sp[0 * 36] * ks[0], sp[1 * 36] * ks[1]); o.y = pk2(sp[2 * 36] * ks[2], sp[3 * 36] * ks[3]); o.z = pk2(sp[4 * 36] * ks[4], sp[5 * 36] * ks[5]); o.w = pk2(sp[6 * 36] * ks[6], sp[7 * 36] * ks[7]);
        *(u32x4*)(WT + (size_t)(dst_row0 + n) * ldk + k0 + 8 * c) = o; } }
    asm volatile("s_waitcnt lgkmcnt(0)" ::: "memory");
}
__device__ __forceinline__ int inproj_pos(int n) { const int l = n & 255; return (n & ~255) + 128 * ((l >> 5) & 1) + 32 * (l >> 6) + (l & 31); }

__device__ __forceinline__ void phase0(const MArgs& a, LAS unsigned char* lds, int vcu, int G) {
    const int tid = threadIdx.x, lane = tid & 63, wave = __builtin_amdgcn_readfirstlane(tid >> 6);
    unsigned char* ws = a.ws;
    LAS float* scr = (LAS float*)(lds + wave * 16384);
    const int gw = vcu * NWAVES + wave, NGW = G * NWAVES;
    constexpr int I_IN = 16 * 128, I_MK = 16 * 16, I_O = 16 * 32, I_W1 = 32 * 16 * 16, I_W2 = 32 * 8 * 32;
    constexpr int NITEMS = I_IN + I_MK + I_O + 2 * I_W1 + I_W2;
    bf16_t* WinT = (bf16_t*)(ws + WS_WINT); bf16_t* WoT = (bf16_t*)(ws + WS_WOT); bf16_t* W13T = (bf16_t*)(ws + WS_W13T); bf16_t* W2T = (bf16_t*)(ws + WS_W2T);
    for (int it = gw; it < NITEMS; it += NGW) {
        int r = it;
        if (r < I_IN) { const int kb = r / 128, nb = r % 128, pn = nb >> 3; const bool isv = pn == 4 || pn == 5 || (pn >= 12 && pn < 15);
            p0_transpose_item(a.in[3], IN_COLS, kb * 64, nb * 32, isv ? (bf16_t*)(ws + WS_WINT8) : WinT, inproj_pos(nb * 32), DM, scr, lane, a.in[2], isv ? SC_WIN : 0.f); continue; } r -= I_IN;
        if (r < I_MK) { const int kb = r / 16, nb = r % 16; p0_transpose_item(a.in[8], 512, kb * 64, nb * 32, WinT, 4096 + inproj_pos(nb * 32), DM, scr, lane); continue; } r -= I_MK;
        if (r < I_O) { const int kb = r / 32, nb = r % 32; p0_transpose_item(a.in[9], DM, kb * 64, nb * 32, WoT, nb * 32, DM, scr, lane, nullptr, SC_WO); continue; } r -= I_O;
        if (r < 2 * I_W1) { const int which = r / I_W1; r %= I_W1; const int e = r / 256, kb = (r % 256) / 16, nb = r % 16; const int n0 = nb * 32;
            p0_transpose_item(a.in[15 + which] + (size_t)e * DM * DEXP, DEXP, kb * 64, n0, W13T, e * 1024 + 256 * (n0 >> 7) + 128 * which + (n0 & 127), DM, scr, lane, a.in[10], SC_W13); continue; } r -= 2 * I_W1;
        { const int e = r / 256, kb = (r % 256) / 32, nb = r % 32; p0_transpose_item(a.in[17] + (size_t)e * DEXP * DM, DM, kb * 64, nb * 32, W2T, e * 1024 + nb * 32, DEXP, scr, lane, nullptr, SC_W2); }
    }
    bf16_t* XN = (bf16_t*)(ws + WS_XN); float* rstdx = (float*)(ws + WS_RSTDX);
    for (int r = gw; r < MROWS; r += NGW) {
        const bool isx = r < NTOK;
        const float* src = isx ? a.in[0] + (size_t)r * DM : a.in[1] + (size_t)(r - NTOK) * DM;
        const float4* xr = (const float4*)src;
        float4 v[4]; float s = 0.f;
#pragma unroll
        for (int j = 0; j < 4; ++j) { v[j] = xr[lane + 64 * j]; s += v[j].x * v[j].x + v[j].y * v[j].y + v[j].z * v[j].z + v[j].w * v[j].w; }
        s = wave_sum(s);
        const float rstd = rsqrtf(s * (1.f / DM) + EPS);
        if (isx) { if (lane == 0) rstdx[r] = rstd; }
        const float sc = isx ? 1.f : rstd;
#pragma unroll
        for (int j = 0; j < 4; ++j) {
            float4 gg = (float4){1.f, 1.f, 1.f, 1.f}; if (!isx) gg = ((const float4*)a.in[7])[lane + 64 * j];
            u32x2 o; o.x = pk2(v[j].x * sc * gg.x, v[j].y * sc * gg.y); o.y = pk2(v[j].z * sc * gg.z, v[j].w * sc * gg.w);
            ((u32x2*)(XN + (size_t)r * DM))[lane + 64 * j] = o;
            if (isx) ((unsigned*)(ws + WS_XQ + (size_t)r * DM))[lane + 64 * j] = pk4_fp8(v[j].x * SC_XQ, v[j].y * SC_XQ, v[j].z * SC_XQ, v[j].w * SC_XQ);
        }
    }
    { bf16_t* WfH = (bf16_t*)(ws + WS_WRF); bf16_t* WfL = WfH + 32 * 3 * 64 * 8; float* b48 = (float*)(ws + WS_WRF + 2 * 32 * 3 * 64 * 8 * 2);
      for (int t = vcu * NTHREADS + tid; t < 32 * 3 * 64 * 8 + 48; t += G * NTHREADS) {
          if (t < 32 * 3 * 64 * 8) { const int j = t & 7, ln = (t >> 3) & 63, sc = t >> 9, ct = sc % 3, st = sc / 3; const int k = 32 * st + 8 * (ln >> 4) + j, col = 16 * ct + (ln & 15);
              const float w = (col < 4 ? a.in[11][k * 4 + col] : (col < 36 ? a.in[13][k * 32 + col - 4] : 0.f)) * a.in[10][k];
              const bf16_t hi = f2bf(w); WfH[t] = hi; WfL[t] = f2bf(w - bf2f(hi)); }
          else { const int col = t - 32 * 3 * 64 * 8; b48[col] = col < 4 ? a.in[12][col] : (col < 36 ? a.in[14][col - 4] : 0.f); }
      } }
    float* biasD = (float*)(ws + WS_BIASD); float* rpb = (float*)(ws + WS_RPB);
    for (int t = vcu * NTHREADS + tid; t < 8 * 15 * 31; t += G * NTHREADS) {
        if (t < 3 * 4 * 129) { const int j = t % 129, hh = (t / 129) % 4, g = t / (129 * 4); const int dil = g == 0 ? 1 : (g == 1 ? 4 : 16);
            biasD[t] = a.in[6][t5_bucket((j - 64) * dil) * 12 + g * 4 + hh] * LOG2E; }
        rpb[t] = a.in[5][t] * LOG2E;
    }
}

template <bool V8>
struct SchedInProjT {
    static constexpr int NPN = V8 ? 5 : 11;
    static constexpr unsigned long long MAP = V8 ? 0xEDC54ull : 0xFBA98763210ull;
    const char* A; const char* B; int G, c;
    __device__ __forceinline__ bool next(int i, pg8::Unit& u) const {
        const int L = i * G + c; constexpr int NW = 256 * NPN;
        int pm, pn;
        if (L < NW) { const int wgid = pg8::xcd_remap(L, NW); const int nig = pg8::WGM * NPN, gid = wgid / nig, fm = gid * pg8::WGM; pm = fm + ((wgid % nig) % pg8::WGM); pn = (int)((MAP >> (4 * ((wgid % nig) / pg8::WGM))) & 15); }
        else return false;
        constexpr int EB = V8 ? 1 : 2;
        u.A = A + (size_t)pm * 256 * DM * EB; u.B0 = B + (size_t)pn * 256 * DM * EB; u.B1 = u.B0; u.ksplit = 1 << 30; u.e0 = pm; u.e1 = pn; u.e2 = 0; u.e3 = 0;
        return true;
    }
    template <bool GATHER> __device__ __forceinline__ void aoffs(const pg8::Unit&, const int (&sR)[2], const int (&sC)[2], int lda, unsigned (&v)[2][2]) const {
#pragma unroll
        for (int h = 0; h < 2; ++h)
#pragma unroll
            for (int i = 0; i < 2; ++i) v[h][i] = (unsigned)((sR[i] + 128 * h) * lda + sC[i]) * 2u;
    }
};
struct EpiInProj {
    static constexpr bool PERM = true;
    bf16_t* QKV; bf16_t* KVM; const float* gain; const float* rstdx; float ascale;
    __device__ __forceinline__ void operator()(const f32x4 (&acc)[2][2][4][2], const pg8::Unit& u, int wr, int wc, int fr, int fq) const {
        const int pm = u.e0, pn = u.e1;
        int gi = -1; float sc = 1.f; bf16_t* base; int hplane, nrows, rowt;
        if (pn < 16) { base = QKV; hplane = 4 * pn; nrows = NTOK; rowt = pm * 256;
            if (pn < 2) { gi = 0; sc = QSCALE; } else if (pn < 4) gi = 1; else if (pn < 6) gi = -1; else if (pn < 9) { gi = 2; sc = QSCALE; } else if (pn < 12) gi = 3; else if (pn < 15) gi = -1; else { gi = 4; sc = QSCALE; } }
        else { base = KVM; hplane = 4 * (pn - 16); nrows = BATCH * MEM_LEN; rowt = (pm - 256) * 256; gi = pn == 16 ? 5 : -1; }
        float gv[2][2][4];
#pragma unroll
        for (int bj = 0; bj < 2; ++bj)
#pragma unroll
            for (int n = 0; n < 2; ++n)
#pragma unroll
                for (int j = 0; j < 4; ++j) gv[bj][n][j] = gi >= 0 ? gain[gi * 64 + 32 * bj + 8 * fq + 4 * n + j] * sc : 1.f;
#pragma unroll
        for (int ai = 0; ai < 2; ++ai)
#pragma unroll
            for (int m = 0; m < 4; ++m) {
                const float rx = pn < 16 ? rstdx[rowt + ai * 128 + wr * 64 + m * 16 + fr] * ascale : 1.f;
                float ss = 0.f;
#pragma unroll
                for (int bj = 0; bj < 2; ++bj)
#pragma unroll
                    for (int n = 0; n < 2; ++n) { const f32x4 x = acc[ai][bj][m][n]; ss += (x[0] * x[0] + x[1] * x[1]) + (x[2] * x[2] + x[3] * x[3]); }
                ss += __shfl_xor(ss, 16); ss += __shfl_xor(ss, 32);
                const float r = (gi >= 0 ? rsqrtf(ss * (rx * rx) * (1.f / 64.f) + EPS) : 1.f) * rx;
                bf16_t* rowp = base + ((size_t)(hplane + wc) * nrows + (rowt + ai * 128 + wr * 64 + m * 16 + fr)) * 64 + 8 * fq;
#pragma unroll
                for (int bj = 0; bj < 2; ++bj) {
                    const f32x4 v0 = acc[ai][bj][m][0], v1 = acc[ai][bj][m][1];
                    u32x4 w;
                    w.x = cvt_pk_bf16(v0[0] * r * gv[bj][0][0], v0[1] * r * gv[bj][0][1]); w.y = cvt_pk_bf16(v0[2] * r * gv[bj][0][2], v0[3] * r * gv[bj][0][3]);
                    w.z = cvt_pk_bf16(v1[0] * r * gv[bj][1][0], v1[1] * r * gv[bj][1][1]); w.w = cvt_pk_bf16(v1[2] * r * gv[bj][1][2], v1[3] * r * gv[bj][1][3]);
                    *(u32x4*)(rowp + 32 * bj) = w;
                }
            }
    }
};


struct SchedOutProj {
    const char* A; const char* B; int G, c;
    __device__ __forceinline__ bool next(int i, pg8::Unit& u) const {
        const int L = i * G + c; constexpr int NW = 256 * 4;
        if (L >= NW) return false;
        const int wgid = pg8::xcd_remap(L, NW); const int nig = pg8::WGM * 4, gid = wgid / nig, fm = gid * pg8::WGM; const int pm = fm + ((wgid % nig) % pg8::WGM), pn = (wgid % nig) / pg8::WGM;
        u.A = A + (size_t)pm * 256 * DM; u.B0 = B + (size_t)pn * 256 * DM; u.B1 = u.B0; u.ksplit = 1 << 30; u.e0 = pm; u.e1 = pn; u.e2 = 0; u.e3 = 0;
        return true;
    }
    template <bool GATHER> __device__ __forceinline__ void aoffs(const pg8::Unit&, const int (&sR)[2], const int (&sC)[2], int lda, unsigned (&v)[2][2]) const {
#pragma unroll
        for (int h = 0; h < 2; ++h)
#pragma unroll
            for (int i = 0; i < 2; ++i) v[h][i] = (unsigned)((sR[i] + 128 * h) * lda + sC[i]) * 2u;
    }
};
struct EpiOutProj {
    static constexpr bool PERM = true;
    const bf16_t* X; bf16_t* O; unsigned char* Q8;
    __device__ __forceinline__ void operator()(const f32x4 (&acc)[2][2][4][2], const pg8::Unit& u, int wr, int wc, int fr, int fq) const {
        const int row0 = u.e0 * 256 + wr * 64 + fr, col0 = u.e1 * 256 + wc * 32 + 8 * fq;
        u32x4 xv[2][4][2];
#pragma unroll
        for (int ai = 0; ai < 2; ++ai)
#pragma unroll
            for (int m = 0; m < 4; ++m) { const size_t off = (size_t)(row0 + ai * 128 + m * 16) * DM + col0;
#pragma unroll
                for (int bj = 0; bj < 2; ++bj) xv[ai][m][bj] = *(const u32x4*)(X + off + bj * 128); }
#pragma unroll
        for (int ai = 0; ai < 2; ++ai)
#pragma unroll
            for (int m = 0; m < 4; ++m) { const size_t off = (size_t)(row0 + ai * 128 + m * 16) * DM + col0;
#pragma unroll
                for (int bj = 0; bj < 2; ++bj) { const u32x4 w0 = xv[ai][m][bj];
                    const f32x4 x0 = (f32x4){__uint_as_float(w0.x << 16), __uint_as_float(w0.x & 0xffff0000u), __uint_as_float(w0.y << 16), __uint_as_float(w0.y & 0xffff0000u)};
                    const f32x4 x1v = (f32x4){__uint_as_float(w0.z << 16), __uint_as_float(w0.z & 0xffff0000u), __uint_as_float(w0.w << 16), __uint_as_float(w0.w & 0xffff0000u)};
                    const f32x4 v0 = x0 + acc[ai][bj][m][0] * (1.f / (SC_MIX * SC_WO)), v1 = x1v + acc[ai][bj][m][1] * (1.f / (SC_MIX * SC_WO));
                    u32x4 w; w.x = cvt_pk_bf16(v0[0], v0[1]); w.y = cvt_pk_bf16(v0[2], v0[3]); w.z = cvt_pk_bf16(v1[0], v1[1]); w.w = cvt_pk_bf16(v1[2], v1[3]);
                    *(u32x4*)(O + off + bj * 128) = w;
                    u32x2 q; q.x = pk4_fp8(v0[0] * SC_X1, v0[1] * SC_X1, v0[2] * SC_X1, v0[3] * SC_X1); q.y = pk4_fp8(v1[0] * SC_X1, v1[1] * SC_X1, v1[2] * SC_X1, v1[3] * SC_X1);
                    *(u32x2*)(Q8 + off + bj * 128) = q; } }
    }
};

constexpr int TT_OFF = RING_BYTES;
constexpr int TT_PBASE = 1 + 2 * MAXTILES, TT_E = TT_PBASE + NPAIR;
static_assert((TT_E + 1 + 2 * MAXETILES) * 4 <= 16384, "tile tables fit the spare LDS");
__device__ __forceinline__ int moe_build_tiles(LAS unsigned char* lds, const unsigned* count, const unsigned* ecount) {
    LAS int* tt = (LAS int*)(lds + TT_OFF);
    __syncthreads();
    if (threadIdx.x == 0) {
        int nt = 0;
        for (int L = 0; L < NPAIR; ++L) { tt[TT_PBASE + L] = nt; const int c = (int)__hip_atomic_load(count + L, __ATOMIC_RELAXED, __HIP_MEMORY_SCOPE_AGENT); for (int r = 0; r < c; r += 256) { tt[1 + nt] = L; tt[1 + MAXTILES + nt] = r; ++nt; } }
        tt[0] = nt;
    }
    if (threadIdx.x == 64) {
        int ne = 0;
        for (int e = 0; e < NEXP; ++e) { const int c = (int)__hip_atomic_load(ecount + e, __ATOMIC_RELAXED, __HIP_MEMORY_SCOPE_AGENT); for (int r = 0; r < c; r += 256) { tt[TT_E + 1 + ne] = e; tt[TT_E + 1 + MAXETILES + ne] = r; ++ne; } }
        tt[TT_E] = ne;
    }
    __syncthreads();
    return tt[0];
}
struct SchedMoe1 {
    const char* Hb; const char* W13T; const int* elists; const unsigned* ecount; const LAS int* tt; int netiles, G, c;
    __device__ __forceinline__ bool next(int i, pg8::Unit& u) const {
        const int L = i * G + c, nwg = netiles * 4;
        if (L >= nwg) return false;
        const int U = pg8::xcd_remap(L, nwg), T = U >> 2, pn = U & 3;
        const int e = tt[TT_E + 1 + T], row0 = tt[TT_E + 1 + MAXETILES + T];
        u.A = Hb; u.B0 = W13T + ((size_t)e * 1024 + pn * 256) * DM; u.B1 = u.B0; u.ksplit = 1 << 30; u.e0 = T; u.e1 = pn; u.e2 = e; u.e3 = row0;
        return true;
    }
    template <bool GATHER> __device__ __forceinline__ void aoffs(const pg8::Unit& u, const int (&sR)[2], const int (&sC)[2], int lda, unsigned (&v)[2][2]) const {
        const int cnt = (int)ecount[u.e2]; const int* lp = elists + (size_t)u.e2 * NTOK;
#pragma unroll
        for (int h = 0; h < 2; ++h)
#pragma unroll
            for (int i = 0; i < 2; ++i) { int p = u.e3 + 128 * h + sR[i]; p = p < cnt ? p : cnt - 1; const int tok = lp[p] >> 1; v[h][i] = (unsigned)(tok * lda + sC[i]) * 2u; }
    }
};
struct EpiMoe1 {
    static constexpr bool PERM = true;
    bf16_t* ACT; const int* elists; const unsigned* ecount; const float* tokg; const float* trstd; const int* tokP; const LAS int* tt;
    __device__ __forceinline__ void operator()(const f32x4 (&acc)[2][2][4][2], const pg8::Unit& u, int wr, int wc, int fr, int fq) const {
        const int pn = u.e1, e = u.e2, row0 = u.e3;
        const int cnt = (int)ecount[e]; const int* lp = elists + (size_t)e * NTOK;
#pragma unroll
        for (int ai = 0; ai < 2; ++ai)
#pragma unroll
            for (int m = 0; m < 4; ++m) {
                const int p = row0 + ai * 128 + wr * 64 + m * 16 + fr;
                if (p < cnt) {
                    const int ent = lp[p], tok = ent >> 1, role = ent & 1;
                    const float g = tokg[tok * 2 + role] * SC_ACT; const float rs = trstd[tok] * (1.f / (SC_X1 * SC_W13)); const int tp = tokP[tok];
                    const int drow = tt[TT_PBASE + (tp >> 16)] * 256 + (tp & 0xffff);
                    const f32x4 a0 = acc[ai][0][m][0], a1 = acc[ai][0][m][1], b0 = acc[ai][1][m][0], b1 = acc[ai][1][m][1];
                    float o[8];
#pragma unroll
                    for (int j = 0; j < 4; ++j) { const float x0 = a0[j] * rs, x1v = a1[j] * rs; o[j] = x0 / (1.f + __expf(-x0)) * (b0[j] * rs) * g; o[4 + j] = x1v / (1.f + __expf(-x1v)) * (b1[j] * rs) * g; }
#pragma unroll
                    for (int j = 0; j < 8; ++j) o[j] = __builtin_fminf(__builtin_fmaxf(o[j], -448.f), 448.f);
                    u32x2 w; w.x = pk4_fp8(o[0], o[1], o[2], o[3]); w.y = pk4_fp8(o[4], o[5], o[6], o[7]);
                    *(u32x2*)((unsigned char*)ACT + (size_t)drow * DM + 512 * role + 128 * pn + 32 * wc + 8 * fq) = w;
                }
            }
    }
};
struct SchedMoe2 {
    const char* ACTb; const char* W2T; const LAS int* tt; int ntiles, G, c;
    __device__ __forceinline__ bool next(int i, pg8::Unit& u) const {
        const int L = i * G + c, nwg = ntiles * 4;
        if (L >= nwg) return false;
        const int U = pg8::xcd_remap(L, nwg), T = U >> 2, pn = U & 3;
        const int list = tt[1 + T], row0 = tt[1 + MAXTILES + T];
        int ea, eb; pair_experts(list, ea, eb);
        u.A = ACTb + (size_t)T * 256 * DM; u.B0 = W2T + ((size_t)ea * 1024 + pn * 256) * DEXP; u.B1 = W2T + ((size_t)eb * 1024 + pn * 256) * DEXP - 4 * 128; u.ksplit = 4;
        u.e0 = T; u.e1 = pn; u.e2 = list; u.e3 = row0;
        return true;
    }
    template <bool GATHER> __device__ __forceinline__ void aoffs(const pg8::Unit&, const int (&sR)[2], const int (&sC)[2], int lda, unsigned (&v)[2][2]) const {
#pragma unroll
        for (int h = 0; h < 2; ++h)
#pragma unroll
            for (int i = 0; i < 2; ++i) v[h][i] = (unsigned)((sR[i] + 128 * h) * lda + sC[i]) * 2u;
    }
};
struct EpiMoe2 {
    static constexpr bool PERM = true;
    float* O; const bf16_t* X1; const int* lists; const unsigned* count; float scale; int var;
    __device__ __forceinline__ void operator()(const f32x4 (&acc)[2][2][4][2], const pg8::Unit& u, int wr, int wc, int fr, int fq) const {
        if (!MK_ONE_LAUNCH && var == 1) return;
        const int pn = u.e1, list = u.e2, row0 = u.e3;
        const int cnt = (int)count[list]; const int* lp = lists + (size_t)list * NTOK;
        const int col0 = pn * 256 + wc * 32 + 8 * fq;
        int tok[2][4];
#pragma unroll
        for (int ai = 0; ai < 2; ++ai)
#pragma unroll
            for (int m = 0; m < 4; ++m) { const int p = row0 + ai * 128 + wr * 64 + m * 16 + fr; tok[ai][m] = p < cnt ? lp[p] : -1; }
#pragma unroll
        for (int ai = 0; ai < 2; ++ai) {
            u32x4 xv[4][2];
#pragma unroll
            for (int m = 0; m < 4; ++m) { const bf16_t* rowp = X1 + (size_t)(tok[ai][m] < 0 ? 0 : tok[ai][m]) * DM + col0;
#pragma unroll
                for (int bj = 0; bj < 2; ++bj) xv[m][bj] = (!MK_ONE_LAUNCH && var == 3) ? (u32x4){0u, 0u, 0u, 0u} : *(const u32x4*)(rowp + bj * 128); }
            if (!MK_ONE_LAUNCH && var == 2) { unsigned t = 0;
#pragma unroll
                for (int m = 0; m < 4; ++m) t |= xv[m][0].x ^ xv[m][1].y ^ xv[m][0].z ^ xv[m][1].w;
                if (t == 0x12345678u) O[0] = 0.f; continue; }
#pragma unroll
            for (int m = 0; m < 4; ++m) if (tok[ai][m] >= 0) { float* rowp = O + (size_t)tok[ai][m] * DM + col0;
#pragma unroll
                for (int bj = 0; bj < 2; ++bj) { const u32x4 w = xv[m][bj];
                    const f32x4 x0 = (f32x4){__uint_as_float(w.x << 16), __uint_as_float(w.x & 0xffff0000u), __uint_as_float(w.y << 16), __uint_as_float(w.y & 0xffff0000u)};
                    const f32x4 x1v = (f32x4){__uint_as_float(w.z << 16), __uint_as_float(w.z & 0xffff0000u), __uint_as_float(w.w << 16), __uint_as_float(w.w & 0xffff0000u)};
                    *(f32x4*)(rowp + bj * 128) = x0 + acc[ai][bj][m][0] * scale; *(f32x4*)(rowp + bj * 128 + 4) = x1v + acc[ai][bj][m][1] * scale; } }
            asm volatile("" ::: "memory");
        }
    }
};


namespace att {
typedef short v4i16_t __attribute__((ext_vector_type(4)));
typedef short s16x4 __attribute__((ext_vector_type(4)));
typedef float f32x2_t __attribute__((ext_vector_type(2)));
typedef __bf16 bf16x2_t __attribute__((ext_vector_type(2)));
__device__ __forceinline__ unsigned cvtpk(float lo, float hi) { f32x2_t v = {lo, hi}; bf16x2_t b = __builtin_convertvector(v, bf16x2_t); return __builtin_bit_cast(unsigned, b); }
__device__ __forceinline__ s16x4 vtr(const LAS unsigned char* p) { return __builtin_bit_cast(s16x4, __builtin_amdgcn_ds_read_tr16_b64_v4i16((LAS v4i16_t*)p)); }
__device__ __forceinline__ constexpr int crow0(int r) { return (r & 3) + 8 * (r >> 2); }
constexpr float NEG_INF = -__builtin_huge_valf();

constexpr int L_V = 0;
constexpr int L_SO = 65536, SO_PITCH = 136;
constexpr int L_SM = L_SO + 512 * SO_PITCH;
constexpr int L_SL = L_SM + 2048;
constexpr int L_BIAS = L_SL + 2048;
constexpr int L_NATAB = L_SO;
static_assert(L_BIAS + 4096 <= LDS_BYTES - 256 && 8 * 576 * 4 <= 512 * SO_PITCH, "attention LDS map");

struct Ctx {
    int lane, q, h;
    LAS unsigned char* vl;
    unsigned vw, vr0, vr1;
    unsigned kw, kr;
};
__device__ __forceinline__ Ctx make_ctx(LAS unsigned char* lds, int wave, int lane) {
    Ctx c; c.lane = lane; c.q = lane & 31; c.h = lane >> 5; c.vl = lds + L_V + wave * 8192;
    { const int key = lane >> 3, ch = lane & 7, swz = ((key >> 1) & 1) << 2; c.vw = (unsigned)(key * 128 + ((ch ^ swz) << 4)); }
    { const int qp = (lane & 15) >> 2, p = lane & 3, sub = (lane >> 4) & 1, swz = ((qp >> 1) & 1) << 2, x = 2 * sub + (p >> 1);
      c.vr0 = (unsigned)((4 * c.h + qp) * 128 + (((0 ^ swz) + x) << 4) + (p & 1) * 8);
      c.vr1 = (unsigned)((4 * c.h + qp) * 128 + (((4 ^ swz) + x) << 4) + (p & 1) * 8); }
    c.kw = (unsigned)((lane >> 3) * 128);
    c.kr = (unsigned)((lane & 31) * 128);
    return c;
}

template <class Spec>
__device__ __forceinline__ void tile_core(const Spec& sp, const Ctx& c, int t, const LAS unsigned char* vt, const LAS unsigned char* kt, const bf16x8 (&qf)[4], float& m, float& l, f32x16& o0, f32x16& o1);
template <bool LOAD, class Spec>
__device__ __forceinline__ void tile_step(const Spec& sp, const Ctx& c, int t, int tnext, u32x4 (&kreg)[4], u32x4 (&vreg)[4], const bf16x8 (&qf)[4], float& m, float& l, f32x16& o0, f32x16& o1) {
    const int key_lo = c.lane >> 3, chn = c.lane & 7;
#pragma unroll
    for (int i = 0; i < 4; ++i) {
        *(LAS u32x4*)(c.vl + c.vw + i * 1024) = vreg[i];
        const int ksw = ((key_lo >> 1) + 4 * i) & 7;
        *(LAS u32x4*)(c.vl + 4096 + c.kw + i * 1024 + ((chn ^ ksw) << 4)) = kreg[i];
    }
    if constexpr (LOAD) { sp.loadKV(tnext, kreg, vreg); __builtin_amdgcn_sched_barrier(0); }
    tile_core(sp, c, t, c.vl, c.vl + 4096, qf, m, l, o0, o1);
}
template <class Spec>
__device__ __forceinline__ void tile_core(const Spec& sp, const Ctx& c, int t, const LAS unsigned char* vt, const LAS unsigned char* kt, const bf16x8 (&qf)[4], float& m, float& l, f32x16& o0, f32x16& o1) {
    bf16x8 kf[4];
    { const int ksw = ((c.lane & 31) >> 1) & 7;
#pragma unroll
      for (int ks = 0; ks < 4; ++ks) kf[ks] = *(const LAS bf16x8*)(kt + c.kr + (((2 * ks + c.h) ^ ksw) << 4)); }
    f32x16 s;
#pragma unroll
    for (int r = 0; r < 16; ++r) s[r] = 0.f;
#pragma unroll
    for (int ks = 0; ks < 4; ++ks) s = __builtin_amdgcn_mfma_f32_32x32x16_bf16(kf[ks], qf[ks], s, 0, 0, 0);
    sp.bias(t, s);
    float mx = s[0];
#pragma unroll
    for (int r = 1; r < 16; ++r) mx = fmaxf(mx, s[r]);
    { auto rr = __builtin_amdgcn_permlane32_swap(__float_as_uint(mx), __float_as_uint(mx), false, false); mx = fmaxf(__uint_as_float(rr[0]), __uint_as_float(rr[1])); }
    const float mn = fmaxf(m, mx);
    if (__any(mn > m)) {
        const float al = __builtin_amdgcn_exp2f(m - mn);
        l *= al;
#pragma unroll
        for (int r = 0; r < 16; ++r) { o0[r] *= al; o1[r] *= al; }
        m = mn;
    }
    float ps = 0.f;
#pragma unroll
    for (int r = 0; r < 16; ++r) { s[r] = __builtin_amdgcn_exp2f(s[r] - m); ps += s[r]; }
    l += ps;
    bf16x8 pf[2];
#pragma unroll
    for (int s2 = 0; s2 < 2; ++s2) { u32x4 w; w.x = cvtpk(s[8 * s2 + 0], s[8 * s2 + 1]); w.y = cvtpk(s[8 * s2 + 2], s[8 * s2 + 3]); w.z = cvtpk(s[8 * s2 + 4], s[8 * s2 + 5]); w.w = cvtpk(s[8 * s2 + 6], s[8 * s2 + 7]); pf[s2] = __builtin_bit_cast(bf16x8, w); }
#pragma unroll
    for (int s2 = 0; s2 < 2; ++s2) {
        const s16x4 a0 = vtr(vt + c.vr0 + s2 * 2048), a1 = vtr(vt + c.vr0 + s2 * 2048 + 1024);
        const s16x4 b0 = vtr(vt + c.vr1 + s2 * 2048), b1 = vtr(vt + c.vr1 + s2 * 2048 + 1024);
        const bf16x8 v0 = (bf16x8){a0[0], a0[1], a0[2], a0[3], a1[0], a1[1], a1[2], a1[3]};
        const bf16x8 v1 = (bf16x8){b0[0], b0[1], b0[2], b0[3], b1[0], b1[1], b1[2], b1[3]};
        o0 = __builtin_amdgcn_mfma_f32_32x32x16_bf16(v0, pf[s2], o0, 0, 0, 0);
        o1 = __builtin_amdgcn_mfma_f32_32x32x16_bf16(v1, pf[s2], o1, 0, 0, 0);
    }
}

struct QState { float m, l; f32x16 o0, o1; };
__device__ __forceinline__ void softmax_tile(f32x16& s, QState& st, bf16x8 (&pf)[2]) {
    float mx = s[0];
#pragma unroll
    for (int r = 1; r < 16; ++r) mx = fmaxf(mx, s[r]);
    { auto rr = __builtin_amdgcn_permlane32_swap(__float_as_uint(mx), __float_as_uint(mx), false, false); mx = fmaxf(__uint_as_float(rr[0]), __uint_as_float(rr[1])); }
    const float mn = fmaxf(st.m, mx);
    if (__any(mn > st.m)) {
        const float al = __builtin_amdgcn_exp2f(st.m - mn);
        st.l *= al;
#pragma unroll
        for (int r = 0; r < 16; ++r) { st.o0[r] *= al; st.o1[r] *= al; }
        st.m = mn;
    }
    float ps = 0.f;
#pragma unroll
    for (int r = 0; r < 16; ++r) { s[r] = __builtin_amdgcn_exp2f(s[r] - st.m); ps += s[r]; }
    st.l += ps;
#pragma unroll
    for (int s2 = 0; s2 < 2; ++s2) { u32x4 w; w.x = cvtpk(s[8 * s2 + 0], s[8 * s2 + 1]); w.y = cvtpk(s[8 * s2 + 2], s[8 * s2 + 3]); w.z = cvtpk(s[8 * s2 + 4], s[8 * s2 + 5]); w.w = cvtpk(s[8 * s2 + 6], s[8 * s2 + 7]); pf[s2] = __builtin_bit_cast(bf16x8, w); }
}
__device__ __forceinline__ void tile_core2(const Ctx& c, const LAS unsigned char* vt, const LAS unsigned char* kt, const bf16x8 (&qa)[4], const bf16x8 (&qb)[4], QState& A, QState& B) {
    bf16x8 kf[4];
    { const int ksw = ((c.lane & 31) >> 1) & 7;
#pragma unroll
      for (int ks = 0; ks < 4; ++ks) kf[ks] = *(const LAS bf16x8*)(kt + c.kr + (((2 * ks + c.h) ^ ksw) << 4)); }
    f32x16 sa, sb;
#pragma unroll
    for (int r = 0; r < 16; ++r) { sa[r] = 0.f; sb[r] = 0.f; }
#pragma unroll
    for (int ks = 0; ks < 4; ++ks) { sa = __builtin_amdgcn_mfma_f32_32x32x16_bf16(kf[ks], qa[ks], sa, 0, 0, 0); sb = __builtin_amdgcn_mfma_f32_32x32x16_bf16(kf[ks], qb[ks], sb, 0, 0, 0); }
    bf16x8 pa[2], pb[2];
    softmax_tile(sa, A, pa); softmax_tile(sb, B, pb);
#pragma unroll
    for (int s2 = 0; s2 < 2; ++s2) {
        const s16x4 a0 = vtr(vt + c.vr0 + s2 * 2048), a1 = vtr(vt + c.vr0 + s2 * 2048 + 1024);
        const s16x4 b0 = vtr(vt + c.vr1 + s2 * 2048), b1 = vtr(vt + c.vr1 + s2 * 2048 + 1024);
        const bf16x8 v0 = (bf16x8){a0[0], a0[1], a0[2], a0[3], a1[0], a1[1], a1[2], a1[3]};
        const bf16x8 v1 = (bf16x8){b0[0], b0[1], b0[2], b0[3], b1[0], b1[1], b1[2], b1[3]};
        A.o0 = __builtin_amdgcn_mfma_f32_32x32x16_bf16(v0, pa[s2], A.o0, 0, 0, 0); A.o1 = __builtin_amdgcn_mfma_f32_32x32x16_bf16(v1, pa[s2], A.o1, 0, 0, 0);
        B.o0 = __builtin_amdgcn_mfma_f32_32x32x16_bf16(v0, pb[s2], B.o0, 0, 0, 0); B.o1 = __builtin_amdgcn_mfma_f32_32x32x16_bf16(v1, pb[s2], B.o1, 0, 0, 0);
    }
}

__device__ __forceinline__ void dma16(__amdgpu_buffer_rsrc_t rs, LAS unsigned char* dst, int vo, int so) { __builtin_amdgcn_raw_ptr_buffer_load_lds(rs, (LAS void*)dst, 16, vo, so, 0, 0); }
__device__ __forceinline__ unsigned lds_u32(const LAS unsigned char* p) { return (unsigned)(uintptr_t)p; }
template <class Spec>
__device__ __forceinline__ void run_dma(const Spec& sp, const Ctx& c, const bf16x8 (&qf)[4], float& m, float& l, f32x16& o0, f32x16& o1) {
    constexpr int NT = Spec::NT;
    LAS unsigned char* vt = c.vl; LAS unsigned char* kt = c.vl + 4096;
    unsigned ka[4];
    { const int ksw = ((c.lane & 31) >> 1) & 7;
#pragma unroll
      for (int ks = 0; ks < 4; ++ks) ka[ks] = lds_u32(kt) + c.kr + (((2 * ks + c.h) ^ ksw) << 4); }
    const unsigned va0 = lds_u32(vt) + c.vr0, va1 = lds_u32(vt) + c.vr1;
    asm volatile("s_waitcnt vmcnt(0) lgkmcnt(0)" ::: "memory");
    sp.dmaK(0, kt); sp.dmaV(0, vt);
    __builtin_amdgcn_sched_barrier(0);
#pragma unroll 1
    for (int t = 0; t < NT; ++t) {
        const bool more = t + 1 < NT;
        asm volatile("s_waitcnt vmcnt(4)" ::: "memory");
        bf16x8 kf0, kf1, kf2, kf3;
        asm volatile("ds_read_b128 %0, %1" : "=v"(kf0) : "v"(ka[0]) : "memory");
        asm volatile("ds_read_b128 %0, %1" : "=v"(kf1) : "v"(ka[1]) : "memory");
        asm volatile("ds_read_b128 %0, %1" : "=v"(kf2) : "v"(ka[2]) : "memory");
        asm volatile("ds_read_b128 %0, %1" : "=v"(kf3) : "v"(ka[3]) : "memory");
        asm volatile("s_waitcnt lgkmcnt(0)" : "+v"(kf0), "+v"(kf1), "+v"(kf2), "+v"(kf3) :: "memory");
        __builtin_amdgcn_sched_barrier(0);
        if (more) sp.dmaK(t + 1, kt);
        __builtin_amdgcn_sched_barrier(0);
        f32x16 s;
#pragma unroll
        for (int r = 0; r < 16; ++r) s[r] = 0.f;
        s = __builtin_amdgcn_mfma_f32_32x32x16_bf16(kf0, qf[0], s, 0, 0, 0); s = __builtin_amdgcn_mfma_f32_32x32x16_bf16(kf1, qf[1], s, 0, 0, 0);
        s = __builtin_amdgcn_mfma_f32_32x32x16_bf16(kf2, qf[2], s, 0, 0, 0); s = __builtin_amdgcn_mfma_f32_32x32x16_bf16(kf3, qf[3], s, 0, 0, 0);
        sp.bias(t, s);
        QState st; bf16x8 pf[2];
        st.m = m; st.l = l; st.o0 = o0; st.o1 = o1;
        softmax_tile(s, st, pf);
        m = st.m; l = st.l; o0 = st.o0; o1 = st.o1;
        __builtin_amdgcn_sched_barrier(0);
        if (more) asm volatile("s_waitcnt vmcnt(4)" ::: "memory"); else asm volatile("s_waitcnt vmcnt(0)" ::: "memory");
        s16x4 a0, a1, a2, a3, b0, b1, b2, b3;
        asm volatile("ds_read_b64_tr_b16 %0, %1" : "=v"(a0) : "v"(va0) : "memory");
        asm volatile("ds_read_b64_tr_b16 %0, %1 offset:1024" : "=v"(a1) : "v"(va0) : "memory");
        asm volatile("ds_read_b64_tr_b16 %0, %1 offset:2048" : "=v"(a2) : "v"(va0) : "memory");
        asm volatile("ds_read_b64_tr_b16 %0, %1 offset:3072" : "=v"(a3) : "v"(va0) : "memory");
        asm volatile("ds_read_b64_tr_b16 %0, %1" : "=v"(b0) : "v"(va1) : "memory");
        asm volatile("ds_read_b64_tr_b16 %0, %1 offset:1024" : "=v"(b1) : "v"(va1) : "memory");
        asm volatile("ds_read_b64_tr_b16 %0, %1 offset:2048" : "=v"(b2) : "v"(va1) : "memory");
        asm volatile("ds_read_b64_tr_b16 %0, %1 offset:3072" : "=v"(b3) : "v"(va1) : "memory");
        asm volatile("s_waitcnt lgkmcnt(0)" : "+v"(a0), "+v"(a1), "+v"(a2), "+v"(a3), "+v"(b0), "+v"(b1), "+v"(b2), "+v"(b3) :: "memory");
        __builtin_amdgcn_sched_barrier(0);
        if (more) sp.dmaV(t + 1, vt);
        __builtin_amdgcn_sched_barrier(0);
        const bf16x8 v00 = (bf16x8){a0[0], a0[1], a0[2], a0[3], a1[0], a1[1], a1[2], a1[3]}, v01 = (bf16x8){a2[0], a2[1], a2[2], a2[3], a3[0], a3[1], a3[2], a3[3]};
        const bf16x8 v10 = (bf16x8){b0[0], b0[1], b0[2], b0[3], b1[0], b1[1], b1[2], b1[3]}, v11 = (bf16x8){b2[0], b2[1], b2[2], b2[3], b3[0], b3[1], b3[2], b3[3]};
        o0 = __builtin_amdgcn_mfma_f32_32x32x16_bf16(v00, pf[0], o0, 0, 0, 0); o1 = __builtin_amdgcn_mfma_f32_32x32x16_bf16(v10, pf[0], o1, 0, 0, 0);
        o0 = __builtin_amdgcn_mfma_f32_32x32x16_bf16(v01, pf[1], o0, 0, 0, 0); o1 = __builtin_amdgcn_mfma_f32_32x32x16_bf16(v11, pf[1], o1, 0, 0, 0);
    }
}

__device__ __forceinline__ void load_q_asm(const unsigned char* qrow, int h, bf16x8& q0, bf16x8& q1, bf16x8& q2, bf16x8& q3) {
    const unsigned char* p = qrow + 16 * h;
    asm volatile("global_load_dwordx4 %0, %1, off" : "=v"(q0) : "v"(p) : "memory");
    asm volatile("global_load_dwordx4 %0, %1, off offset:32" : "=v"(q1) : "v"(p) : "memory");
    asm volatile("global_load_dwordx4 %0, %1, off offset:64" : "=v"(q2) : "v"(p) : "memory");
    asm volatile("global_load_dwordx4 %0, %1, off offset:96" : "=v"(q3) : "v"(p) : "memory");
}
template <class Spec>
__device__ __forceinline__ void run_dma_x(const Spec& sp, const Ctx& c, bf16x8& q0, bf16x8& q1, bf16x8& q2, bf16x8& q3, QState& st,
                                          bool first, bool hn, __amdgpu_buffer_rsrc_t rsn, int rw0n, const unsigned char* qrow_n) {
    constexpr int NT = Spec::NT;
    LAS unsigned char* vt = c.vl; LAS unsigned char* kt = c.vl + 4096;
    unsigned ka[4];
    { const int ksw = ((c.lane & 31) >> 1) & 7;
#pragma unroll
      for (int ks = 0; ks < 4; ++ks) ka[ks] = lds_u32(kt) + c.kr + (((2 * ks + c.h) ^ ksw) << 4); }
    const unsigned va0 = lds_u32(vt) + c.vr0, va1 = lds_u32(vt) + c.vr1;
#pragma unroll 1
    for (int t = 0; t < NT; ++t) {
        const bool lastt = t + 1 == NT;
        if (t == 0 && !first) asm volatile("s_waitcnt vmcnt(6)" ::: "memory"); else asm volatile("s_waitcnt vmcnt(4)" ::: "memory");
        bf16x8 kf0, kf1, kf2, kf3;
        asm volatile("ds_read_b128 %0, %1" : "=v"(kf0) : "v"(ka[0]) : "memory");
        asm volatile("ds_read_b128 %0, %1" : "=v"(kf1) : "v"(ka[1]) : "memory");
        asm volatile("ds_read_b128 %0, %1" : "=v"(kf2) : "v"(ka[2]) : "memory");
        asm volatile("ds_read_b128 %0, %1" : "=v"(kf3) : "v"(ka[3]) : "memory");
        asm volatile("s_waitcnt lgkmcnt(0)" : "+v"(kf0), "+v"(kf1), "+v"(kf2), "+v"(kf3) :: "memory");
        __builtin_amdgcn_sched_barrier(0);
        if (!lastt) sp.dmaK(t + 1, kt);
        __builtin_amdgcn_sched_barrier(0);
        f32x16 s;
#pragma unroll
        for (int r = 0; r < 16; ++r) s[r] = 0.f;
        s = __builtin_amdgcn_mfma_f32_32x32x16_bf16(kf0, q0, s, 0, 0, 0); s = __builtin_amdgcn_mfma_f32_32x32x16_bf16(kf1, q1, s, 0, 0, 0);
        s = __builtin_amdgcn_mfma_f32_32x32x16_bf16(kf2, q2, s, 0, 0, 0); s = __builtin_amdgcn_mfma_f32_32x32x16_bf16(kf3, q3, s, 0, 0, 0);
        if (lastt && hn) {
            __builtin_amdgcn_sched_barrier(0);
            load_q_asm(qrow_n, c.h, q0, q1, q2, q3); sp.dmaK_n(rsn, rw0n, kt);
            __builtin_amdgcn_sched_barrier(0);
        }
        sp.bias(t, s);
        bf16x8 pf[2];
        softmax_tile(s, st, pf);
        __builtin_amdgcn_sched_barrier(0);
        if (t == 0 && !first) asm volatile("s_waitcnt vmcnt(6)" ::: "memory");
        else if (lastt) { if (hn) asm volatile("s_waitcnt vmcnt(8)" ::: "memory"); else asm volatile("s_waitcnt vmcnt(0)" ::: "memory"); }
        else asm volatile("s_waitcnt vmcnt(4)" ::: "memory");
        s16x4 a0, a1, a2, a3, b0, b1, b2, b3;
        asm volatile("ds_read_b64_tr_b16 %0, %1" : "=v"(a0) : "v"(va0) : "memory");
        asm volatile("ds_read_b64_tr_b16 %0, %1 offset:1024" : "=v"(a1) : "v"(va0) : "memory");
        asm volatile("ds_read_b64_tr_b16 %0, %1 offset:2048" : "=v"(a2) : "v"(va0) : "memory");
        asm volatile("ds_read_b64_tr_b16 %0, %1 offset:3072" : "=v"(a3) : "v"(va0) : "memory");
        asm volatile("ds_read_b64_tr_b16 %0, %1" : "=v"(b0) : "v"(va1) : "memory");
        asm volatile("ds_read_b64_tr_b16 %0, %1 offset:1024" : "=v"(b1) : "v"(va1) : "memory");
        asm volatile("ds_read_b64_tr_b16 %0, %1 offset:2048" : "=v"(b2) : "v"(va1) : "memory");
        asm volatile("ds_read_b64_tr_b16 %0, %1 offset:3072" : "=v"(b3) : "v"(va1) : "memory");
        asm volatile("s_waitcnt lgkmcnt(0)" : "+v"(a0), "+v"(a1), "+v"(a2), "+v"(a3), "+v"(b0), "+v"(b1), "+v"(b2), "+v"(b3) :: "memory");
        __builtin_amdgcn_sched_barrier(0);
        if (!lastt) sp.dmaV(t + 1, vt); else if (hn) sp.dmaV_n(rsn, rw0n, vt);
        __builtin_amdgcn_sched_barrier(0);
        const bf16x8 v00 = (bf16x8){a0[0], a0[1], a0[2], a0[3], a1[0], a1[1], a1[2], a1[3]}, v01 = (bf16x8){a2[0], a2[1], a2[2], a2[3], a3[0], a3[1], a3[2], a3[3]};
        const bf16x8 v10 = (bf16x8){b0[0], b0[1], b0[2], b0[3], b1[0], b1[1], b1[2], b1[3]}, v11 = (bf16x8){b2[0], b2[1], b2[2], b2[3], b3[0], b3[1], b3[2], b3[3]};
        st.o0 = __builtin_amdgcn_mfma_f32_32x32x16_bf16(v00, pf[0], st.o0, 0, 0, 0); st.o1 = __builtin_amdgcn_mfma_f32_32x32x16_bf16(v10, pf[0], st.o1, 0, 0, 0);
        st.o0 = __builtin_amdgcn_mfma_f32_32x32x16_bf16(v01, pf[1], st.o0, 0, 0, 0); st.o1 = __builtin_amdgcn_mfma_f32_32x32x16_bf16(v11, pf[1], st.o1, 0, 0, 0);
    }
}
template <class Spec>
__device__ __forceinline__ void run(const Spec& sp, const Ctx& c, const bf16x8 (&qf)[4], float& m, float& l, f32x16& o0, f32x16& o1) {
    constexpr int NT = Spec::NT;
    static_assert(NT >= 4, "tile loop is peeled for NT >= 4");
    u32x4 kA[4], vA[4], kB[4], vB[4];
    sp.loadKV(0, kA, vA); sp.loadKV(1, kB, vB);
    int t = 0;
#pragma unroll 1
    for (; t + 3 < NT; t += 2) {
        tile_step<true>(sp, c, t, t + 2, kA, vA, qf, m, l, o0, o1);
        tile_step<true>(sp, c, t + 1, t + 3, kB, vB, qf, m, l, o0, o1);
    }
    if constexpr ((NT & 1) == 0) {
        tile_step<false>(sp, c, NT - 2, 0, kA, vA, qf, m, l, o0, o1);
        tile_step<false>(sp, c, NT - 1, 0, kB, vB, qf, m, l, o0, o1);
    } else {
        tile_step<true>(sp, c, NT - 3, NT - 1, kA, vA, qf, m, l, o0, o1);
        tile_step<false>(sp, c, NT - 2, 0, kB, vB, qf, m, l, o0, o1);
        tile_step<false>(sp, c, NT - 1, 0, kA, vA, qf, m, l, o0, o1);
    }
}
__device__ __forceinline__ float pair_sum(float v) { auto rr = __builtin_amdgcn_permlane32_swap(__float_as_uint(v), __float_as_uint(v), false, false); return __uint_as_float(rr[0]) + __uint_as_float(rr[1]); }
template <class P> __device__ __forceinline__ void store_o(P rowp, const f32x16& o0, const f32x16& o1, float inv, int h) {
#pragma unroll
    for (int g4 = 0; g4 < 4; ++g4) {
        u32x2 w0, w1; w0.x = cvtpk(o0[4 * g4] * inv, o0[4 * g4 + 1] * inv); w0.y = cvtpk(o0[4 * g4 + 2] * inv, o0[4 * g4 + 3] * inv);
        w1.x = cvtpk(o1[4 * g4] * inv, o1[4 * g4 + 1] * inv); w1.y = cvtpk(o1[4 * g4 + 2] * inv, o1[4 * g4 + 3] * inv);
        *(u32x2*)(rowp + (8 * g4 + 4 * h) * 2) = w0; *(u32x2*)(rowp + (32 + 8 * g4 + 4 * h) * 2) = w1;
    }
}
__device__ __forceinline__ void store_o8(unsigned char* rowp, const f32x16& o0, const f32x16& o1, float inv, int h) {
    const float sc = inv * SC_MIX;
    unsigned w[8];
#pragma unroll
    for (int g4 = 0; g4 < 4; ++g4) {
        const unsigned a = pk4_fp8(o0[4 * g4] * sc, o0[4 * g4 + 1] * sc, o0[4 * g4 + 2] * sc, o0[4 * g4 + 3] * sc);
        const unsigned b = pk4_fp8(o1[4 * g4] * sc, o1[4 * g4 + 1] * sc, o1[4 * g4 + 2] * sc, o1[4 * g4 + 3] * sc);
        auto rr = __builtin_amdgcn_permlane32_swap(a, b, false, false);
        w[2 * g4] = rr[0]; w[2 * g4 + 1] = rr[1];
    }
    *(u32x4*)(rowp + 32 * h) = (u32x4){w[0], w[1], w[2], w[3]}; *(u32x4*)(rowp + 32 * h + 16) = (u32x4){w[4], w[5], w[6], w[7]};
}
__device__ __forceinline__ void load_q(const unsigned char* qrow, int h, bf16x8 (&qf)[4]) {
#pragma unroll
    for (int ks = 0; ks < 4; ++ks) qf[ks] = *(const bf16x8*)(qrow + (16 * ks + 8 * h) * 2);
}

__device__ __forceinline__ u32x4 bload(__amdgpu_buffer_rsrc_t rs, int vo, int so) { return __builtin_amdgcn_raw_buffer_load_b128(rs, vo, so, 0); }
constexpr int NA_NEGIDX = 544;
struct SpecNA {
    static constexpr int NT = 9;
    __amdgpu_buffer_rsrc_t rs; int vo[4]; int rw0, kcolK, kcolV;
    int qr, r0q, bidx; const LAS float* btab; f32x16 madd;
    int dk0, dk1, dv0;
    __device__ __forceinline__ void dmaK(int t, LAS unsigned char* kt) const { int row = rw0 + t; row = row > GRID_R - 1 ? GRID_R - 1 : row; const int so = row * (GRID_W * 128) + kcolK;
        dma16(rs, kt, dk0, so); dma16(rs, kt + 1024, dk1, so + 1024); dma16(rs, kt + 2048, dk0, so + 2048); dma16(rs, kt + 3072, dk1, so + 3072); }
    __device__ __forceinline__ void dmaV(int t, LAS unsigned char* vt) const { int row = rw0 + t; row = row > GRID_R - 1 ? GRID_R - 1 : row; const int so = row * (GRID_W * 128) + kcolV;
        dma16(rs, vt, dv0, so); dma16(rs, vt + 1024, dv0, so + 1024); dma16(rs, vt + 2048, dv0, so + 2048); dma16(rs, vt + 3072, dv0, so + 3072); }
    __device__ __forceinline__ void dmaK_n(__amdgpu_buffer_rsrc_t rsn, int rw0n, LAS unsigned char* kt) const { const int so = rw0n * (GRID_W * 128) + kcolK;
        dma16(rsn, kt, dk0, so); dma16(rsn, kt + 1024, dk1, so + 1024); dma16(rsn, kt + 2048, dk0, so + 2048); dma16(rsn, kt + 3072, dk1, so + 3072); }
    __device__ __forceinline__ void dmaV_n(__amdgpu_buffer_rsrc_t rsn, int rw0n, LAS unsigned char* vt) const { const int so = rw0n * (GRID_W * 128) + kcolV;
        dma16(rsn, vt, dv0, so); dma16(rsn, vt + 1024, dv0, so + 1024); dma16(rsn, vt + 2048, dv0, so + 2048); dma16(rsn, vt + 3072, dv0, so + 3072); }
    __device__ __forceinline__ void loadKV(int t, u32x4 (&kr)[4], u32x4 (&vr)[4]) const {
        int row = rw0 + t; row = row > GRID_R - 1 ? GRID_R - 1 : row; const int so = row * (GRID_W * 128);
#pragma unroll
        for (int i = 0; i < 4; ++i) { kr[i] = bload(rs, vo[i], so + kcolK); vr[i] = bload(rs, vo[i], so + kcolV); } }
    __device__ __forceinline__ void bias(int t, f32x16& s) const {
        const int row = rw0 + t; const bool rv = (unsigned)(row - r0q) < 8u;
        const int idx = rv ? bidx + (row - qr + 7) * 31 : NA_NEGIDX;
        float bv[16];
#pragma unroll
        for (int rg = 0; rg < 16; ++rg) bv[rg] = btab[idx + crow0(rg)];
#pragma unroll
        for (int rg = 0; rg < 16; ++rg) asm volatile("" : "+v"(bv[rg]));
#pragma unroll
        for (int rg = 0; rg < 16; ++rg) s[rg] = (s[rg] + bv[rg]) + madd[rg];
    }
};
struct SpecDil {
    static constexpr int NT = 5;
    __amdgpu_buffer_rsrc_t rs; int pi[4]; int cb, kcolK, kcolV;
    int pos0, dil, q, h; const LAS float* btab;
    int ck0, ck1, cv0;
    __device__ __forceinline__ int cl(int p) const { return p < 0 ? 0 : (p > SEQ - 1 ? SEQ - 1 : p); }
    __device__ __forceinline__ void dmaK(int t, LAS unsigned char* kt) const { const int d = 32 * dil * t;
        dma16(rs, kt, cl(pi[0] + d) * 128 + ck0, kcolK); dma16(rs, kt + 1024, cl(pi[1] + d) * 128 + ck1, kcolK); dma16(rs, kt + 2048, cl(pi[2] + d) * 128 + ck0, kcolK); dma16(rs, kt + 3072, cl(pi[3] + d) * 128 + ck1, kcolK); }
    __device__ __forceinline__ void dmaV(int t, LAS unsigned char* vt) const { const int d = 32 * dil * t;
        dma16(rs, vt, cl(pi[0] + d) * 128 + cv0, kcolV); dma16(rs, vt + 1024, cl(pi[1] + d) * 128 + cv0, kcolV); dma16(rs, vt + 2048, cl(pi[2] + d) * 128 + cv0, kcolV); dma16(rs, vt + 3072, cl(pi[3] + d) * 128 + cv0, kcolV); }
    __device__ __forceinline__ void loadKV(int t, u32x4 (&kr)[4], u32x4 (&vr)[4]) const {
#pragma unroll
        for (int i = 0; i < 4; ++i) { int p = pi[i] + 32 * dil * t; p = p < 0 ? 0 : (p > SEQ - 1 ? SEQ - 1 : p); const int vo = p * 128 + cb; kr[i] = bload(rs, vo, kcolK); vr[i] = bload(rs, vo, kcolV); } }
    __device__ __forceinline__ void bias(int t, f32x16& s) const {
        const int idx = 32 + 32 * t + 4 * h - q;
        float bv[16];
#pragma unroll
        for (int rg = 0; rg < 16; ++rg) bv[rg] = btab[idx + crow0(rg)];
#pragma unroll
        for (int rg = 0; rg < 16; ++rg) asm volatile("" : "+v"(bv[rg]));
#pragma unroll
        for (int rg = 0; rg < 16; ++rg) s[rg] += bv[rg];
        const int lo = pos0 + dil * (-64 + 32 * t);
        if (lo < 0 || lo + 31 * dil >= SEQ) {
            const int pb = lo + dil * 4 * h;
#pragma unroll
            for (int rg = 0; rg < 16; ++rg) { const int pk = pb + dil * crow0(rg); s[rg] = ((unsigned)pk < (unsigned)SEQ) ? s[rg] : NEG_INF; }
        }
    }
};
struct SpecMem {
    static constexpr int NT = 8;
    __amdgpu_buffer_rsrc_t rs; int vo[4];
    __device__ __forceinline__ void loadKV(int t, u32x4 (&kr)[4], u32x4 (&vr)[4]) const {
        const int so = t * 32 * 128;
#pragma unroll
        for (int i = 0; i < 4; ++i) { kr[i] = bload(rs, vo[i], so); vr[i] = bload(rs, vo[i], so + 4 * BATCH * MEM_LEN * 128); } }
    __device__ __forceinline__ void bias(int, f32x16&) const {}
};

__device__ __forceinline__ void phase2(const MArgs& a, LAS unsigned char* lds, int vcu, int G) {
    const int tid = threadIdx.x, lane = tid & 63, wave = __builtin_amdgcn_readfirstlane(tid >> 6);
    const Ctx c = make_ctx(lds, wave, lane);
    const unsigned char* QKV = a.ws + WS_QKV; const unsigned char* KVM = a.ws + WS_KVM; unsigned char* MIX = a.ws + WS_MIX;
    const float* rpb = (const float*)(a.ws + WS_RPB); const float* biasD = (const float*)(a.ws + WS_BIASD);
    LAS float* lb = (LAS float*)(lds + L_BIAS);
    const int key_lo = lane >> 3, chunk16 = (lane & 7) * 16;
    const int parts = (!MK_ONE_LAUNCH && a.ph_lo >= 20) ? 1 << (a.ph_lo - 20) : 7;
    if (parts & 1) { LAS float* nt = (LAS float*)(lds + L_NATAB);
      __syncthreads();
      for (int i = tid; i < 8 * 576; i += NTHREADS) { const int hd = i / 576, j = i - 576 * hd; nt[i] = (j >= 32 && j < 32 + 465) ? rpb[hd * 465 + j - 32] : (j >= NA_NEGIDX ? NEG_INF : 0.f); }
      __syncthreads(); }
    if (parts & 1) {
        constexpr int NU = BATCH * NA_HEADS * (GRID_R / 4);
        const int I_ = wave & 3, cq_ = 16 * I_ + (c.q & 15);
        const int sc_ = 16 * I_ - 8 < 0 ? 0 : (16 * I_ - 8 > 32 ? 32 : 16 * I_ - 8); const int c0_ = cq_ - 8 < 0 ? 0 : (cq_ - 8 > GRID_W - 16 ? GRID_W - 16 : cq_ - 8);
        SpecNA sp;
        { const int chn_ = lane & 7, g16_ = lane >> 4; sp.dk0 = (sc_ + key_lo) * 128 + ((chn_ ^ (g16_ & 7)) << 4); sp.dk1 = (sc_ + key_lo) * 128 + ((chn_ ^ ((g16_ + 4) & 7)) << 4); sp.dv0 = (sc_ + key_lo) * 128 + ((chn_ ^ ((g16_ & 1) << 2)) << 4); }
        sp.kcolK = 0; sp.kcolV = ((C_VA - C_KA) / 64) * NTOK * 128; sp.bidx = 32 + (sc_ - cq_ + 15) + 4 * c.h;
#pragma unroll
        for (int r2 = 0; r2 < 16; ++r2) sp.madd[r2] = ((unsigned)(sc_ + crow0(r2) + 4 * c.h - c0_) < 16u) ? 0.f : NEG_INF;
#define NA_UNIT(u_, RS, RW0, QR, TQ, HEAD) do { const int rg_ = (u_) & 31, head_ = ((u_) >> 5) & 7, b_ = (u_) >> 8; const int rp_ = 2 * rg_ + (wave >> 2); \
            RS = __builtin_amdgcn_make_buffer_rsrc((void*)(QKV + ((size_t)(C_KA / 64 + head_) * NTOK + (size_t)b_ * SEQ) * 128), 0, 0x7fffffff, 0x00020000); \
            RW0 = 2 * rp_ - 4 < 0 ? 0 : (2 * rp_ - 4 > GRID_R - 8 ? GRID_R - 8 : 2 * rp_ - 4); QR = 2 * rp_ + (c.q >> 4); TQ = b_ * SEQ + QR * GRID_W + cq_; HEAD = head_; } while (0)
        int u = vcu; bool have = u < NU, first = true;
        int tq = 0, head = 0, qr = 0, rw0 = 0; __amdgpu_buffer_rsrc_t rs = __builtin_amdgcn_make_buffer_rsrc((void*)QKV, 0, 0x7fffffff, 0x00020000);
        bf16x8 q0, q1, q2, q3;
        if (have) {
            NA_UNIT(u, rs, rw0, qr, tq, head);
            sp.rs = rs; sp.rw0 = rw0;
            asm volatile("s_waitcnt vmcnt(0) lgkmcnt(0)" ::: "memory");
            load_q_asm(QKV + ((size_t)(C_QA / 64 + head) * NTOK + tq) * 128, c.h, q0, q1, q2, q3);
            sp.dmaK(0, c.vl + 4096); sp.dmaV(0, c.vl);
            asm volatile("s_waitcnt vmcnt(8)" : "+v"(q0), "+v"(q1), "+v"(q2), "+v"(q3) :: "memory");
            __builtin_amdgcn_sched_barrier(0);
        }
        while (have) {
            __builtin_amdgcn_s_barrier();
            const int un = u + G; const bool hn = un < NU;
            int tqn = tq, headn = head, qrn = qr, rw0n = rw0; __amdgpu_buffer_rsrc_t rsn = rs;
            if (hn) NA_UNIT(un, rsn, rw0n, qrn, tqn, headn);
            sp.rs = rs; sp.rw0 = rw0; sp.qr = qr; sp.r0q = qr - 4 < 0 ? 0 : (qr - 4 > GRID_R - 8 ? GRID_R - 8 : qr - 4); sp.btab = (const LAS float*)(lds + L_NATAB) + head * 576;
            QState st; st.m = -1e30f; st.l = 0.f;
#pragma unroll
            for (int i = 0; i < 16; ++i) { st.o0[i] = 0.f; st.o1[i] = 0.f; }
            run_dma_x(sp, c, q0, q1, q2, q3, st, first, hn, rsn, rw0n, QKV + ((size_t)(C_QA / 64 + headn) * NTOK + tqn) * 128);
            const float inv = 1.f / pair_sum(st.l);
            store_o8(MIX + (size_t)tq * DM + head * 64, st.o0, st.o1, inv, c.h);
            if (hn) { asm volatile("s_waitcnt vmcnt(10)" : "+v"(q0), "+v"(q1), "+v"(q2), "+v"(q3) :: "memory");
                      __builtin_amdgcn_sched_barrier(0); }
            rs = rsn; rw0 = rw0n; qr = qrn; tq = tqn; head = headn; u = un; have = hn; first = false;
        }
#undef NA_UNIT
        asm volatile("s_waitcnt vmcnt(0)" ::: "memory");
    }
    if (parts & 2) {
        struct NoBias { __device__ __forceinline__ void bias(int, f32x16&) const {} } nb;
        const int nqb = SEQ / 256;
        for (int u = vcu; u < BATCH * MEM_HEADS * 8; u += G) {
            const int pair = u >> 3, head = pair & 3, b = pair >> 2;
            __syncthreads();
            { const unsigned char* kb = KVM + ((size_t)head * BATCH * MEM_LEN + (size_t)b * MEM_LEN) * 128; const unsigned char* vb = kb + (size_t)4 * BATCH * MEM_LEN * 128;
#pragma unroll
              for (int i = 0; i < 4; ++i) { const int idx = tid + NTHREADS * i, key = idx >> 3, ch = idx & 7;
                  const u32x4 kv = *(const u32x4*)(kb + (size_t)key * 128 + ch * 16), vv = *(const u32x4*)(vb + (size_t)key * 128 + ch * 16);
                  *(LAS u32x4*)(lds + key * 128 + ((ch ^ ((key >> 1) & 7)) << 4)) = kv;
                  *(LAS u32x4*)(lds + 32768 + key * 128 + ((ch ^ (((key >> 1) & 1) << 2)) << 4)) = vv; } }
            __syncthreads();
#pragma unroll 1
            for (int qq = 0; qq < 2; ++qq) {
                const int q0 = (4 * (u & 7) + 2 * qq) * 256 + wave * 64; if (q0 >= SEQ) break;
                const int tqa = b * SEQ + q0 + c.q, tqb = tqa + 32;
                bf16x8 qa[4], qbf[4]; load_q(QKV + ((size_t)(C_QM / 64 + head) * NTOK + tqa) * 128, c.h, qa); load_q(QKV + ((size_t)(C_QM / 64 + head) * NTOK + tqb) * 128, c.h, qbf);
                QState A, B; A.m = -1e30f; A.l = 0.f; B.m = -1e30f; B.l = 0.f;
#pragma unroll
                for (int i = 0; i < 16; ++i) { A.o0[i] = 0.f; A.o1[i] = 0.f; B.o0[i] = 0.f; B.o1[i] = 0.f; }
#pragma unroll 1
                for (int t = 0; t < 8; ++t) tile_core2(c, lds + 32768 + t * 4096, lds + t * 4096, qa, qbf, A, B);
                store_o8(MIX + (size_t)tqa * DM + NA_W + 256 + head * 64, A.o0, A.o1, 1.f / pair_sum(A.l), c.h);
                store_o8(MIX + (size_t)tqb * DM + NA_W + 256 + head * 64, B.o0, B.o1, 1.f / pair_sum(B.l), c.h);
            }
        }
        __syncthreads();
    }
    LAS unsigned char* so = lds + L_SO; LAS float* sm = (LAS float*)(lds + L_SM); LAS float* sl = (LAS float*)(lds + L_SL);
    if (parts & 4) for (int u = vcu; u < BATCH * 4 * (SEQ / 512); u += G) {
        const int blk = u & 15, hh = (u >> 4) & 3, b = u >> 6;
        __syncthreads();
        for (int i = tid; i < 3 * 192; i += NTHREADS) { const int g = i / 192, j = i - 192 * g - 32; lb[i] = (j >= 0 && j <= 128) ? biasD[(g * 4 + hh) * 129 + j] : NEG_INF; }
        __syncthreads();
#pragma unroll 1
        for (int g = 0; g < 3; ++g) {
            const int dil = g == 0 ? 1 : (g == 1 ? 4 : 16), head = g * 4 + hh;
#pragma unroll 1
            for (int k = 0; k < 2; ++k) {
                const int tl = wave * 2 + k;
                const int base = g == 0 ? 32 * tl : (g == 1 ? (tl & 3) + 128 * (tl >> 2) : tl);
                const int tql = base + dil * c.q;
                const int tq = b * SEQ + blk * 512 + tql;
                SpecDil sp; sp.rs = __builtin_amdgcn_make_buffer_rsrc((void*)(QKV + ((size_t)(C_KD / 64 + head) * NTOK + (size_t)b * SEQ) * 128), 0, 0x7fffffff, 0x00020000); sp.pos0 = blk * 512 + base; sp.dil = dil; sp.q = c.q; sp.h = c.h; sp.btab = lb + g * 192; sp.cb = chunk16;
#pragma unroll
                for (int i = 0; i < 4; ++i) sp.pi[i] = sp.pos0 + dil * (-64 + key_lo + 8 * i);
                sp.kcolK = 0; sp.kcolV = ((C_VD - C_KD) / 64) * NTOK * 128;
                { const int chn = lane & 7, g16 = lane >> 4; sp.ck0 = (chn ^ (g16 & 7)) << 4; sp.ck1 = (chn ^ ((g16 + 4) & 7)) << 4; sp.cv0 = (chn ^ ((g16 & 1) << 2)) << 4; }
                bf16x8 qf[4]; load_q(QKV + ((size_t)(C_QD / 64 + head) * NTOK + tq) * 128, c.h, qf);
                float m, l; f32x16 o0, o1;
                if (g == 0) { m = -1e30f; l = 0.f;
#pragma unroll
                    for (int i = 0; i < 16; ++i) { o0[i] = 0.f; o1[i] = 0.f; } }
                else {
                    m = sm[tql]; const float lt = sl[tql]; l = c.h == 0 ? lt : 0.f;
                    const LAS unsigned char* rowp = so + tql * SO_PITCH;
#pragma unroll
                    for (int g4 = 0; g4 < 4; ++g4) {
                        const u32x2 w0 = *(const LAS u32x2*)(rowp + (8 * g4 + 4 * c.h) * 2), w1 = *(const LAS u32x2*)(rowp + (32 + 8 * g4 + 4 * c.h) * 2);
                        o0[4 * g4] = __uint_as_float(w0.x << 16) * lt; o0[4 * g4 + 1] = __uint_as_float(w0.x & 0xffff0000u) * lt; o0[4 * g4 + 2] = __uint_as_float(w0.y << 16) * lt; o0[4 * g4 + 3] = __uint_as_float(w0.y & 0xffff0000u) * lt;
                        o1[4 * g4] = __uint_as_float(w1.x << 16) * lt; o1[4 * g4 + 1] = __uint_as_float(w1.x & 0xffff0000u) * lt; o1[4 * g4 + 2] = __uint_as_float(w1.y << 16) * lt; o1[4 * g4 + 3] = __uint_as_float(w1.y & 0xffff0000u) * lt;
                    }
                }
                run_dma(sp, c, qf, m, l, o0, o1);
                const float lt = pair_sum(l); const float inv = 1.f / lt;
                if (g < 2) { store_o(so + tql * SO_PITCH, o0, o1, inv, c.h); if (c.h == 0) { sm[tql] = m; sl[tql] = lt; } }
                else store_o8(MIX + (size_t)tq * DM + NA_W + hh * 64, o0, o1, inv, c.h);
            }
            __syncthreads();
        }
    }
}
}

__device__ __forceinline__ void memkv_mini(const MArgs& a, LAS unsigned char* lds, int u) {
    const int tid = threadIdx.x, lane = tid & 63, wave = __builtin_amdgcn_readfirstlane(tid >> 6);
    const int hd = u & 7, rb = u >> 3, rh = wave & 1, kq = wave >> 1, r = lane & 31, h = lane >> 5;
    const bf16_t* XNm = (const bf16_t*)(a.ws + WS_XN) + (size_t)NTOK * DM;
    const bf16_t* WT = (const bf16_t*)(a.ws + WS_WINT);
    const bf16_t* arow = XNm + (size_t)(rb * 64 + rh * 32 + r) * DM + kq * 256 + 8 * h;
    const int n0 = 64 * hd + r, n1 = n0 + 32;
    const bf16_t* b0 = WT + (size_t)(4096 + inproj_pos(n0)) * DM + kq * 256 + 8 * h;
    const bf16_t* b1 = WT + (size_t)(4096 + inproj_pos(n1)) * DM + kq * 256 + 8 * h;
    f32x16 c0, c1;
#pragma unroll
    for (int i = 0; i < 16; ++i) { c0[i] = 0.f; c1[i] = 0.f; }
#pragma unroll 4
    for (int s2 = 0; s2 < 16; ++s2) {
        const bf16x8 af = *(const bf16x8*)(arow + 16 * s2), bf0 = *(const bf16x8*)(b0 + 16 * s2), bf1 = *(const bf16x8*)(b1 + 16 * s2);
        c0 = __builtin_amdgcn_mfma_f32_32x32x16_bf16(af, bf0, c0, 0, 0, 0);
        c1 = __builtin_amdgcn_mfma_f32_32x32x16_bf16(af, bf1, c1, 0, 0, 0);
    }
    LAS float* part = (LAS float*)lds + ((kq * 2 + rh) * 32) * 64;
#pragma unroll
    for (int i = 0; i < 16; ++i) { const int row = (i & 3) + 8 * (i >> 2) + 4 * h; part[row * 64 + r] = c0[i]; part[row * 64 + 32 + r] = c1[i]; }
    __syncthreads();
    { const int row = tid >> 3, cg = tid & 7; const int rh2 = row >> 5, rr = row & 31;
      float v[8];
#pragma unroll
      for (int j = 0; j < 8; ++j) { float sacc = 0.f;
#pragma unroll
          for (int q = 0; q < 4; ++q) sacc += ((LAS float*)lds)[(((q * 2 + rh2) * 32) + rr) * 64 + cg * 8 + j];
          v[j] = sacc; }
      float ss = 0.f;
#pragma unroll
      for (int j = 0; j < 8; ++j) ss += v[j] * v[j];
      ss += __shfl_xor(ss, 1); ss += __shfl_xor(ss, 2); ss += __shfl_xor(ss, 4);
      const float rn = hd < 4 ? rsqrtf(ss * (1.f / 64.f) + EPS) : 1.f;
      u32x4 w;
      if (hd < 4) { const float* gq = a.in[4] + 5 * 64 + cg * 8;
          w.x = att::cvtpk(v[0] * rn * gq[0], v[1] * rn * gq[1]); w.y = att::cvtpk(v[2] * rn * gq[2], v[3] * rn * gq[3]); w.z = att::cvtpk(v[4] * rn * gq[4], v[5] * rn * gq[5]); w.w = att::cvtpk(v[6] * rn * gq[6], v[7] * rn * gq[7]); }
      else { w.x = att::cvtpk(v[0], v[1]); w.y = att::cvtpk(v[2], v[3]); w.z = att::cvtpk(v[4], v[5]); w.w = att::cvtpk(v[6], v[7]); }
      bf16_t* KVM = (bf16_t*)(a.ws + WS_KVM);
      *(u32x4*)(KVM + ((size_t)hd * (BATCH * MEM_LEN) + rb * 64 + row) * 64 + cg * 8) = w;
    }
    __syncthreads();
}

__device__ __forceinline__ void phase4(const MArgs& a, LAS unsigned char* lds, int vcu, int G, bool dry) {
    const int tid = threadIdx.x, lane = tid & 63, wave = __builtin_amdgcn_readfirstlane(tid >> 6);
    const int r = lane & 15, kq = lane >> 4;
    LAS float* sR = (LAS float*)(lds + wave * 4096);
    LAS float* sLg = sR + 16;
    const bf16_t* x1 = (const bf16_t*)(a.ws + WS_X1B); const float* g_ffn = a.in[10];
    const bf16_t* WfH = (const bf16_t*)(a.ws + WS_WRF); const bf16_t* WfL = WfH + 32 * 3 * 64 * 8; const float* b48 = (const float*)(a.ws + WS_WRF + 2 * 32 * 3 * 64 * 8 * 2);
    constexpr int P4_MAXSLOT = 512;
    LAS int* hP = (LAS int*)(lds + 32768); LAS int* hE = hP + 128; LAS int* bP = hE + 32; LAS int* bE = bP + 128; LAS int* tinfo = bE + 32;
    for (int i = tid; i < 320 + P4_MAXSLOT * 4; i += NTHREADS) hP[i] = i < 320 ? 0 : -1;
    __syncthreads();
    int slot0 = wave * 16;
    bf16_t* H = (bf16_t*)(a.ws + WS_H); float* tokg = (float*)(a.ws + WS_TOKG); float* trstd = (float*)(a.ws + WS_RSTD); int* lists = (int*)(a.ws + WS_LIST); unsigned* count = (unsigned*)(a.ws + WS_CTL) + CW_COUNT;
    int* elists = (int*)(a.ws + WS_ELIST); int* tokP = (int*)(a.ws + WS_TOKP); unsigned* ecount = (unsigned*)(a.ws + WS_CTL) + CW_ECOUNT;
    for (int tile = vcu * NWAVES + wave; tile < NTOK / 16; tile += G * NWAVES) {
        const int tok0 = tile * 16;
        const bf16_t* xr = x1 + (size_t)(tok0 + r) * DM + 8 * kq;
        bf16_t* hr = H + (size_t)(tok0 + r) * DM + 8 * kq;
        f32x4 acc[3]; float ss = 0.f;
#pragma unroll
        for (int ct = 0; ct < 3; ++ct) acc[ct] = (f32x4){0.f, 0.f, 0.f, 0.f};
#pragma unroll 2
        for (int s = 0; s < 32; ++s) {
            const u32x4 xw = *(const u32x4*)(xr + 32 * s);
            const f32x4 xa = (f32x4){__uint_as_float(xw.x << 16), __uint_as_float(xw.x & 0xffff0000u), __uint_as_float(xw.y << 16), __uint_as_float(xw.y & 0xffff0000u)};
            const f32x4 xb = (f32x4){__uint_as_float(xw.z << 16), __uint_as_float(xw.z & 0xffff0000u), __uint_as_float(xw.w << 16), __uint_as_float(xw.w & 0xffff0000u)};
            ss += (xa[0] * xa[0] + xa[1] * xa[1]) + (xa[2] * xa[2] + xa[3] * xa[3]) + (xb[0] * xb[0] + xb[1] * xb[1]) + (xb[2] * xb[2] + xb[3] * xb[3]);
            const bf16x8 ah = __builtin_bit_cast(bf16x8, xw);
#pragma unroll
            for (int ct = 0; ct < 3; ++ct) {
                const bf16x8 wh = *(const bf16x8*)(WfH + ((size_t)(s * 3 + ct) * 64 + lane) * 8), wl = *(const bf16x8*)(WfL + ((size_t)(s * 3 + ct) * 64 + lane) * 8);
                acc[ct] = __builtin_amdgcn_mfma_f32_16x16x32_bf16(ah, wh, acc[ct], 0, 0, 0);
                acc[ct] = __builtin_amdgcn_mfma_f32_16x16x32_bf16(ah, wl, acc[ct], 0, 0, 0);
            }
        }
        ss += __shfl_xor(ss, 16); ss += __shfl_xor(ss, 32);
        const float rstd = rsqrtf(ss * (1.f / DM) + EPS);
        if (kq == 0) { sR[r] = rstd; trstd[tok0 + r] = rstd; }
#pragma unroll
        for (int ct = 0; ct < 3; ++ct) { const float bb = b48[16 * ct + r];
#pragma unroll
            for (int i = 0; i < 4; ++i) { const int tk = 4 * kq + i; sLg[tk * 48 + 16 * ct + r] = acc[ct][i] * sR[tk] + bb; } }
        if (lane < 16) {
            const int tok = tok0 + lane; const LAS float* lg = sLg + lane * 48;
            int gi = 0; float gm = lg[0];
            for (int i = 1; i < 4; ++i) if (lg[i] > gm) { gm = lg[i]; gi = i; }
            float den = 0.f; for (int i = 0; i < 4; ++i) den += __expf(lg[i] - gm);
            const float grp_gate = 1.f / den;
            const LAS float* fl = lg + 4 + gi * 8;
            int i0 = 0; float v0 = fl[0];
            for (int i = 1; i < 8; ++i) if (fl[i] > v0) { v0 = fl[i]; i0 = i; }
            int i1 = -1; float v1 = -3.0e38f;
            for (int i = 0; i < 8; ++i) if (i != i0 && fl[i] > v1) { v1 = fl[i]; i1 = i; }
            const float e1 = __expf(v1 - v0); const float g0 = grp_gate / (1.f + e1), g1 = grp_gate * e1 / (1.f + e1);
            int pa, pb; float ga, gb;
            if (i0 < i1) { pa = i0; pb = i1; ga = g0; gb = g1; } else { pa = i1; pb = i0; ga = g1; gb = g0; }
            const int L = gi * 28 + pa * 8 - pa * (pa + 1) / 2 + (pb - pa - 1);
            tokg[tok * 2] = ga; tokg[tok * 2 + 1] = gb;
            if (!dry) {
                const int ea = gi * 8 + pa, eb = gi * 8 + pb;
                if (slot0 + 16 <= P4_MAXSLOT) {
                    const int rp = __hip_atomic_fetch_add(&hP[L], 1, __ATOMIC_RELAXED, __HIP_MEMORY_SCOPE_WORKGROUP);
                    const int ra = __hip_atomic_fetch_add(&hE[ea], 1, __ATOMIC_RELAXED, __HIP_MEMORY_SCOPE_WORKGROUP);
                    const int rb = __hip_atomic_fetch_add(&hE[eb], 1, __ATOMIC_RELAXED, __HIP_MEMORY_SCOPE_WORKGROUP);
                    LAS int* ti = tinfo + (slot0 + lane) * 4;
                    ti[0] = tok; ti[1] = (L << 16) | rp; ti[2] = (ea << 16) | ra; ti[3] = (eb << 16) | rb;
                } else {
                    const unsigned pos = atomicAdd(&count[L], 1u); lists[(size_t)L * NTOK + pos] = tok; tokP[tok] = (L << 16) | (int)pos;
                    const unsigned qa = atomicAdd(&ecount[ea], 1u); elists[(size_t)ea * NTOK + qa] = tok * 2;
                    const unsigned qb = atomicAdd(&ecount[eb], 1u); elists[(size_t)eb * NTOK + qb] = tok * 2 + 1;
                }
            }
        }
        slot0 += NWAVES * 16;
    }
    if (!dry) {
        __syncthreads();
        const int nslot = slot0 - wave * 16 < P4_MAXSLOT ? slot0 - wave * 16 : P4_MAXSLOT;
        if (tid < NPAIR) { const int h = hP[tid]; bP[tid] = h ? (int)atomicAdd(&count[tid], (unsigned)h) : 0; }
        else if (tid >= 128 && tid < 128 + NEXP) { const int h = hE[tid - 128]; bE[tid - 128] = h ? (int)atomicAdd(&ecount[tid - 128], (unsigned)h) : 0; }
        __syncthreads();
        for (int sidx = tid; sidx < nslot; sidx += NTHREADS) {
            const LAS int* ti = tinfo + sidx * 4; const int tok = ti[0];
            if (tok >= 0) {
                const int L = ti[1] >> 16, pos = bP[L] + (ti[1] & 0xffff); lists[(size_t)L * NTOK + pos] = tok; tokP[tok] = (L << 16) | pos;
                const int ea = ti[2] >> 16, eb = ti[3] >> 16;
                elists[(size_t)ea * NTOK + bE[ea] + (ti[2] & 0xffff)] = tok * 2;
                elists[(size_t)eb * NTOK + bE[eb] + (ti[3] & 0xffff)] = tok * 2 + 1;
            }
        }
    }
}

#define XB_TMO      128
#define XB_XCNT(j)  (256  + 64 * (j))
#define XB_XSUB(j)  (1280 + 64 * (j))
#define XB_XGEN(j)  (2304 + 64 * (j))
#define XB_TOP      3328
#define XB_TOPGEN   3392
#define XCD_BAR_WORDS 3456
#define XB_SPIN_CAP (1u << 18)
__device__ __forceinline__ unsigned xb_ld(unsigned* p)              { return __hip_atomic_load(p, __ATOMIC_RELAXED, __HIP_MEMORY_SCOPE_AGENT); }
__device__ __forceinline__ unsigned xb_add(unsigned* p, unsigned v) { return __hip_atomic_fetch_add(p, v, __ATOMIC_RELAXED, __HIP_MEMORY_SCOPE_AGENT); }
__device__ __forceinline__ unsigned xb_xcc_id() { return (unsigned)__builtin_amdgcn_s_getreg((3 << 11) | 20) & 0xFu; }
#define XB_SPIN(cond, bar) do { unsigned _sp = 0; while (cond) { __builtin_amdgcn_s_sleep(1); \
    if ((++_sp & 255u) == 0u) { if (xb_ld(&(bar)[XB_TMO])) break; if (_sp > XB_SPIN_CAP) { atomicAdd(&(bar)[XB_TMO], 1u); break; } } } } while (0)
struct XcdBarrier { unsigned* bar; unsigned x; volatile LAS unsigned* st; };
__device__ __forceinline__ XcdBarrier xcd_barrier_post(unsigned* bar, volatile LAS unsigned* st) {
    XcdBarrier b; b.bar = bar; b.x = xb_xcc_id(); b.st = st;
    if (threadIdx.x == 0) (void)xb_add(&bar[XB_XCNT(b.x)], 1u);
    return b;
}
__device__ __forceinline__ void xcd_barrier_complete(unsigned* bar, unsigned x, unsigned& nloc, unsigned& nx) {
    const unsigned G = gridDim.x * gridDim.y * gridDim.z;
    unsigned sum, cnt, mine, sp = 0u;
    for (;;) {
        sum = 0u; cnt = 0u; mine = 0u;
#pragma unroll
        for (unsigned j = 0; j < 16; ++j) { const unsigned c = xb_ld(&bar[XB_XCNT(j)]); sum += c; cnt += (c > 0u) ? 1u : 0u; mine = (j == x) ? c : mine; }
        if (sum == G) break;
        __builtin_amdgcn_s_sleep(1);
        if ((++sp & 255u) == 0u) { if (xb_ld(&bar[XB_TMO])) break; if (sp > XB_SPIN_CAP) { atomicAdd(&bar[XB_TMO], 1u); break; } }
    }
    nloc = mine > 0u ? mine : 1u; nx = cnt > 0u ? cnt : 1u;
}
__device__ __forceinline__ void xcd_barrier(const XcdBarrier& b) {
    asm volatile("s_waitcnt vmcnt(0)" ::: "memory");
    __syncthreads();
    if (threadIdx.x == 0) {
        unsigned* bar = b.bar;
        __builtin_amdgcn_s_waitcnt(0);
        unsigned nloc = b.st[0], nx = b.st[1];
        if (nloc == 0u) { xcd_barrier_complete(bar, b.x, nloc, nx); b.st[0] = nloc; b.st[1] = nx; }
        const unsigned old = xb_add(&bar[XB_XSUB(b.x)], 1u);
        const unsigned gen = old / nloc;
        if (old + 1u == (gen + 1u) * nloc) {
            __builtin_amdgcn_fence(__ATOMIC_RELEASE, "agent");
            asm volatile("s_waitcnt vmcnt(0)" ::: "memory");
            const unsigned og = xb_add(&bar[XB_TOP], 1u);
            const unsigned tg = og / nx;
            if (og + 1u == (tg + 1u) * nx) xb_add(&bar[XB_TOPGEN], 1u);
            else XB_SPIN(xb_ld(&bar[XB_TOPGEN]) == tg, bar);
            __builtin_amdgcn_fence(__ATOMIC_ACQUIRE, "agent");
            xb_add(&bar[XB_XGEN(b.x)], 1u);
            asm volatile("s_waitcnt vmcnt(0)" ::: "memory");
        } else {
            XB_SPIN(xb_ld(&bar[XB_XGEN(b.x)]) == gen, bar);
            __builtin_amdgcn_fence(__ATOMIC_ACQUIRE, "agent");
            asm volatile("s_waitcnt vmcnt(0)" ::: "memory");
        }
    }
    __syncthreads();
}
constexpr int CW_BAR = 4096;
constexpr int MISC_OFF = LDS_BYTES - 256;

__global__ void __launch_bounds__(NTHREADS, 2) mega(MArgs a) {
    extern __shared__ __attribute__((aligned(16))) unsigned char lds_raw[];
    LAS unsigned char* lds = (LAS unsigned char*)lds_raw;
    const int G = gridDim.x; const int bx = blockIdx.x; const int vcu = (G % 8 == 0) ? (bx % 8) * (G / 8) + bx / 8 : bx;
    const int lo = a.ph_lo, hi = a.ph_hi;
#define IN_PH(k) (lo <= (k) && (k) < hi)
    volatile LAS unsigned* misc = (volatile LAS unsigned*)(lds + MISC_OFF);
    if (threadIdx.x < 2) misc[threadIdx.x] = 0u;
    __syncthreads();
    XcdBarrier xbar; xbar.bar = (unsigned*)(a.ws + WS_CTL) + CW_BAR; xbar.x = 0; xbar.st = misc;
    if (hi - lo > 1) xbar = xcd_barrier_post((unsigned*)(a.ws + WS_CTL) + CW_BAR, misc);
#define SEAM(k) do { if (IN_PH(k) && IN_PH((k) + 1)) { if ((k) == 0) cg::this_grid().sync(); else xcd_barrier(xbar); } } while (0)
    if (IN_PH(0)) { phase0(a, lds, vcu, G); }
    SEAM(0);
    if (IN_PH(1)) {
        for (int u = bx; u < 256; u += G) memkv_mini(a, lds, u);
        { SchedInProjT<false> S{(const char*)(a.ws + WS_XN), (const char*)(a.ws + WS_WINT), G, bx};
          EpiInProj E{(bf16_t*)(a.ws + WS_QKV), (bf16_t*)(a.ws + WS_KVM), a.in[4], (const float*)(a.ws + WS_RSTDX), 1.f};
          pg8::gemm_phase<EpiInProj, SchedInProjT<false>, false, true>(lds, DM / 64, DM, DM, S, E); }
        { SchedInProjT<true> S{(const char*)(a.ws + WS_XQ), (const char*)(a.ws + WS_WINT8), G, bx};
          EpiInProj E{(bf16_t*)(a.ws + WS_QKV), (bf16_t*)(a.ws + WS_KVM), a.in[4], (const float*)(a.ws + WS_RSTDX), 1.f / (SC_XQ * SC_WIN)};
          pg8::gemm_phase<EpiInProj, SchedInProjT<true>, false, true, true>(lds, DM / 128, DM / 2, DM / 2, S, E); }
    }
    SEAM(1);
    if (IN_PH(2) || (!MK_ONE_LAUNCH && a.ph_lo >= 20 && a.ph_lo < 23)) { att::phase2(a, lds, vcu, G); }
    SEAM(2);
    if (IN_PH(3)) {
        SchedOutProj S{(const char*)(a.ws + WS_MIX), (const char*)(a.ws + WS_WOT), G, bx};
        EpiOutProj E{(const bf16_t*)(a.ws + WS_XN), (bf16_t*)(a.ws + WS_X1B), a.ws + WS_X1Q};
        pg8::gemm_phase<EpiOutProj, SchedOutProj, false, true, true>(lds, DM / 128, DM / 2, DM / 2, S, E);
    }
    SEAM(3);
    if (IN_PH(4) || lo == 7) { phase4(a, lds, vcu, G, lo == 7); }
    SEAM(4);
    if (IN_PH(5)) {
        const unsigned* count = (const unsigned*)(a.ws + WS_CTL) + CW_COUNT; const unsigned* ecount = (const unsigned*)(a.ws + WS_CTL) + CW_ECOUNT;
        moe_build_tiles(lds, count, ecount);
        const LAS int* tt = (const LAS int*)(lds + TT_OFF);
        SchedMoe1 S{(const char*)(a.ws + WS_X1Q), (const char*)(a.ws + WS_W13T), (const int*)(a.ws + WS_ELIST), ecount, tt, tt[TT_E], G, bx};
        EpiMoe1 E{(bf16_t*)(a.ws + WS_ACT), (const int*)(a.ws + WS_ELIST), ecount, (const float*)(a.ws + WS_TOKG), (const float*)(a.ws + WS_RSTD), (const int*)(a.ws + WS_TOKP), tt};
        pg8::gemm_phase<EpiMoe1, SchedMoe1, true, true, true>(lds, DM / 128, DM / 2, DM / 2, S, E);
    }
    SEAM(5);
    if (IN_PH(6) || lo == 8) {
        const unsigned* count = (const unsigned*)(a.ws + WS_CTL) + CW_COUNT;
        const int ntiles = moe_build_tiles(lds, count, (const unsigned*)(a.ws + WS_CTL) + CW_ECOUNT);
        SchedMoe2 S{(const char*)(a.ws + WS_ACT), (const char*)(a.ws + WS_W2T), (const LAS int*)(lds + TT_OFF), ntiles, G, bx};
        EpiMoe2 E{(!MK_ONE_LAUNCH && a.var == 3) ? (float*)(a.ws + WS_XN) : a.out, (const bf16_t*)(a.ws + WS_X1B), (const int*)(a.ws + WS_LIST), count, lo == 8 ? 0.f : 1.f / (SC_ACT * SC_W2), MK_ONE_LAUNCH ? 0 : a.var};
        pg8::gemm_phase<EpiMoe2, SchedMoe2, false, true, true>(lds, DM / 128, DM / 2, DEXP / 2, S, E);
    }
#undef IN_PH
#undef SEAM
}

static void launch_mega(const MArgs& base, int lo, int hi, int grid, hipStream_t stream) {
    MArgs a = base; a.ph_lo = lo; a.ph_hi = hi;
    hipLaunchKernelGGL(mega, dim3(grid), dim3(NTHREADS), LDS_BYTES, stream, a);
}
extern "C" void kernel_launch(void* const* d_in, const int* in_sizes, int n_in, void* d_out, int out_size, void* d_ws, size_t ws_size, hipStream_t stream) {
    if (n_in != 18 || ws_size < WS_END || out_size != NTOK * DM) { fprintf(stderr, "kernel_launch: unexpected sizes n_in %d ws %zu out %d\n", n_in, ws_size, out_size); return; }
    static int grid = 0;
    if (grid == 0) {
        int dev = 0, cus = 0, per_cu = 0;
        if (hipGetDevice(&dev) != hipSuccess || hipDeviceGetAttribute(&cus, hipDeviceAttributeMultiprocessorCount, dev) != hipSuccess) { grid = -1; return; }
        if (hipFuncSetAttribute((const void*)mega, hipFuncAttributeMaxDynamicSharedMemorySize, LDS_BYTES) != hipSuccess) { fprintf(stderr, "hipFuncSetAttribute failed\n"); grid = -1; return; }
        if (hipOccupancyMaxActiveBlocksPerMultiprocessor(&per_cu, (const void*)mega, NTHREADS, LDS_BYTES) != hipSuccess || per_cu < 1) { fprintf(stderr, "occupancy query failed (%d)\n", per_cu); grid = -1; return; }
        grid = cus * per_cu;
    }
    if (grid < 0) return;
    MArgs base; memset(&base, 0, sizeof base);
    for (int i = 0; i < 18; ++i) base.in[i] = (const float*)d_in[i];
    base.out = (float*)d_out; base.ws = (unsigned char*)d_ws;
    static_assert((CW_BAR + XCD_BAR_WORDS) * 4 <= 65536 && (CW_ECOUNT + NEXP) * 4 <= 65536, "control words inside the zeroed region");
    (void)hipMemsetAsync((unsigned char*)d_ws + WS_CTL, 0, 65536, stream);
#if MK_ONE_LAUNCH
    base.ph_lo = 0; base.ph_hi = 7;
    void* args[] = {&base};
    hipError_t e = hipLaunchCooperativeKernel((const void*)mega, dim3(grid), dim3(NTHREADS), args, LDS_BYTES, stream);
    if (e != hipSuccess) fprintf(stderr, "cooperative launch failed: %s (grid %d)\n", hipGetErrorString(e), grid);
#else
    for (int p = 0; p < 7; ++p) { launch_mega(base, p, p + 1, grid, stream); if (p == MK_REP_PHASE) launch_mega(base, p, p + 1, grid, stream); if (p == 4 && MK_REP_PHASE == 7) launch_mega(base, 7, 8, grid, stream); if (p == 6 && MK_REP_PHASE == 8) launch_mega(base, 8, 9, grid, stream);
        if (p == 2 && MK_REP_PHASE >= 20 && MK_REP_PHASE < 30) for (int r = 0; r < 4; ++r) launch_mega(base, MK_REP_PHASE, MK_REP_PHASE + 1, grid, stream);
        if (MK_REP_PHASE >= 100 && p == MK_REP_PHASE % 100) { MArgs b2 = base; b2.var = MK_REP_PHASE / 100; for (int r = 0; r < 2; ++r) launch_mega(b2, p, p + 1, grid, stream); } }
#endif
    (void)in_sizes;
}
```

```cpp
#include <hip/hip_runtime.h>
#include <hip/hip_cooperative_groups.h>
#include <cstdio>
#include <cstdint>
#include <cstring>

constexpr int DM = 1024, BATCH = 8, SEQ = 8192, NTOK = BATCH * SEQ;
constexpr int HD = 64, MEM_LEN = 256, GRID_W = 64, GRID_R = SEQ / GRID_W;
constexpr int NA_HEADS = 8, DIL_HEADS = 12, MEM_HEADS = 4;
constexpr int NA_W = 512, DIL_W = 768, MEM_W = 256, IN_COLS = 4096;
constexpr int C_QA = 0, C_KA = 512, C_VA = 1024, C_QD = 1536, C_KD = 2304, C_VD = 3072, C_QM = 3840;
constexpr int NEXP = 32, DEXP = 512;
constexpr int NPAIR = 112;
constexpr int MROWS = NTOK + MEM_LEN * BATCH;
constexpr float EPS = 1e-6f;
constexpr float LOG2E = 1.4426950408889634f;
constexpr float QSCALE = 0.125f * LOG2E;

typedef unsigned short bf16_t;
namespace cg = cooperative_groups;
#ifndef MK_ONE_LAUNCH
#define MK_ONE_LAUNCH 1
#endif
#ifndef MK_REP_PHASE
#define MK_REP_PHASE -1
#endif

constexpr size_t MiB = 1u << 20;
constexpr size_t WS_CTL = 0;
constexpr size_t WS_BIASD = 1 * MiB;
constexpr size_t WS_RPB = 1 * MiB + 64 * 1024;
constexpr size_t WS_WRF = 1 * MiB + 128 * 1024;
constexpr size_t WS_TOKG = 2 * MiB;
constexpr size_t WS_RSTD = 2 * MiB + 512 * 1024;
constexpr size_t WS_LIST = 4 * MiB;
constexpr size_t WS_KVM = 32 * MiB;
constexpr size_t WS_ELIST = 36 * MiB;
constexpr size_t WS_TOKP = 2 * MiB + 768 * 1024;
constexpr size_t WS_WT = 48 * MiB;
constexpr size_t WS_XN = 160 * MiB;
constexpr size_t WS_QKV = 304 * MiB;
constexpr size_t WS_H = WS_QKV;
constexpr size_t WS_X1Q = WS_QKV;
constexpr float SC_XQ = 16.f, SC_WIN = 512.f;
constexpr float SC_X1 = 16.f, SC_W13 = 512.f, SC_ACT = 8.f, SC_W2 = 256.f, SC_MIX = 32.f, SC_WO = 512.f;
constexpr size_t WS_ACT = WS_QKV + 128 * MiB;
constexpr size_t WS_X1B = 640 * MiB;
constexpr size_t WS_MIX = 816 * MiB;
constexpr size_t WS_XQ = WS_MIX + 64 * MiB;
constexpr size_t WS_RSTDX = 3 * MiB;
constexpr size_t WS_EREC = 944 * MiB;
constexpr size_t WS_END = 976 * MiB;
constexpr int MAXTILES = NTOK / 256 + NPAIR;
constexpr int CW_COUNT = 64;
constexpr int CW_ECOUNT = 256;
constexpr int MAXETILES = 2 * NTOK / 256 + 32;

__device__ __forceinline__ float bf2f(bf16_t v) { return __uint_as_float((unsigned)v << 16); }
__device__ __forceinline__ bf16_t f2bf(float f) { unsigned u = __float_as_uint(f); return (bf16_t)((u + 0x7fffu + ((u >> 16) & 1u)) >> 16); }
__device__ __forceinline__ float wave_sum(float v) {
#pragma unroll
    for (int o = 1; o < 64; o <<= 1) v += __shfl_xor(v, o);
    return v;
}

__device__ __forceinline__ int t5_bucket(int rel) {
    const int n = rel < 0 ? -rel : rel;
    const int upper = rel > 0 ? 16 : 0;
    const float nf = (float)(n < 1 ? 1 : n);
    int large = 8 + (int)(logf(nf / 8.f) / logf(128.f) * 8.f);
    large = large < 15 ? large : 15;
    return upper + (n < 8 ? n : large);
}
__device__ __forceinline__ void pair_experts(int L, int& ea, int& eb) {
    const int grp = L / 28; int idx = L % 28; int a = 0;
    while (idx >= 7 - a) { idx -= 7 - a; ++a; }
    ea = grp * 8 + a; eb = grp * 8 + a + 1 + idx;
}

#define LAS __attribute__((address_space(3)))
typedef short bf16x8 __attribute__((ext_vector_type(8)));
typedef float f32x4 __attribute__((ext_vector_type(4)));
typedef float f32x16 __attribute__((ext_vector_type(16)));
typedef unsigned u32x4 __attribute__((ext_vector_type(4)));
typedef unsigned u32x2 __attribute__((ext_vector_type(2)));

constexpr int NWAVES = 8, NTHREADS = 512;
constexpr int LDS_BYTES = 163840;
constexpr int RING_BYTES = 131072;
constexpr int EPI_SCR = RING_BYTES + 8192;

constexpr size_t WS_WINT = WS_WT;
constexpr size_t WS_WOT = WS_WINT + (size_t)4608 * 1024 * 2;
constexpr size_t WS_W13T = WS_WOT + (size_t)1024 * 1024 * 2;
constexpr size_t WS_W2T = WS_W13T + (size_t)32 * 1024 * 1024 * 2;
constexpr size_t WS_WINT8 = WS_W13T + (size_t)32 * 1024 * 1024;
static_assert(WS_W2T + (size_t)32 * 1024 * 512 * 2 <= WS_XN, "weight copies fit");
static_assert(WS_ACT + (size_t)MAXTILES * 256 * 1024 * 2 <= WS_X1B && WS_X1B + (size_t)NTOK * 1024 * 2 <= WS_MIX, "ACT | X1B | MIX do not overlap");

__device__ __forceinline__ unsigned cvt_pk_bf16(float lo, float hi) { unsigned r; asm volatile("v_cvt_pk_bf16_f32 %0, %1, %2" : "=v"(r) : "v"(lo), "v"(hi)); return r; }
__device__ __forceinline__ unsigned pk4_fp8(float a, float b, float c, float d) { int w = 0; w = __builtin_amdgcn_cvt_pk_fp8_f32(a, b, w, false); w = __builtin_amdgcn_cvt_pk_fp8_f32(c, d, w, true); return (unsigned)w; }
__device__ __forceinline__ unsigned pk2(float lo, float hi) { return (unsigned)f2bf(lo) | ((unsigned)f2bf(hi) << 16); }

namespace pg8 {
constexpr int BM = 256, BK = 64, HALF = 128, HTB = HALF * BK * 2, NXCD = 8, WGM = 8;
__device__ __forceinline__ int lds_byte(int r, int c) { const int st = (r >> 4) * 2 + (c >> 5), rr = r & 15, cc = c & 31, ob = rr * 64 + cc * 2; return st * 1024 + (ob ^ (((ob >> 9) & 1) << 5)); }
__device__ __forceinline__ void stage_rc(int b, int& R, int& C) { const int st = b / 1024, sb = b % 1024, swz = sb ^ (((sb >> 9) & 1) << 5); R = (st >> 1) * 16 + swz / 64; C = (st & 1) * 32 + (swz % 64) / 2; }
__device__ __forceinline__ int perm32(int rho) { const int n = rho >> 4, i = rho & 15; return 8 * (i >> 2) + 4 * n + (i & 3); }

typedef short bf16x16_t __attribute__((ext_vector_type(16)));
typedef int i32x4_t __attribute__((ext_vector_type(4)));
typedef int i32x8_t __attribute__((ext_vector_type(8)));
__device__ __forceinline__ f32x4 mfma_fp8(const bf16x8& a0, const bf16x8& a1, const bf16x8& b0, const bf16x8& b1, const f32x4& c) {
    const i32x8_t A = __builtin_shufflevector(__builtin_bit_cast(i32x4_t, a0), __builtin_bit_cast(i32x4_t, a1), 0, 1, 2, 3, 4, 5, 6, 7);
    const i32x8_t B = __builtin_shufflevector(__builtin_bit_cast(i32x4_t, b0), __builtin_bit_cast(i32x4_t, b1), 0, 1, 2, 3, 4, 5, 6, 7);
    return __builtin_amdgcn_mfma_scale_f32_16x16x128_f8f6f4(A, B, c, 0, 0, 0, 0x7F7F7F7F, 0, 0x7F7F7F7F);
}
struct Unit { const char* A; const char* B0; const char* B1; int ksplit; int e0, e1, e2, e3; };

__device__ __forceinline__ int xcd_remap(int L, int nwg) { const int q = nwg / NXCD, r = nwg % NXCD, xcd = L % NXCD, off = L / NXCD; return (xcd < r ? xcd * (q + 1) : r * (q + 1) + (xcd - r) * q) + off; }

template <class Epi, class Sched, bool GATHER, bool ALIGN_EPI, bool FP8 = false>
__device__ __forceinline__ void gemm_phase(LAS unsigned char* lds, const int nt, const int lda, const int ldb, const Sched& S, const Epi& E) {
    const int tid = threadIdx.x, wid = __builtin_amdgcn_readfirstlane(tid >> 6), lane = tid & 63, wr = wid >> 2, wc = wid & 3, fr = lane & 15, fq = lane >> 4;
    int sR[2], sC[2]; unsigned voffB[2];
#pragma unroll
    for (int i = 0; i < 2; ++i) { int R, C; stage_rc(tid * 16 + i * 8192, R, C); sR[i] = R; sC[i] = C; const int Rb = Epi::PERM ? ((R & ~31) + perm32(R & 31)) : R; voffB[i] = (unsigned)(Rb * ldb + C) * 2u; }
    const size_t kstep = (size_t)(BK * 2);
    const size_t hstepB = (size_t)HALF * ldb * 2;
    const unsigned ldsw = (unsigned)wid * 1024u;
    const int aoff = lds_byte(wr * 64 + fr, fq * 8), boff = lds_byte(wc * 32 + fr, fq * 8);
#define PG8_SA(b, h) (((b) * 2 + (h)) * HTB)
#define PG8_SB(b, h) ((4 + (b) * 2 + (h)) * HTB)
#define PG8_STAGE(bufoff, gbase, voff) do { _Pragma("unroll") for (int _i = 0; _i < 2; ++_i) \
        __builtin_amdgcn_global_load_lds((const unsigned*)((const char*)(gbase) + (voff)[_i]), (LAS unsigned*)(lds + (bufoff) + ldsw + _i * 8192), 16, 0, 0); } while (0)
#define PG8_LDA(dst, b, h) do { _Pragma("unroll") for (int m = 0; m < 4; ++m) { \
        if constexpr (FP8) { const i32x4_t lo_ = *(const LAS i32x4_t*)(lds + PG8_SA(b, h) + aoff + m * 2048), hi_ = *(const LAS i32x4_t*)(lds + PG8_SA(b, h) + aoff + m * 2048 + 1024); dst##W[m] = __builtin_shufflevector(lo_, hi_, 0, 1, 2, 3, 4, 5, 6, 7); } \
        else { _Pragma("unroll") for (int k = 0; k < 2; ++k) dst[m][k] = *(const LAS bf16x8*)(lds + PG8_SA(b, h) + aoff + m * 2048 + k * 1024); } } } while (0)
#define PG8_LDB(dst, b, h) do { _Pragma("unroll") for (int n = 0; n < 2; ++n) { \
        if constexpr (FP8) { const i32x4_t lo_ = *(const LAS i32x4_t*)(lds + PG8_SB(b, h) + boff + n * 2048), hi_ = *(const LAS i32x4_t*)(lds + PG8_SB(b, h) + boff + n * 2048 + 1024); dst##W[n] = __builtin_shufflevector(lo_, hi_, 0, 1, 2, 3, 4, 5, 6, 7); } \
        else { _Pragma("unroll") for (int k = 0; k < 2; ++k) dst[n][k] = *(const LAS bf16x8*)(lds + PG8_SB(b, h) + boff + n * 2048 + k * 1024); } } } while (0)
#define PG8_MMA(ai, bj, At, Bt) do { __builtin_amdgcn_s_setprio(1); _Pragma("unroll") for (int m = 0; m < 4; ++m) _Pragma("unroll") for (int n = 0; n < 2; ++n) { \
        if constexpr (FP8) asm("v_mfma_scale_f32_16x16x128_f8f6f4 %0, %1, %2, %0, %3, %3 op_sel_hi:[0,0,0]" : "+v"(acc[ai][bj][m][n]) : "v"(Bt##W[n]), "v"(At##W[m]), "v"(one8)); \
        else { _Pragma("unroll") for (int k = 0; k < 2; ++k) acc[ai][bj][m][n] = __builtin_amdgcn_mfma_f32_16x16x32_bf16(Bt[n][k], At[m][k], acc[ai][bj][m][n], 0, 0, 0); } } __builtin_amdgcn_s_setprio(0); } while (0)
#define PG8_WAIT_V(n) asm volatile("s_waitcnt vmcnt(" #n ")" ::: "memory")
#define PG8_WAIT_VN(n) asm volatile("s_waitcnt vmcnt(%0)" :: "n"(n) : "memory")
#define PG8_WAIT_L(n) asm volatile("s_waitcnt lgkmcnt(" #n ")" ::: "memory")
#define PG8_BAR __builtin_amdgcn_s_barrier()
#define PG8_SCHED __builtin_amdgcn_sched_barrier(0)
#define PG8_BP(u, t) (((t) < (u).ksplit ? (u).B0 : (u).B1) + (size_t)(t) * kstep)
    Unit cur, nxt; int ui = 0;
    if (!S.next(0, cur)) return;
    f32x4 acc[2][2][4][2];
#pragma unroll
    for (int a = 0; a < 2; ++a)
#pragma unroll
        for (int b = 0; b < 2; ++b)
#pragma unroll
            for (int m = 0; m < 4; ++m)
#pragma unroll
                for (int n = 0; n < 2; ++n) acc[a][b][m][n] = (f32x4){0.f, 0.f, 0.f, 0.f};
    bf16x8 At[4][2], B0[2][2], B1[2][2];
    i32x8_t AtW[4], B0W[2], B1W[2];
    const int one8 = 0x7F7F7F7F;
    unsigned vA[2][2], nvA[2][2];
    S.template aoffs<GATHER>(cur, sR, sC, lda, vA);
    const char* cA = cur.A; const char* cB0 = PG8_BP(cur, 0); const char* cB1 = PG8_BP(cur, 1);
    PG8_STAGE(PG8_SB(0, 0), cB0, voffB); PG8_STAGE(PG8_SB(0, 1), cB0 + hstepB, voffB); PG8_STAGE(PG8_SA(0, 0), cA, vA[0]); PG8_STAGE(PG8_SA(0, 1), cA, vA[1]);
    if (wr == 1) PG8_BAR;
    PG8_WAIT_V(2); PG8_BAR;
    PG8_STAGE(PG8_SB(1, 0), cB1, voffB); PG8_STAGE(PG8_SA(1, 0), cA + kstep, vA[0]); PG8_STAGE(PG8_SB(1, 1), cB1 + hstepB, voffB);
    PG8_WAIT_V(6); PG8_BAR;
    for (;;) {
        const bool has_next = S.next(ui + 1, nxt);
        if (!has_next) nxt = cur;
        unsigned rawA[2][2];
        if constexpr (GATHER) {
            if (has_next) { int R2[2]; { int C_, t_ = tid; asm volatile("" : "+v"(t_)); pg8::stage_rc(t_ * 16, R2[0], C_); pg8::stage_rc(t_ * 16 + 8192, R2[1], C_); } S.raw(nxt, R2, rawA); }
        }
        const char* nA = nxt.A;
#pragma unroll 1
        for (int t = 0; t < nt; t += 2) {
            const bool last = (t == nt - 2);
            const char* a1 = cA + (size_t)(t + 1) * kstep;
            const char* a2 = last ? nA : cA + (size_t)(t + 2) * kstep; const char* a3 = a2 + kstep;
            const char* b2 = last ? PG8_BP(nxt, 0) : PG8_BP(cur, t + 2); const char* b3 = last ? PG8_BP(nxt, 1) : PG8_BP(cur, t + 3);
            unsigned wA[2][2];
#pragma unroll
            for (int h = 0; h < 2; ++h)
#pragma unroll
                for (int i = 0; i < 2; ++i) wA[h][i] = vA[h][i];
            if constexpr (GATHER) {
                if (last) { asm volatile("" : "+v"(nvA[0][0]), "+v"(nvA[0][1]), "+v"(nvA[1][0]), "+v"(nvA[1][1]));
                            wA[0][0] = nvA[0][0]; wA[0][1] = nvA[0][1]; wA[1][0] = nvA[1][0]; wA[1][1] = nvA[1][1]; }
            }
            PG8_LDB(B0, 0, 0); PG8_LDB(B1, 0, 1); PG8_SCHED; PG8_LDA(At, 0, 0); PG8_STAGE(PG8_SA(1, 1), a1, vA[1]);
            if (Epi::NST > 0 && t == 0 && ui > 0) PG8_WAIT_VN(8 + Epi::NST); else PG8_WAIT_V(8);
            PG8_WAIT_L(0); PG8_BAR; PG8_MMA(0, 0, At, B0); PG8_MMA(0, 1, At, B1); PG8_BAR; PG8_SCHED;
            PG8_LDA(At, 0, 1); PG8_STAGE(PG8_SB(0, 0), b2, voffB); PG8_STAGE(PG8_SB(0, 1), b2 + hstepB, voffB); PG8_STAGE(PG8_SA(0, 0), a2, wA[0]);
            if (Epi::NST > 0 && t == 0 && ui > 0) PG8_WAIT_VN(8 + Epi::NST); else PG8_WAIT_V(8);
            PG8_WAIT_L(0); PG8_BAR; PG8_MMA(1, 0, At, B0); PG8_MMA(1, 1, At, B1); PG8_BAR; PG8_SCHED;
            PG8_LDB(B0, 1, 0); PG8_LDB(B1, 1, 1); PG8_SCHED; PG8_LDA(At, 1, 0); PG8_STAGE(PG8_SA(0, 1), a2, wA[1]);
            PG8_WAIT_V(8); PG8_WAIT_L(0); PG8_BAR; PG8_MMA(0, 0, At, B0); PG8_MMA(0, 1, At, B1); PG8_BAR; PG8_SCHED;
            PG8_LDA(At, 1, 1); PG8_STAGE(PG8_SB(1, 0), b3, voffB); PG8_STAGE(PG8_SB(1, 1), b3 + hstepB, voffB); PG8_STAGE(PG8_SA(1, 0), a3, wA[0]);
            PG8_WAIT_V(8); PG8_WAIT_L(0); PG8_BAR; PG8_MMA(1, 0, At, B0); PG8_MMA(1, 1, At, B1); PG8_BAR; PG8_SCHED;
            if constexpr (GATHER) {
                if (t == 0) {
                    if (has_next) { asm volatile("" : "+v"(rawA[0][0]), "+v"(rawA[0][1]), "+v"(rawA[1][0]), "+v"(rawA[1][1])); int C2[2]; { int R_, t_ = tid; asm volatile("" : "+v"(t_)); pg8::stage_rc(t_ * 16, R_, C2[0]); pg8::stage_rc(t_ * 16 + 8192, R_, C2[1]); } S.fin(rawA, C2, lda, nvA); }
                    else {
#pragma unroll
                        for (int h = 0; h < 2; ++h)
#pragma unroll
                            for (int i = 0; i < 2; ++i) nvA[h][i] = vA[h][i];
                    }
                }
            }
        }
        if constexpr (ALIGN_EPI) { if (wr == 0) PG8_BAR; }
        if constexpr (FP8) asm volatile("s_nop 15\n\ts_nop 15" ::: "memory");
        E(acc, cur, wr, wc, fr, fq);
        if (!has_next) break;
#pragma unroll
        for (int a = 0; a < 2; ++a)
#pragma unroll
            for (int b = 0; b < 2; ++b)
#pragma unroll
                for (int m = 0; m < 4; ++m)
#pragma unroll
                    for (int n = 0; n < 2; ++n) acc[a][b][m][n] = (f32x4){0.f, 0.f, 0.f, 0.f};
        cur = nxt; cA = nA; ++ui;
        if constexpr (GATHER) {
#pragma unroll
            for (int h = 0; h < 2; ++h)
#pragma unroll
                for (int i = 0; i < 2; ++i) vA[h][i] = nvA[h][i];
        }
        if constexpr (ALIGN_EPI) { if (wr == 1) PG8_BAR; }
    }
    PG8_WAIT_V(0);
    if constexpr (!ALIGN_EPI) { if (wr == 0) PG8_BAR; }
    PG8_BAR;
#undef PG8_SA
#undef PG8_SB
#undef PG8_STAGE
#undef PG8_LDA
#undef PG8_LDB
#undef PG8_MMA
#undef PG8_WAIT_V
#undef PG8_WAIT_L
#undef PG8_BAR
#undef PG8_SCHED
#undef PG8_BP
}
}

struct MArgs {
    const float* in[18]; float* out; unsigned char* ws; int ph_lo, ph_hi, var, pad_;
};

template <int ST = 36>
__device__ __forceinline__ void p0_transpose_item(const float* W, int N, int k0, int n0, bf16_t* WT, int dst_row0, int ldk, LAS float* scr, int lane, const float* kscale = nullptr, float fp8scale = 0.f) {
    { const int kr = lane >> 3, g = lane & 7;
      const float* src = W + (size_t)(k0 + kr) * N + n0 + 4 * g;
      f32x4 v[8];
#pragma unroll
      for (int i = 0; i < 8; ++i) v[i] = __builtin_nontemporal_load((const f32x4*)(src + (size_t)(8 * i) * N));
#pragma unroll
      for (int i = 0; i < 8; ++i) { const int kk = kr + 8 * i; *(LAS f32x4*)(scr + kk * ST + ((g ^ i) << 2)) = v[i]; } }
    const int c = lane & 7;
    float ks[8];
    if (kscale) { const f32x4 s0 = *(const f32x4*)(kscale + k0 + 8 * c), s1 = *(const f32x4*)(kscale + k0 + 8 * c + 4); ks[0] = s0[0]; ks[1] = s0[1]; ks[2] = s0[2]; ks[3] = s0[3]; ks[4] = s1[0]; ks[5] = s1[1]; ks[6] = s1[2]; ks[7] = s1[3]; }
    else {
#pragma unroll
        for (int j = 0; j < 8; ++j) ks[j] = 1.f; }
    asm volatile("s_waitcnt lgkmcnt(0)" ::: "memory");
#pragma unroll
    for (int j = 0; j < 4; ++j) { const int n = (lane >> 3) + 8 * j; const LAS float* sp = scr + (8 * c) * ST + ((((n >> 2) ^ c) << 2) | (n & 3));
        if (fp8scale != 0.f) {
            u32x2 o; o.x = pk4_fp8(sp[0 * ST] * ks[0] * fp8scale, sp[1 * ST] * ks[1] * fp8scale, sp[2 * ST] * ks[2] * fp8scale, sp[3 * ST] * ks[3] * fp8scale);
            o.y = pk4_fp8(sp[4 * ST] * ks[4] * fp8scale, sp[5 * ST] * ks[5] * fp8scale, sp[6 * ST] * ks[6] * fp8scale, sp[7 * ST] * ks[7] * fp8scale);
            *(u32x2*)((unsigned char*)WT + (size_t)(dst_row0 + n) * ldk + k0 + 8 * c) = o;
        } else {
        u32x4 o; o.x = pk2(sp[0 * ST] * ks[0], sp[1 * ST] * ks[1]); o.y = pk2(sp[2 * ST] * ks[2], sp[3 * ST] * ks[3]); o.z = pk2(sp[4 * ST] * ks[4], sp[5 * ST] * ks[5]); o.w = pk2(sp[6 * ST] * ks[6], sp[7 * ST] * ks[7]);
        *(u32x4*)(WT + (size_t)(dst_row0 + n) * ldk + k0 + 8 * c) = o; } }
    asm volatile("s_waitcnt lgkmcnt(0)" ::: "memory");
}
__device__ __forceinline__ int inproj_pos(int n) { const int l = n & 255; return (n & ~255) + 128 * ((l >> 5) & 1) + 32 * (l >> 6) + (l & 31); }

constexpr int I_W1 = 32 * 16 * 16, I_W2 = 32 * 8 * 32, N_EXP_ITEMS = 2 * I_W1 + I_W2;
__device__ __forceinline__ void item_fp8_reg(const float* W, int N, int k0, int n0, unsigned char* WT, int dst_row0, int ldk, int lane, const float* kscale, float fp8scale) {
    const int kr8 = lane & 7, g = lane >> 3;
    const float* src = W + (size_t)(k0 + 8 * kr8) * N + n0 + 4 * g;
    f32x4 v[8];
#pragma unroll
    for (int i = 0; i < 8; ++i) v[i] = __builtin_nontemporal_load((const f32x4*)(src + (size_t)i * N));
    float ks[8];
    if (kscale) { const f32x4 s0 = *(const f32x4*)(kscale + k0 + 8 * kr8), s1 = *(const f32x4*)(kscale + k0 + 8 * kr8 + 4);
        ks[0] = s0[0] * fp8scale; ks[1] = s0[1] * fp8scale; ks[2] = s0[2] * fp8scale; ks[3] = s0[3] * fp8scale; ks[4] = s1[0] * fp8scale; ks[5] = s1[1] * fp8scale; ks[6] = s1[2] * fp8scale; ks[7] = s1[3] * fp8scale; }
    else {
#pragma unroll
        for (int i = 0; i < 8; ++i) ks[i] = fp8scale; }
#pragma unroll
    for (int j = 0; j < 4; ++j) {
        u32x2 o; o.x = pk4_fp8(v[0][j] * ks[0], v[1][j] * ks[1], v[2][j] * ks[2], v[3][j] * ks[3]); o.y = pk4_fp8(v[4][j] * ks[4], v[5][j] * ks[5], v[6][j] * ks[6], v[7][j] * ks[7]);
        __builtin_nontemporal_store(o, (u32x2*)(WT + (size_t)(dst_row0 + 4 * g + j) * ldk + k0 + 8 * kr8));
    }
}
__device__ __forceinline__ void expert_item(const MArgs& a, int r, int lane) {
    bf16_t* W13T = (bf16_t*)(a.ws + WS_W13T); bf16_t* W2T = (bf16_t*)(a.ws + WS_W2T);
    if (r < 2 * I_W1) { const int which = r / I_W1; r %= I_W1; const int e = r / 256, kb = (r % 256) / 16, nb = r % 16; const int n0 = nb * 32;
        item_fp8_reg(a.in[15 + which] + (size_t)e * DM * DEXP, DEXP, kb * 64, n0, (unsigned char*)W13T, e * 1024 + 256 * (n0 >> 7) + 128 * which + (n0 & 127), DM, lane, a.in[10], SC_W13); return; }
    r -= 2 * I_W1;
    { const int e = r / 256, kb = (r % 256) / 32, nb = r % 32; item_fp8_reg(a.in[17] + (size_t)e * DEXP * DM, DM, kb * 64, nb * 32, (unsigned char*)W2T, e * 1024 + nb * 32, DEXP, lane, nullptr, SC_W2); }
}
__device__ __forceinline__ void phase0(const MArgs& a, LAS unsigned char* lds, int vcu, int G) {
    const int tid = threadIdx.x, lane = tid & 63, wave = __builtin_amdgcn_readfirstlane(tid >> 6);
    unsigned char* ws = a.ws;
    LAS float* scr = (LAS float*)(lds + wave * 16384);
    const int gw = vcu * NWAVES + wave, NGW = G * NWAVES;
    constexpr int I_IN = 16 * 128, I_MK = 16 * 16, I_O = 16 * 32;
    constexpr int NITEMS = I_IN + I_MK + I_O;
    bf16_t* WinT = (bf16_t*)(ws + WS_WINT); bf16_t* WoT = (bf16_t*)(ws + WS_WOT);
    for (int it = gw; it < NITEMS; it += NGW) {
        int r = it;
        if (r < I_IN) { const int kb = r / 128, nb = r % 128; p0_transpose_item(a.in[3], IN_COLS, kb * 64, nb * 32, (bf16_t*)(ws + WS_WINT8), inproj_pos(nb * 32), DM, scr, lane, a.in[2], SC_WIN); continue; } r -= I_IN;
        if (r < I_MK) { const int kb = r / 16, nb = r % 16; p0_transpose_item(a.in[8], 512, kb * 64, nb * 32, WinT, 4096 + inproj_pos(nb * 32), DM, scr, lane); continue; } r -= I_MK;
        { const int kb = r / 32, nb = r % 32; p0_transpose_item(a.in[9], DM, kb * 64, nb * 32, WoT, inproj_pos(nb * 32), DM, scr, lane, nullptr, SC_WO); }
    }
    bf16_t* XN = (bf16_t*)(ws + WS_XN); float* rstdx = (float*)(ws + WS_RSTDX);
    for (int r = gw; r < MROWS; r += NGW) {
        const bool isx = r < NTOK;
        const float* src = isx ? a.in[0] + (size_t)r * DM : a.in[1] + (size_t)(r - NTOK) * DM;
        const float4* xr = (const float4*)src;
        float4 v[4]; float s = 0.f;
#pragma unroll
        for (int j = 0; j < 4; ++j) { { const f32x4 t_ = __builtin_nontemporal_load((const f32x4*)(xr + lane + 64 * j)); v[j] = (float4){t_[0], t_[1], t_[2], t_[3]}; } s += v[j].x * v[j].x + v[j].y * v[j].y + v[j].z * v[j].z + v[j].w * v[j].w; }
        s = wave_sum(s);
        const float rstd = rsqrtf(s * (1.f / DM) + EPS);
        if (isx) { if (lane == 0) rstdx[r] = rstd; }
        const float sc = isx ? 1.f : rstd;
#pragma unroll
        for (int j = 0; j < 4; ++j) {
            float4 gg = (float4){1.f, 1.f, 1.f, 1.f}; if (!isx) gg = ((const float4*)a.in[7])[lane + 64 * j];
            u32x2 o; o.x = pk2(v[j].x * sc * gg.x, v[j].y * sc * gg.y); o.y = pk2(v[j].z * sc * gg.z, v[j].w * sc * gg.w);
            if (!isx) __builtin_nontemporal_store(o, (u32x2*)(XN + (size_t)r * DM) + lane + 64 * j);
            if (isx) { const float q = rstd * SC_XQ; ((unsigned*)(ws + WS_XQ + (size_t)r * DM))[lane + 64 * j] = pk4_fp8(v[j].x * q, v[j].y * q, v[j].z * q, v[j].w * q); }
        }
    }
    { bf16_t* WfH = (bf16_t*)(ws + WS_WRF); bf16_t* WfL = WfH + 32 * 3 * 64 * 8; float* b48 = (float*)(ws + WS_WRF + 2 * 32 * 3 * 64 * 8 * 2);
      for (int t = vcu * NTHREADS + tid; t < 32 * 3 * 64 * 8 + 48; t += G * NTHREADS) {
          if (t < 32 * 3 * 64 * 8) { const int j = t & 7, ln = (t >> 3) & 63, sc = t >> 9, ct = sc % 3, st = sc / 3; const int k = 32 * st + 8 * (ln >> 4) + j, col = 16 * ct + (ln & 15);
              const float w = (col < 4 ? a.in[11][k * 4 + col] : (col < 36 ? a.in[13][k * 32 + col - 4] : 0.f)) * a.in[10][k];
              const bf16_t hi = f2bf(w); WfH[t] = hi; WfL[t] = f2bf(w - bf2f(hi)); }
          else { const int col = t - 32 * 3 * 64 * 8; b48[col] = col < 4 ? a.in[12][col] : (col < 36 ? a.in[14][col - 4] : 0.f); }
      } }
    float* biasD = (float*)(ws + WS_BIASD); float* rpb = (float*)(ws + WS_RPB);
    for (int t = vcu * NTHREADS + tid; t < 8 * 15 * 31; t += G * NTHREADS) {
        if (t < 3 * 4 * 129) { const int j = t % 129, hh = (t / 129) % 4, g = t / (129 * 4); const int dil = g == 0 ? 1 : (g == 1 ? 4 : 16);
            biasD[t] = a.in[6][t5_bucket((j - 64) * dil) * 12 + g * 4 + hh] * LOG2E; }
        rpb[t] = a.in[5][t] * LOG2E;
    }
}

template <bool V8>
struct SchedInProjT {
    static constexpr int NPN = 16;
    static constexpr unsigned long long MAP = 0xFEDCBA9876543210ull;
    const char* A; const char* B; int G, c;
    __device__ __forceinline__ bool next(int i, pg8::Unit& u) const {
        const int L = i * G + c; constexpr int NW = 256 * NPN;
        int pm, pn;
        if (L < NW) { const int wgid = pg8::xcd_remap(L, NW); const int nig = pg8::WGM * NPN, gid = wgid / nig, fm = gid * pg8::WGM; pm = fm + ((wgid % nig) % pg8::WGM); pn = (int)((MAP >> (4 * ((wgid % nig) / pg8::WGM))) & 15); }
        else return false;
        constexpr int EB = V8 ? 1 : 2;
        u.A = A + (size_t)pm * 256 * DM * EB; u.B0 = B + (size_t)pn * 256 * DM * EB; u.B1 = u.B0; u.ksplit = 1 << 30; u.e0 = pm; u.e1 = pn; u.e2 = 0; u.e3 = 0;
        return true;
    }
    template <bool GATHER> __device__ __forceinline__ void aoffs(const pg8::Unit&, const int (&sR)[2], const int (&sC)[2], int lda, unsigned (&v)[2][2]) const {
#pragma unroll
        for (int h = 0; h < 2; ++h)
#pragma unroll
            for (int i = 0; i < 2; ++i) v[h][i] = (unsigned)((sR[i] + 128 * h) * lda + sC[i]) * 2u;
    }
};
typedef float f32x2_t __attribute__((ext_vector_type(2)));
struct EpiInProj {
    static constexpr bool PERM = true; static constexpr int NST = 16;
    bf16_t* QKV; bf16_t* KVM; const float* gain; const float* rstdx; float ascale; int var;
    LAS unsigned char* scr0;
    __device__ __forceinline__ void operator()(const f32x4 (&acc)[2][2][4][2], const pg8::Unit& u, int wr, int wc, int fr, int fq) const {
        if (!MK_ONE_LAUNCH && var == 1) return;
        const int pm = u.e0, pn = u.e1;
        int gi = -1; float sc = 1.f; bf16_t* base; int hplane, nrows, rowt;
        if (pn < 16) { base = QKV; hplane = 4 * pn; nrows = NTOK; rowt = pm * 256;
            if (pn < 2) { gi = 0; sc = QSCALE; } else if (pn < 4) gi = 1; else if (pn < 6) gi = -1; else if (pn < 9) { gi = 2; sc = QSCALE; } else if (pn < 12) gi = 3; else if (pn < 15) gi = -1; else { gi = 4; sc = QSCALE; } }
        else { base = KVM; hplane = 4 * (pn - 16); nrows = BATCH * MEM_LEN; rowt = (pm - 256) * 256; gi = pn == 16 ? 5 : -1; }
        float gv[2][2][4];
        { const int gi0 = gi < 0 ? 0 : gi;
          f32x4 gl[2][2];
#pragma unroll
          for (int bj = 0; bj < 2; ++bj)
#pragma unroll
              for (int n = 0; n < 2; ++n) gl[bj][n] = *(const f32x4*)(gain + gi0 * 64 + 32 * bj + 8 * fq + 4 * n);
#pragma unroll
          for (int bj = 0; bj < 2; ++bj)
#pragma unroll
              for (int n = 0; n < 2; ++n)
#pragma unroll
                  for (int j = 0; j < 4; ++j) gv[bj][n][j] = gi >= 0 ? gl[bj][n][j] * sc : 1.f; }
#pragma unroll
        for (int ai = 0; ai < 2; ++ai)
#pragma unroll
            for (int m = 0; m < 4; ++m) {
                const float rx = ascale;
                f32x2_t s2 = {0.f, 0.f};
#pragma unroll
                for (int bj = 0; bj < 2; ++bj)
#pragma unroll
                    for (int n = 0; n < 2; ++n) { const f32x4 x = acc[ai][bj][m][n]; const f32x2_t lo = {x[0], x[1]}, hi = {x[2], x[3]}; s2 = __builtin_elementwise_fma(lo, lo, s2); s2 = __builtin_elementwise_fma(hi, hi, s2); }
                float ss = s2[0] + s2[1];
                ss += __shfl_xor(ss, 16); ss += __shfl_xor(ss, 32);
                const float r = (gi >= 0 ? rsqrtf(ss * (rx * rx) * (1.f / 64.f) + EPS) : 1.f) * rx;
                const f32x2_t r2 = {r, r};
                const unsigned sb = (unsigned)(size_t)(scr0 + (wr * 4 + wc) * 2048);
#pragma unroll
                for (int bj = 0; bj < 2; ++bj) {
                    unsigned wv[4];
#pragma unroll
                    for (int n = 0; n < 2; ++n) {
                        const f32x4 x = acc[ai][bj][m][n];
                        const f32x2_t lo = (f32x2_t){x[0], x[1]} * r2 * (f32x2_t){gv[bj][n][0], gv[bj][n][1]}, hi = (f32x2_t){x[2], x[3]} * r2 * (f32x2_t){gv[bj][n][2], gv[bj][n][3]};
                        wv[2 * n] = cvt_pk_bf16(lo[0], lo[1]); wv[2 * n + 1] = cvt_pk_bf16(hi[0], hi[1]);
                    }
                    const u32x4 w4 = (u32x4){wv[0], wv[1], wv[2], wv[3]};
                    const unsigned wa = sb + fr * 128 + (((4 * bj + fq) ^ (fr & 7)) << 4);
                    asm volatile("ds_write_b128 %0, %1" :: "v"(wa), "v"(w4) : "memory");
                }
                u32x4 ov[2];
#pragma unroll
                for (int rr = 0; rr < 2; ++rr) { const int row = 8 * rr + 2 * fq + (fr >> 3); const unsigned ra = sb + row * 128 + (((fr & 7) ^ (row & 7)) << 4);
                    asm volatile("ds_read_b128 %0, %1" : "=v"(ov[rr]) : "v"(ra) : "memory"); }
                asm volatile("s_waitcnt lgkmcnt(0)" : "+v"(ov[0]), "+v"(ov[1]) :: "memory");
#pragma unroll
                for (int rr = 0; rr < 2; ++rr) { const int row = 8 * rr + 2 * fq + (fr >> 3);
                    bf16_t* rowp = base + ((size_t)(hplane + wc) * nrows + (rowt + ai * 128 + wr * 64 + m * 16 + row)) * 64 + 8 * (fr & 7);
                    __builtin_nontemporal_store(ov[rr], (u32x4*)rowp); }
            }
    }
};


struct SchedOutProj {
    const char* A; const char* B; int G, c;
    __device__ __forceinline__ bool next(int i, pg8::Unit& u) const {
        const int L = i * G + c; constexpr int NW = 256 * 4;
        if (L >= NW) return false;
        const int wgid = pg8::xcd_remap(L, NW); const int nig = pg8::WGM * 4, gid = wgid / nig, fm = gid * pg8::WGM; const int pm = fm + ((wgid % nig) % pg8::WGM), pn = (wgid % nig) / pg8::WGM;
        u.A = A + (size_t)pm * 256 * DM; u.B0 = B + (size_t)pn * 256 * DM; u.B1 = u.B0; u.ksplit = 1 << 30; u.e0 = pm; u.e1 = pn; u.e2 = 0; u.e3 = 0;
        return true;
    }
    template <bool GATHER> __device__ __forceinline__ void aoffs(const pg8::Unit&, const int (&sR)[2], const int (&sC)[2], int lda, unsigned (&v)[2][2]) const {
#pragma unroll
        for (int h = 0; h < 2; ++h)
#pragma unroll
            for (int i = 0; i < 2; ++i) v[h][i] = (unsigned)((sR[i] + 128 * h) * lda + sC[i]) * 2u;
    }
};
struct EpiOutProj {
    static constexpr bool PERM = true; static constexpr int NST = 24;
    const float* Xf; bf16_t* O; unsigned char* Q8;
    LAS unsigned char* scr0;
    __device__ __forceinline__ void operator()(const f32x4 (&acc)[2][2][4][2], const pg8::Unit& u, int wr, int wc, int fr, int fq) const {
        const int row0 = u.e0 * 256 + wr * 64 + fr, col0 = u.e1 * 256 + wc * 64 + 8 * fq;
        const unsigned sb = (unsigned)(size_t)(scr0 + (wr * 4 + wc) * 2048);
#pragma unroll
        for (int ai = 0; ai < 2; ++ai) {
            f32x4 xf[4][2][2];
#pragma unroll
            for (int m = 0; m < 4; ++m) { const size_t off = (size_t)(row0 + ai * 128 + m * 16) * DM + col0;
#pragma unroll
                for (int bj = 0; bj < 2; ++bj) { xf[m][bj][0] = __builtin_nontemporal_load((const f32x4*)(Xf + off + bj * 32)); xf[m][bj][1] = __builtin_nontemporal_load((const f32x4*)(Xf + off + bj * 32 + 4)); } }
#pragma unroll
            for (int m = 0; m < 4; ++m) {
                unsigned qv[2][2];
#pragma unroll
                for (int bj = 0; bj < 2; ++bj) { const f32x4 x0 = xf[m][bj][0], x1v = xf[m][bj][1];
                    const f32x4 v0 = x0 + acc[ai][bj][m][0] * (1.f / (SC_MIX * SC_WO)), v1 = x1v + acc[ai][bj][m][1] * (1.f / (SC_MIX * SC_WO));
                    u32x4 w; w.x = cvt_pk_bf16(v0[0], v0[1]); w.y = cvt_pk_bf16(v0[2], v0[3]); w.z = cvt_pk_bf16(v1[0], v1[1]); w.w = cvt_pk_bf16(v1[2], v1[3]);
                    qv[bj][0] = pk4_fp8(v0[0] * SC_X1, v0[1] * SC_X1, v0[2] * SC_X1, v0[3] * SC_X1); qv[bj][1] = pk4_fp8(v1[0] * SC_X1, v1[1] * SC_X1, v1[2] * SC_X1, v1[3] * SC_X1);
                    const unsigned wa = sb + fr * 128 + (((4 * bj + fq) ^ (fr & 7)) << 4);
                    asm volatile("ds_write_b128 %0, %1" :: "v"(wa), "v"(w) : "memory");
                }
                u32x4 ov[2];
#pragma unroll
                for (int rr = 0; rr < 2; ++rr) { const int row = 8 * rr + 2 * fq + (fr >> 3); const unsigned ra = sb + row * 128 + (((fr & 7) ^ (row & 7)) << 4);
                    asm volatile("ds_read_b128 %0, %1" : "=v"(ov[rr]) : "v"(ra) : "memory"); }
                asm volatile("s_waitcnt lgkmcnt(0)" : "+v"(ov[0]), "+v"(ov[1]) :: "memory");
                const size_t rbase = (size_t)(u.e0 * 256 + wr * 64 + ai * 128 + m * 16) * DM + u.e1 * 256 + wc * 64;
#pragma unroll
                for (int rr = 0; rr < 2; ++rr) { const int row = 8 * rr + 2 * fq + (fr >> 3), c = fr & 7;
                    *(u32x4*)(O + rbase + (size_t)row * DM + c * 8) = ov[rr]; }
                {   const int row = fr;
                    const unsigned q0 = sb + row * 64 + (((0 + (fq >> 1)) ^ (row & 3)) << 4) + (fq & 1) * 8, q1 = sb + row * 64 + (((2 + (fq >> 1)) ^ (row & 3)) << 4) + (fq & 1) * 8;
                    const u32x2 a0 = (u32x2){qv[0][0], qv[0][1]}, a1 = (u32x2){qv[1][0], qv[1][1]};
                    asm volatile("ds_write_b64 %0, %1" :: "v"(q0), "v"(a0) : "memory");
                    asm volatile("ds_write_b64 %0, %1" :: "v"(q1), "v"(a1) : "memory"); }
                u32x4 oq;
                { const int row = 4 * fq + (fr >> 2), c = fr & 3; const unsigned ra = sb + row * 64 + ((c ^ (row & 3)) << 4);
                  asm volatile("ds_read_b128 %0, %1" : "=v"(oq) : "v"(ra) : "memory");
                  asm volatile("s_waitcnt lgkmcnt(0)" : "+v"(oq) :: "memory");
                  *(u32x4*)(Q8 + rbase + (size_t)row * DM + c * 16) = oq; }
            }
        }
    }
};

constexpr int TT_OFF = RING_BYTES;
constexpr int TT_PBASE = 1 + 2 * MAXTILES, TT_E = TT_PBASE + NPAIR;
static_assert((TT_E + 1 + 2 * MAXETILES) * 4 <= 8192 && EPI_SCR + 16384 <= LDS_BYTES - 256, "tile tables and the epilogue scratch fit the spare LDS");
__device__ __forceinline__ int lds_tab(const LAS int* p) { int v; asm volatile("ds_read_b32 %0, %1\n\ts_waitcnt lgkmcnt(0)" : "=v"(v) : "v"((unsigned)(size_t)p) : "memory"); return v; }
__device__ __forceinline__ int moe_build_tiles(LAS unsigned char* lds, const unsigned* count, const unsigned* ecount) {
    LAS int* tt = (LAS int*)(lds + TT_OFF);
    LAS int* cn = (LAS int*)(lds + EPI_SCR);
    const int tid = threadIdx.x;
    __syncthreads();
    int c = 0;
    if (tid < NPAIR) c = (int)__hip_atomic_load(count + tid, __ATOMIC_RELAXED, __HIP_MEMORY_SCOPE_AGENT);
    else if (tid >= 128 && tid < 128 + NEXP) c = (int)__hip_atomic_load(ecount + (tid - 128), __ATOMIC_RELAXED, __HIP_MEMORY_SCOPE_AGENT);
    if (tid < 160) cn[tid] = (c + 255) >> 8;
    __syncthreads();
    if (tid < NPAIR) {
        int base = 0;
        for (int j = 0; j < tid; ++j) base += cn[j];
        tt[TT_PBASE + tid] = base;
        for (int r = 0, k = 0; r < c; r += 256, ++k) { tt[1 + base + k] = tid; tt[1 + MAXTILES + base + k] = r; }
        if (tid == NPAIR - 1) tt[0] = base + cn[tid];
    } else if (tid >= 128 && tid < 128 + NEXP) {
        const int e = tid - 128; int base = 0;
        for (int j = 0; j < e; ++j) base += cn[128 + j];
        for (int r = 0, k = 0; r < c; r += 256, ++k) { tt[TT_E + 1 + base + k] = e; tt[TT_E + 1 + MAXETILES + base + k] = r + (c - r < 256 ? c - r : 256) - 1; }
        if (e == NEXP - 1) tt[TT_E] = base + cn[tid];
    }
    __syncthreads();
    return tt[0];
}
struct SchedMoe1 {
    const char* Hb; const char* W13T; const int* elists; const unsigned* ecount; const LAS int* tt; int netiles, G, c;
    __device__ __forceinline__ bool next(int i, pg8::Unit& u) const {
        const int L = i * G + c, nwg = netiles * 4;
        if (L >= nwg) return false;
        const int U = pg8::xcd_remap(L, nwg), T = U >> 2, pn = U & 3;
        const int e = __builtin_amdgcn_readfirstlane(lds_tab(tt + TT_E + 1 + T)), rv = __builtin_amdgcn_readfirstlane(lds_tab(tt + TT_E + 1 + MAXETILES + T)), row0 = rv & ~255;
        u.A = Hb; u.B0 = W13T + ((size_t)e * 1024 + pn * 256) * DM; u.B1 = u.B0; u.ksplit = 1 << 30; u.e0 = (rv & 255) + 1; u.e1 = pn; u.e2 = e; u.e3 = row0;
        return true;
    }
    __device__ __forceinline__ void raw(const pg8::Unit& u, const int (&sR)[2], unsigned (&r)[2][2]) const {
        const int valid = u.e0; const int* lp = elists + (size_t)u.e2 * NTOK + u.e3;
#pragma unroll
        for (int h = 0; h < 2; ++h)
#pragma unroll
            for (int i = 0; i < 2; ++i) { int p = 128 * h + sR[i]; p = p < valid ? p : valid - 1; const int* q = lp + p; asm volatile("global_load_dword %0, %1, off" : "=v"(r[h][i]) : "v"(q) : "memory"); }
    }
    __device__ __forceinline__ void fin(const unsigned (&r)[2][2], const int (&sC)[2], int lda, unsigned (&v)[2][2]) const {
#pragma unroll
        for (int h = 0; h < 2; ++h)
#pragma unroll
            for (int i = 0; i < 2; ++i) v[h][i] = (unsigned)((int)(r[h][i] >> 1) * lda + sC[i]) * 2u;
    }
    template <bool GATHER> __device__ __forceinline__ void aoffs(const pg8::Unit& u, const int (&sR)[2], const int (&sC)[2], int lda, unsigned (&v)[2][2]) const {
        const int valid = u.e0; const int* lp = elists + (size_t)u.e2 * NTOK + u.e3;
#pragma unroll
        for (int h = 0; h < 2; ++h)
#pragma unroll
            for (int i = 0; i < 2; ++i) { int p = 128 * h + sR[i]; p = p < valid ? p : valid - 1; const int tok = lp[p] >> 1; v[h][i] = (unsigned)(tok * lda + sC[i]) * 2u; }
    }
};
struct EpiMoe1 {
    static constexpr bool PERM = true; static constexpr int NST = 0;
    bf16_t* ACT; const int* elists; const unsigned* ecount; const float* tokg; const float* trstd; const int* tokP; const LAS int* tt;
    LAS unsigned char* scr0; const u32x4* erec;
    __device__ __forceinline__ void operator()(const f32x4 (&acc)[2][2][4][2], const pg8::Unit& u, int wr, int wc, int fr, int fq) const {
        const int pn = u.e1, valid = u.e0; const int* lp = elists + (size_t)u.e2 * NTOK + u.e3;
        const unsigned sb = (unsigned)(size_t)(scr0 + (wr * 4 + wc) * 2048);
        const u32x4* rp = erec + (size_t)u.e2 * NTOK + u.e3;
        u32x4 rec[2][4];
#pragma unroll
        for (int ai = 0; ai < 2; ++ai)
#pragma unroll
            for (int m = 0; m < 4; ++m) { const int p = ai * 128 + wr * 64 + m * 16 + fr; rec[ai][m] = rp[p < valid ? p : valid - 1]; }
        float gg[2][4], rr[2][4]; int mta[2][4];
#pragma unroll
        for (int ai = 0; ai < 2; ++ai)
#pragma unroll
            for (int m = 0; m < 4; ++m) { const int tp = (int)rec[ai][m].z;
                gg[ai][m] = __uint_as_float(rec[ai][m].x); rr[ai][m] = __uint_as_float(rec[ai][m].y);
                asm volatile("ds_read_b32 %0, %1" : "=v"(mta[ai][m]) : "v"((unsigned)(size_t)(tt + TT_PBASE + (tp >> 16))) : "memory"); }
        asm volatile("s_waitcnt lgkmcnt(0)" : "+v"(mta[0][0]), "+v"(mta[0][1]), "+v"(mta[0][2]), "+v"(mta[0][3]), "+v"(mta[1][0]), "+v"(mta[1][1]), "+v"(mta[1][2]), "+v"(mta[1][3]) :: "memory");
#pragma unroll
        for (int ai = 0; ai < 2; ++ai)
#pragma unroll
            for (int m = 0; m < 4; ++m) { const int tp = (int)rec[ai][m].z, p = ai * 128 + wr * 64 + m * 16 + fr;
                const int drow = mta[ai][m] * 256 + (tp & 0xffff); mta[ai][m] = p < valid ? drow * 2 + (int)(rec[ai][m].w & 1u) : -1; }
#pragma unroll
        for (int ai = 0; ai < 2; ++ai)
#pragma unroll
            for (int m0 = 0; m0 < 4; m0 += 2) {
                int meta[2];
#pragma unroll
                for (int mm = 0; mm < 2; ++mm) { const int m = m0 + mm;
                    const float g = gg[ai][m] * SC_ACT, rs = rr[ai][m] * (1.f / (SC_X1 * SC_W13));
                    const float rse = rs * -1.44269504f, rsg = rs * rs * g;
                    meta[mm] = mta[ai][m];
                    const f32x4 a0 = acc[ai][0][m][0], a1 = acc[ai][0][m][1], b0 = acc[ai][1][m][0], b1 = acc[ai][1][m][1];
                    float o[8];
#pragma unroll
                    for (int j = 0; j < 4; ++j) {
                        o[j] = a0[j] * __builtin_amdgcn_rcpf(1.f + __builtin_amdgcn_exp2f(a0[j] * rse)) * (b0[j] * rsg); o[4 + j] = a1[j] * __builtin_amdgcn_rcpf(1.f + __builtin_amdgcn_exp2f(a1[j] * rse)) * (b1[j] * rsg); }
#pragma unroll
                    for (int j = 0; j < 8; ++j) o[j] = __builtin_amdgcn_fmed3f(o[j], -448.f, 448.f);
                    const u32x2 w = (u32x2){pk4_fp8(o[0], o[1], o[2], o[3]), pk4_fp8(o[4], o[5], o[6], o[7])};
                    const unsigned wa = sb + (mm * 16 + fr) * 32 + fq * 8;
                    asm volatile("ds_write_b64 %0, %1" :: "v"(wa), "v"(w) : "memory");
                }
                const int mm2 = fq >> 1, row = 8 * (fq & 1) + (fr >> 1), half = fr & 1;
                u32x4 ov;
                { const unsigned ra = sb + (mm2 * 16 + row) * 32 + half * 16;
                  asm volatile("ds_read_b128 %0, %1" : "=v"(ov) : "v"(ra) : "memory"); }
                const int t0 = __builtin_amdgcn_ds_bpermute(row << 2, meta[0]), t1 = __builtin_amdgcn_ds_bpermute(row << 2, meta[1]);
                const int mt = mm2 ? t1 : t0;
                asm volatile("s_waitcnt lgkmcnt(0)" : "+v"(ov) :: "memory");
                if (mt >= 0) *(u32x4*)((unsigned char*)ACT + (size_t)(mt >> 1) * DM + 512 * (mt & 1) + 128 * pn + 32 * wc + 16 * half) = ov;
            }
    }
};
struct SchedMoe2 {
    const char* ACTb; const char* W2T; const LAS int* tt; int ntiles, G, c;
    __device__ __forceinline__ bool next(int i, pg8::Unit& u) const {
        const int L = i * G + c, nwg = ntiles * 4;
        if (L >= nwg) return false;
        const int U = pg8::xcd_remap(L, nwg), T = U >> 2, pn = U & 3;
        const int list = __builtin_amdgcn_readfirstlane(lds_tab(tt + 1 + T)), row0 = __builtin_amdgcn_readfirstlane(lds_tab(tt + 1 + MAXTILES + T));
        int ea, eb; pair_experts(list, ea, eb);
        u.A = ACTb + (size_t)T * 256 * DM; u.B0 = W2T + ((size_t)ea * 1024 + pn * 256) * DEXP; u.B1 = W2T + ((size_t)eb * 1024 + pn * 256) * DEXP - 4 * 128; u.ksplit = 4;
        u.e0 = T; u.e1 = pn; u.e2 = list; u.e3 = row0;
        return true;
    }
    template <bool GATHER> __device__ __forceinline__ void aoffs(const pg8::Unit&, const int (&sR)[2], const int (&sC)[2], int lda, unsigned (&v)[2][2]) const {
#pragma unroll
        for (int h = 0; h < 2; ++h)
#pragma unroll
            for (int i = 0; i < 2; ++i) v[h][i] = (unsigned)((sR[i] + 128 * h) * lda + sC[i]) * 2u;
    }
};
struct EpiMoe2 {
    static constexpr bool PERM = true; static constexpr int NST = 0;
    float* O; const bf16_t* X1; const int* lists; const unsigned* count; float scale; int var;
    LAS unsigned char* scr0;
    __device__ __forceinline__ void operator()(const f32x4 (&acc)[2][2][4][2], const pg8::Unit& u, int wr, int wc, int fr, int fq) const {
        if (!MK_ONE_LAUNCH && var == 1) return;
        const int pn = u.e1, list = u.e2, row0 = u.e3;
        const int cnt = (int)count[list]; const int* lp = lists + (size_t)list * NTOK;
        const int col0 = pn * 256 + wc * 32 + 8 * fq;
        const unsigned sb = (unsigned)(size_t)(scr0 + (wr * 4 + wc) * 2048);
        int tok[2][4];
#pragma unroll
        for (int ai = 0; ai < 2; ++ai)
#pragma unroll
            for (int m = 0; m < 4; ++m) { const int p = row0 + ai * 128 + wr * 64 + m * 16 + fr; tok[ai][m] = p < cnt ? lp[p] : -1; }
#pragma unroll
        for (int ai = 0; ai < 2; ++ai) {
            u32x4 xv[4][2];
#pragma unroll
            for (int m = 0; m < 4; ++m) { const bf16_t* rowp = X1 + (size_t)(tok[ai][m] < 0 ? 0 : tok[ai][m]) * DM + col0;
#pragma unroll
                for (int bj = 0; bj < 2; ++bj) xv[m][bj] = __builtin_nontemporal_load((const u32x4*)(rowp + bj * 128)); }
#pragma unroll
            for (int m = 0; m < 4; ++m) {
                int tkn[2];
#pragma unroll
                for (int rr = 0; rr < 2; ++rr) tkn[rr] = __builtin_amdgcn_ds_bpermute((8 * rr + 2 * fq + (fr >> 3)) << 2, tok[ai][m]);
#pragma unroll
                for (int bj = 0; bj < 2; ++bj) { const u32x4 w = xv[m][bj];
                    const f32x4 x0 = (f32x4){__uint_as_float(w.x << 16), __uint_as_float(w.x & 0xffff0000u), __uint_as_float(w.y << 16), __uint_as_float(w.y & 0xffff0000u)};
                    const f32x4 x1v = (f32x4){__uint_as_float(w.z << 16), __uint_as_float(w.z & 0xffff0000u), __uint_as_float(w.w << 16), __uint_as_float(w.w & 0xffff0000u)};
                    const f32x4 r0 = x0 + acc[ai][bj][m][0] * scale, r1 = x1v + acc[ai][bj][m][1] * scale;
                    const unsigned wa0 = sb + fr * 128 + (((2 * fq) ^ (fr & 7)) << 4), wa1 = sb + fr * 128 + (((2 * fq + 1) ^ (fr & 7)) << 4);
                    asm volatile("ds_write_b128 %0, %1" :: "v"(wa0), "v"(r0) : "memory");
                    asm volatile("ds_write_b128 %0, %1" :: "v"(wa1), "v"(r1) : "memory");
                    f32x4 ov[2];
#pragma unroll
                    for (int rr = 0; rr < 2; ++rr) { const int row = 8 * rr + 2 * fq + (fr >> 3); const unsigned ra = sb + row * 128 + (((fr & 7) ^ (row & 7)) << 4);
                        asm volatile("ds_read_b128 %0, %1" : "=v"(ov[rr]) : "v"(ra) : "memory"); }
                    asm volatile("s_waitcnt lgkmcnt(0)" : "+v"(ov[0]), "+v"(ov[1]) :: "memory");
#pragma unroll
                    for (int rr = 0; rr < 2; ++rr) if (tkn[rr] >= 0) *(f32x4*)(O + (size_t)tkn[rr] * DM + pn * 256 + bj * 128 + wc * 32 + 4 * (fr & 7)) = ov[rr];
                }
            }
            asm volatile("" ::: "memory");
        }
    }
};


namespace att {
typedef short v4i16_t __attribute__((ext_vector_type(4)));
typedef short s16x4 __attribute__((ext_vector_type(4)));
typedef float f32x2_t __attribute__((ext_vector_type(2)));
typedef __bf16 bf16x2_t __attribute__((ext_vector_type(2)));
__device__ __forceinline__ unsigned cvtpk(float lo, float hi) { f32x2_t v = {lo, hi}; bf16x2_t b = __builtin_convertvector(v, bf16x2_t); return __builtin_bit_cast(unsigned, b); }
__device__ __forceinline__ s16x4 vtr(const LAS unsigned char* p) { return __builtin_bit_cast(s16x4, __builtin_amdgcn_ds_read_tr16_b64_v4i16((LAS v4i16_t*)p)); }
__device__ __forceinline__ constexpr int crow0(int r) { return (r & 3) + 8 * (r >> 2); }
constexpr float NEG_INF = -__builtin_huge_valf();

constexpr int L_V = 0;
constexpr int L_SO = 65536, SO_PITCH = 136;
constexpr int L_SM = L_SO + 512 * SO_PITCH;
constexpr int L_SL = L_SM + 2048;
constexpr int L_BIAS = L_SL + 2048;
constexpr int L_NATAB = L_SO;
static_assert(L_BIAS + 4096 <= LDS_BYTES - 256 && 8 * 576 * 4 <= 512 * SO_PITCH, "attention LDS map");

struct Ctx {
    int lane, q, h;
    LAS unsigned char* vl;
    unsigned vw, vr0, vr1;
    unsigned kw, kr;
};
__device__ __forceinline__ Ctx make_ctx(LAS unsigned char* lds, int wave, int lane) {
    Ctx c; c.lane = lane; c.q = lane & 31; c.h = lane >> 5; c.vl = lds + L_V + wave * 8192;
    { const int key = lane >> 3, ch = lane & 7, swz = ((key >> 1) & 1) << 2; c.vw = (unsigned)(key * 128 + ((ch ^ swz) << 4)); }
    { const int qp = (lane & 15) >> 2, p = lane & 3, sub = (lane >> 4) & 1, swz = ((qp >> 1) & 1) << 2, x = 2 * sub + (p >> 1);
      c.vr0 = (unsigned)((4 * c.h + qp) * 128 + (((0 ^ swz) + x) << 4) + (p & 1) * 8);
      c.vr1 = (unsigned)((4 * c.h + qp) * 128 + (((4 ^ swz) + x) << 4) + (p & 1) * 8); }
    c.kw = (unsigned)((lane >> 3) * 128);
    c.kr = (unsigned)((lane & 31) * 128);
    return c;
}

template <class Spec>
__device__ __forceinline__ void tile_core(const Spec& sp, const Ctx& c, int t, const LAS unsigned char* vt, const LAS unsigned char* kt, const bf16x8 (&qf)[4], float& m, float& l, f32x16& o0, f32x16& o1);
template <bool LOAD, class Spec>
__device__ __forceinline__ void tile_step(const Spec& sp, const Ctx& c, int t, int tnext, u32x4 (&kreg)[4], u32x4 (&vreg)[4], const bf16x8 (&qf)[4], float& m, float& l, f32x16& o0, f32x16& o1) {
    const int key_lo = c.lane >> 3, chn = c.lane & 7;
#pragma unroll
    for (int i = 0; i < 4; ++i) {
        *(LAS u32x4*)(c.vl + c.vw + i * 1024) = vreg[i];
        const int ksw = ((key_lo >> 1) + 4 * i) & 7;
        *(LAS u32x4*)(c.vl + 4096 + c.kw + i * 1024 + ((chn ^ ksw) << 4)) = kreg[i];
    }
    if constexpr (LOAD) { sp.loadKV(tnext, kreg, vreg); __builtin_amdgcn_sched_barrier(0); }
    tile_core(sp, c, t, c.vl, c.vl + 4096, qf, m, l, o0, o1);
}
template <class Spec>
__device__ __forceinline__ void tile_core(const Spec& sp, const Ctx& c, int t, const LAS unsigned char* vt, const LAS unsigned char* kt, const bf16x8 (&qf)[4], float& m, float& l, f32x16& o0, f32x16& o1) {
    bf16x8 kf[4];
    { const int ksw = ((c.lane & 31) >> 1) & 7;
#pragma unroll
      for (int ks = 0; ks < 4; ++ks) kf[ks] = *(const LAS bf16x8*)(kt + c.kr + (((2 * ks + c.h) ^ ksw) << 4)); }
    f32x16 s;
#pragma unroll
    for (int r = 0; r < 16; ++r) s[r] = 0.f;
#pragma unroll
    for (int ks = 0; ks < 4; ++ks) s = __builtin_amdgcn_mfma_f32_32x32x16_bf16(kf[ks], qf[ks], s, 0, 0, 0);
    sp.bias(t, s);
    float mx = s[0];
#pragma unroll
    for (int r = 1; r < 16; ++r) mx = fmaxf(mx, s[r]);
    { auto rr = __builtin_amdgcn_permlane32_swap(__float_as_uint(mx), __float_as_uint(mx), false, false); mx = fmaxf(__uint_as_float(rr[0]), __uint_as_float(rr[1])); }
    const float mn = fmaxf(m, mx);
    if (__any(mn > m)) {
        const float al = __builtin_amdgcn_exp2f(m - mn);
        l *= al;
#pragma unroll
        for (int r = 0; r < 16; ++r) { o0[r] *= al; o1[r] *= al; }
        m = mn;
    }
    float ps = 0.f;
#pragma unroll
    for (int r = 0; r < 16; ++r) { s[r] = __builtin_amdgcn_exp2f(s[r] - m); ps += s[r]; }
    l += ps;
    bf16x8 pf[2];
#pragma unroll
    for (int s2 = 0; s2 < 2; ++s2) { u32x4 w; w.x = cvtpk(s[8 * s2 + 0], s[8 * s2 + 1]); w.y = cvtpk(s[8 * s2 + 2], s[8 * s2 + 3]); w.z = cvtpk(s[8 * s2 + 4], s[8 * s2 + 5]); w.w = cvtpk(s[8 * s2 + 6], s[8 * s2 + 7]); pf[s2] = __builtin_bit_cast(bf16x8, w); }
#pragma unroll
    for (int s2 = 0; s2 < 2; ++s2) {
        const s16x4 a0 = vtr(vt + c.vr0 + s2 * 2048), a1 = vtr(vt + c.vr0 + s2 * 2048 + 1024);
        const s16x4 b0 = vtr(vt + c.vr1 + s2 * 2048), b1 = vtr(vt + c.vr1 + s2 * 2048 + 1024);
        const bf16x8 v0 = (bf16x8){a0[0], a0[1], a0[2], a0[3], a1[0], a1[1], a1[2], a1[3]};
        const bf16x8 v1 = (bf16x8){b0[0], b0[1], b0[2], b0[3], b1[0], b1[1], b1[2], b1[3]};
        o0 = __builtin_amdgcn_mfma_f32_32x32x16_bf16(v0, pf[s2], o0, 0, 0, 0);
        o1 = __builtin_amdgcn_mfma_f32_32x32x16_bf16(v1, pf[s2], o1, 0, 0, 0);
    }
}

struct QState { float m, l; f32x16 o0, o1; };
__device__ __forceinline__ void softmax_tile(f32x16& s, QState& st, bf16x8 (&pf)[2]) {
    float mx = s[0];
#pragma unroll
    for (int r = 1; r < 16; ++r) mx = fmaxf(mx, s[r]);
    { auto rr = __builtin_amdgcn_permlane32_swap(__float_as_uint(mx), __float_as_uint(mx), false, false); mx = fmaxf(__uint_as_float(rr[0]), __uint_as_float(rr[1])); }
    const float mn = fmaxf(st.m, mx);
    if (__any(mn > st.m)) {
        const float al = __builtin_amdgcn_exp2f(st.m - mn);
        st.l *= al;
#pragma unroll
        for (int r = 0; r < 16; ++r) { st.o0[r] *= al; st.o1[r] *= al; }
        st.m = mn;
    }
    const f32x2_t nm2 = {-st.m, -st.m}; f32x2_t ps2 = {0.f, 0.f};
#pragma unroll
    for (int i = 0; i < 8; ++i) { f32x2_t v = {s[2 * i], s[2 * i + 1]}; v = v + nm2; v[0] = __builtin_amdgcn_exp2f(v[0]); v[1] = __builtin_amdgcn_exp2f(v[1]); ps2 = ps2 + v; s[2 * i] = v[0]; s[2 * i + 1] = v[1]; }
    st.l += ps2[0] + ps2[1];
#pragma unroll
    for (int s2 = 0; s2 < 2; ++s2) { u32x4 w; w.x = cvtpk(s[8 * s2 + 0], s[8 * s2 + 1]); w.y = cvtpk(s[8 * s2 + 2], s[8 * s2 + 3]); w.z = cvtpk(s[8 * s2 + 4], s[8 * s2 + 5]); w.w = cvtpk(s[8 * s2 + 6], s[8 * s2 + 7]); pf[s2] = __builtin_bit_cast(bf16x8, w); }
}
__device__ __forceinline__ void tile_core2(const Ctx& c, const LAS unsigned char* vt, const LAS unsigned char* kt, const bf16x8 (&qa)[4], const bf16x8 (&qb)[4], QState& A, QState& B) {
    bf16x8 kf[4];
    { const int ksw = ((c.lane & 31) >> 1) & 7;
#pragma unroll
      for (int ks = 0; ks < 4; ++ks) kf[ks] = *(const LAS bf16x8*)(kt + c.kr + (((2 * ks + c.h) ^ ksw) << 4)); }
    f32x16 sa, sb;
#pragma unroll
    for (int r = 0; r < 16; ++r) { sa[r] = 0.f; sb[r] = 0.f; }
#pragma unroll
    for (int ks = 0; ks < 4; ++ks) { sa = __builtin_amdgcn_mfma_f32_32x32x16_bf16(kf[ks], qa[ks], sa, 0, 0, 0); sb = __builtin_amdgcn_mfma_f32_32x32x16_bf16(kf[ks], qb[ks], sb, 0, 0, 0); }
    bf16x8 pa[2], pb[2];
    softmax_tile(sa, A, pa); softmax_tile(sb, B, pb);
#pragma unroll
    for (int s2 = 0; s2 < 2; ++s2) {
        const s16x4 a0 = vtr(vt + c.vr0 + s2 * 2048), a1 = vtr(vt + c.vr0 + s2 * 2048 + 1024);
        const s16x4 b0 = vtr(vt + c.vr1 + s2 * 2048), b1 = vtr(vt + c.vr1 + s2 * 2048 + 1024);
        const bf16x8 v0 = (bf16x8){a0[0], a0[1], a0[2], a0[3], a1[0], a1[1], a1[2], a1[3]};
        const bf16x8 v1 = (bf16x8){b0[0], b0[1], b0[2], b0[3], b1[0], b1[1], b1[2], b1[3]};
        A.o0 = __builtin_amdgcn_mfma_f32_32x32x16_bf16(v0, pa[s2], A.o0, 0, 0, 0); A.o1 = __builtin_amdgcn_mfma_f32_32x32x16_bf16(v1, pa[s2], A.o1, 0, 0, 0);
        B.o0 = __builtin_amdgcn_mfma_f32_32x32x16_bf16(v0, pb[s2], B.o0, 0, 0, 0); B.o1 = __builtin_amdgcn_mfma_f32_32x32x16_bf16(v1, pb[s2], B.o1, 0, 0, 0);
    }
}

__device__ __forceinline__ void dma16(__amdgpu_buffer_rsrc_t rs, LAS unsigned char* dst, int vo, int so) { __builtin_amdgcn_raw_ptr_buffer_load_lds(rs, (LAS void*)dst, 16, vo, so, 0, 0); }
__device__ __forceinline__ unsigned lds_u32(const LAS unsigned char* p) { return (unsigned)(uintptr_t)p; }
template <class Spec>
__device__ __forceinline__ void run_dma(const Spec& sp, const Ctx& c, const bf16x8 (&qf)[4], float& m, float& l, f32x16& o0, f32x16& o1) {
    constexpr int NT = Spec::NT;
    LAS unsigned char* vt = c.vl; LAS unsigned char* kt = c.vl + 4096;
    unsigned ka[4];
    { const int ksw = ((c.lane & 31) >> 1) & 7;
#pragma unroll
      for (int ks = 0; ks < 4; ++ks) ka[ks] = lds_u32(kt) + c.kr + (((2 * ks + c.h) ^ ksw) << 4); }
    const unsigned va0 = lds_u32(vt) + c.vr0, va1 = lds_u32(vt) + c.vr1;
    asm volatile("s_waitcnt vmcnt(0) lgkmcnt(0)" ::: "memory");
    sp.dmaK(0, kt); sp.dmaV(0, vt);
    __builtin_amdgcn_sched_barrier(0);
#pragma unroll 1
    for (int t = 0; t < NT; ++t) {
        const bool more = t + 1 < NT;
        asm volatile("s_waitcnt vmcnt(4)" ::: "memory");
        bf16x8 kf0, kf1, kf2, kf3;
        asm volatile("ds_read_b128 %0, %1" : "=v"(kf0) : "v"(ka[0]) : "memory");
        asm volatile("ds_read_b128 %0, %1" : "=v"(kf1) : "v"(ka[1]) : "memory");
        asm volatile("ds_read_b128 %0, %1" : "=v"(kf2) : "v"(ka[2]) : "memory");
        asm volatile("ds_read_b128 %0, %1" : "=v"(kf3) : "v"(ka[3]) : "memory");
        asm volatile("s_waitcnt lgkmcnt(0)" : "+v"(kf0), "+v"(kf1), "+v"(kf2), "+v"(kf3) :: "memory");
        __builtin_amdgcn_sched_barrier(0);
        if (more) sp.dmaK(t + 1, kt);
        __builtin_amdgcn_sched_barrier(0);
        f32x16 s;
#pragma unroll
        for (int r = 0; r < 16; ++r) s[r] = 0.f;
        s = __builtin_amdgcn_mfma_f32_32x32x16_bf16(kf0, qf[0], s, 0, 0, 0); s = __builtin_amdgcn_mfma_f32_32x32x16_bf16(kf1, qf[1], s, 0, 0, 0);
        s = __builtin_amdgcn_mfma_f32_32x32x16_bf16(kf2, qf[2], s, 0, 0, 0); s = __builtin_amdgcn_mfma_f32_32x32x16_bf16(kf3, qf[3], s, 0, 0, 0);
        sp.bias(t, s);
        QState st; bf16x8 pf[2];
        st.m = m; st.l = l; st.o0 = o0; st.o1 = o1;
        softmax_tile(s, st, pf);
        m = st.m; l = st.l; o0 = st.o0; o1 = st.o1;
        __builtin_amdgcn_sched_barrier(0);
        if (more) asm volatile("s_waitcnt vmcnt(4)" ::: "memory"); else asm volatile("s_waitcnt vmcnt(0)" ::: "memory");
        s16x4 a0, a1, a2, a3, b0, b1, b2, b3;
        asm volatile("ds_read_b64_tr_b16 %0, %1" : "=v"(a0) : "v"(va0) : "memory");
        asm volatile("ds_read_b64_tr_b16 %0, %1 offset:1024" : "=v"(a1) : "v"(va0) : "memory");
        asm volatile("ds_read_b64_tr_b16 %0, %1 offset:2048" : "=v"(a2) : "v"(va0) : "memory");
        asm volatile("ds_read_b64_tr_b16 %0, %1 offset:3072" : "=v"(a3) : "v"(va0) : "memory");
        asm volatile("ds_read_b64_tr_b16 %0, %1" : "=v"(b0) : "v"(va1) : "memory");
        asm volatile("ds_read_b64_tr_b16 %0, %1 offset:1024" : "=v"(b1) : "v"(va1) : "memory");
        asm volatile("ds_read_b64_tr_b16 %0, %1 offset:2048" : "=v"(b2) : "v"(va1) : "memory");
        asm volatile("ds_read_b64_tr_b16 %0, %1 offset:3072" : "=v"(b3) : "v"(va1) : "memory");
        asm volatile("s_waitcnt lgkmcnt(0)" : "+v"(a0), "+v"(a1), "+v"(a2), "+v"(a3), "+v"(b0), "+v"(b1), "+v"(b2), "+v"(b3) :: "memory");
        __builtin_amdgcn_sched_barrier(0);
        if (more) sp.dmaV(t + 1, vt);
        __builtin_amdgcn_sched_barrier(0);
        const bf16x8 v00 = (bf16x8){a0[0], a0[1], a0[2], a0[3], a1[0], a1[1], a1[2], a1[3]}, v01 = (bf16x8){a2[0], a2[1], a2[2], a2[3], a3[0], a3[1], a3[2], a3[3]};
        const bf16x8 v10 = (bf16x8){b0[0], b0[1], b0[2], b0[3], b1[0], b1[1], b1[2], b1[3]}, v11 = (bf16x8){b2[0], b2[1], b2[2], b2[3], b3[0], b3[1], b3[2], b3[3]};
        o0 = __builtin_amdgcn_mfma_f32_32x32x16_bf16(v00, pf[0], o0, 0, 0, 0); o1 = __builtin_amdgcn_mfma_f32_32x32x16_bf16(v10, pf[0], o1, 0, 0, 0);
        o0 = __builtin_amdgcn_mfma_f32_32x32x16_bf16(v01, pf[1], o0, 0, 0, 0); o1 = __builtin_amdgcn_mfma_f32_32x32x16_bf16(v11, pf[1], o1, 0, 0, 0);
    }
}

__device__ __forceinline__ void load_q_asm(const unsigned char* qrow, int h, bf16x8& q0, bf16x8& q1, bf16x8& q2, bf16x8& q3) {
    const unsigned char* p = qrow + 16 * h;
    asm volatile("global_load_dwordx4 %0, %1, off nt" : "=v"(q0) : "v"(p) : "memory");
    asm volatile("global_load_dwordx4 %0, %1, off offset:32 nt" : "=v"(q1) : "v"(p) : "memory");
    asm volatile("global_load_dwordx4 %0, %1, off offset:64 nt" : "=v"(q2) : "v"(p) : "memory");
    asm volatile("global_load_dwordx4 %0, %1, off offset:96 nt" : "=v"(q3) : "v"(p) : "memory");
}
template <class Spec>
__device__ __forceinline__ void run_dma_x(const Spec& sp, const Ctx& c, bf16x8& q0, bf16x8& q1, bf16x8& q2, bf16x8& q3, QState& st,
                                          bool first, bool hn, __amdgpu_buffer_rsrc_t rsn, int rw0n, const unsigned char* qrow_n) {
    constexpr int NT = Spec::NT;
    LAS unsigned char* vt = c.vl; LAS unsigned char* kt = c.vl + 4096;
    unsigned ka[4];
    { const int ksw = ((c.lane & 31) >> 1) & 7;
#pragma unroll
      for (int ks = 0; ks < 4; ++ks) ka[ks] = lds_u32(kt) + c.kr + (((2 * ks + c.h) ^ ksw) << 4); }
    const unsigned va0 = lds_u32(vt) + c.vr0, va1 = lds_u32(vt) + c.vr1;
#pragma unroll 1
    for (int t = 0; t < NT; ++t) {
        const bool lastt = t + 1 == NT;
        if (t == 0 && !first) asm volatile("s_waitcnt vmcnt(6)" ::: "memory"); else asm volatile("s_waitcnt vmcnt(4)" ::: "memory");
        bf16x8 kf0, kf1, kf2, kf3;
        asm volatile("ds_read_b128 %0, %1" : "=v"(kf0) : "v"(ka[0]) : "memory");
        asm volatile("ds_read_b128 %0, %1" : "=v"(kf1) : "v"(ka[1]) : "memory");
        asm volatile("ds_read_b128 %0, %1" : "=v"(kf2) : "v"(ka[2]) : "memory");
        asm volatile("ds_read_b128 %0, %1" : "=v"(kf3) : "v"(ka[3]) : "memory");
        asm volatile("s_waitcnt lgkmcnt(0)" : "+v"(kf0), "+v"(kf1), "+v"(kf2), "+v"(kf3) :: "memory");
        __builtin_amdgcn_sched_barrier(0);
        if (!lastt) sp.dmaK(t + 1, kt);
        __builtin_amdgcn_sched_barrier(0);
        f32x16 s = sp.madd;
        s = __builtin_amdgcn_mfma_f32_32x32x16_bf16(kf0, q0, s, 0, 0, 0); s = __builtin_amdgcn_mfma_f32_32x32x16_bf16(kf1, q1, s, 0, 0, 0);
        s = __builtin_amdgcn_mfma_f32_32x32x16_bf16(kf2, q2, s, 0, 0, 0); s = __builtin_amdgcn_mfma_f32_32x32x16_bf16(kf3, q3, s, 0, 0, 0);
        if (lastt && hn) {
            __builtin_amdgcn_sched_barrier(0);
            load_q_asm(qrow_n, c.h, q0, q1, q2, q3); sp.dmaK_n(rsn, rw0n, kt);
            __builtin_amdgcn_sched_barrier(0);
        }
        sp.bias(t, s);
        bf16x8 pf[2];
        softmax_tile(s, st, pf);
        __builtin_amdgcn_sched_barrier(0);
        if (t == 0 && !first) asm volatile("s_waitcnt vmcnt(6)" ::: "memory");
        else if (lastt) { if (hn) asm volatile("s_waitcnt vmcnt(8)" ::: "memory"); else asm volatile("s_waitcnt vmcnt(0)" ::: "memory"); }
        else asm volatile("s_waitcnt vmcnt(4)" ::: "memory");
        s16x4 a0, a1, a2, a3, b0, b1, b2, b3;
        asm volatile("ds_read_b64_tr_b16 %0, %1" : "=v"(a0) : "v"(va0) : "memory");
        asm volatile("ds_read_b64_tr_b16 %0, %1 offset:1024" : "=v"(a1) : "v"(va0) : "memory");
        asm volatile("ds_read_b64_tr_b16 %0, %1 offset:2048" : "=v"(a2) : "v"(va0) : "memory");
        asm volatile("ds_read_b64_tr_b16 %0, %1 offset:3072" : "=v"(a3) : "v"(va0) : "memory");
        asm volatile("ds_read_b64_tr_b16 %0, %1" : "=v"(b0) : "v"(va1) : "memory");
        asm volatile("ds_read_b64_tr_b16 %0, %1 offset:1024" : "=v"(b1) : "v"(va1) : "memory");
        asm volatile("ds_read_b64_tr_b16 %0, %1 offset:2048" : "=v"(b2) : "v"(va1) : "memory");
        asm volatile("ds_read_b64_tr_b16 %0, %1 offset:3072" : "=v"(b3) : "v"(va1) : "memory");
        asm volatile("s_waitcnt lgkmcnt(0)" : "+v"(a0), "+v"(a1), "+v"(a2), "+v"(a3), "+v"(b0), "+v"(b1), "+v"(b2), "+v"(b3) :: "memory");
        __builtin_amdgcn_sched_barrier(0);
        if (!lastt) sp.dmaV(t + 1, vt); else if (hn) sp.dmaV_n(rsn, rw0n, vt);
        __builtin_amdgcn_sched_barrier(0);
        const bf16x8 v00 = (bf16x8){a0[0], a0[1], a0[2], a0[3], a1[0], a1[1], a1[2], a1[3]}, v01 = (bf16x8){a2[0], a2[1], a2[2], a2[3], a3[0], a3[1], a3[2], a3[3]};
        const bf16x8 v10 = (bf16x8){b0[0], b0[1], b0[2], b0[3], b1[0], b1[1], b1[2], b1[3]}, v11 = (bf16x8){b2[0], b2[1], b2[2], b2[3], b3[0], b3[1], b3[2], b3[3]};
        st.o0 = __builtin_amdgcn_mfma_f32_32x32x16_bf16(v00, pf[0], st.o0, 0, 0, 0); st.o1 = __builtin_amdgcn_mfma_f32_32x32x16_bf16(v10, pf[0], st.o1, 0, 0, 0);
        st.o0 = __builtin_amdgcn_mfma_f32_32x32x16_bf16(v01, pf[1], st.o0, 0, 0, 0); st.o1 = __builtin_amdgcn_mfma_f32_32x32x16_bf16(v11, pf[1], st.o1, 0, 0, 0);
    }
}
template <class Spec>
__device__ __forceinline__ void run(const Spec& sp, const Ctx& c, const bf16x8 (&qf)[4], float& m, float& l, f32x16& o0, f32x16& o1) {
    constexpr int NT = Spec::NT;
    static_assert(NT >= 4, "tile loop is peeled for NT >= 4");
    u32x4 kA[4], vA[4], kB[4], vB[4];
    sp.loadKV(0, kA, vA); sp.loadKV(1, kB, vB);
    int t = 0;
#pragma unroll 1
    for (; t + 3 < NT; t += 2) {
        tile_step<true>(sp, c, t, t + 2, kA, vA, qf, m, l, o0, o1);
        tile_step<true>(sp, c, t + 1, t + 3, kB, vB, qf, m, l, o0, o1);
    }
    if constexpr ((NT & 1) == 0) {
        tile_step<false>(sp, c, NT - 2, 0, kA, vA, qf, m, l, o0, o1);
        tile_step<false>(sp, c, NT - 1, 0, kB, vB, qf, m, l, o0, o1);
    } else {
        tile_step<true>(sp, c, NT - 3, NT - 1, kA, vA, qf, m, l, o0, o1);
        tile_step<false>(sp, c, NT - 2, 0, kB, vB, qf, m, l, o0, o1);
        tile_step<false>(sp, c, NT - 1, 0, kA, vA, qf, m, l, o0, o1);
    }
}
__device__ __forceinline__ float pair_sum(float v) { auto rr = __builtin_amdgcn_permlane32_swap(__float_as_uint(v), __float_as_uint(v), false, false); return __uint_as_float(rr[0]) + __uint_as_float(rr[1]); }
template <class P> __device__ __forceinline__ void store_o(P rowp, const f32x16& o0, const f32x16& o1, float inv, int h) {
#pragma unroll
    for (int g4 = 0; g4 < 4; ++g4) {
        u32x2 w0, w1; w0.x = cvtpk(o0[4 * g4] * inv, o0[4 * g4 + 1] * inv); w0.y = cvtpk(o0[4 * g4 + 2] * inv, o0[4 * g4 + 3] * inv);
        w1.x = cvtpk(o1[4 * g4] * inv, o1[4 * g4 + 1] * inv); w1.y = cvtpk(o1[4 * g4 + 2] * inv, o1[4 * g4 + 3] * inv);
        *(u32x2*)(rowp + (8 * g4 + 4 * h) * 2) = w0; *(u32x2*)(rowp + (32 + 8 * g4 + 4 * h) * 2) = w1;
    }
}
__device__ __forceinline__ void store_o8(unsigned char* rowp, const f32x16& o0, const f32x16& o1, float inv, int h) {
    const float sc = inv * SC_MIX;
    unsigned w[8];
#pragma unroll
    for (int g4 = 0; g4 < 4; ++g4) {
        const unsigned a = pk4_fp8(o0[4 * g4] * sc, o0[4 * g4 + 1] * sc, o0[4 * g4 + 2] * sc, o0[4 * g4 + 3] * sc);
        const unsigned b = pk4_fp8(o1[4 * g4] * sc, o1[4 * g4 + 1] * sc, o1[4 * g4 + 2] * sc, o1[4 * g4 + 3] * sc);
        auto rr = __builtin_amdgcn_permlane32_swap(a, b, false, false);
        w[2 * g4] = rr[0]; w[2 * g4 + 1] = rr[1];
    }
    *(u32x4*)(rowp + 32 * h) = (u32x4){w[0], w[1], w[2], w[3]}; *(u32x4*)(rowp + 32 * h + 16) = (u32x4){w[4], w[5], w[6], w[7]};
}
__device__ __forceinline__ void load_q(const unsigned char* qrow, int h, bf16x8 (&qf)[4]) {
#pragma unroll
    for (int ks = 0; ks < 4; ++ks) qf[ks] = *(const bf16x8*)(qrow + (16 * ks + 8 * h) * 2);
}

__device__ __forceinline__ u32x4 bload(__amdgpu_buffer_rsrc_t rs, int vo, int so) { return __builtin_amdgcn_raw_buffer_load_b128(rs, vo, so, 0); }
constexpr int NA_NEGIDX = 544;
struct SpecNA {
    static constexpr int NT = 9;
    __amdgpu_buffer_rsrc_t rs; int vo[4]; int rw0, kcolK, kcolV;
    int qr, r0q, bidx; const LAS float* btab; f32x16 madd;
    int dk0, dk1, dv0;
    __device__ __forceinline__ void dmaK(int t, LAS unsigned char* kt) const { int row = rw0 + t; row = row > GRID_R - 1 ? GRID_R - 1 : row; const int so = row * (GRID_W * 128) + kcolK;
        dma16(rs, kt, dk0, so); dma16(rs, kt + 1024, dk1, so + 1024); dma16(rs, kt + 2048, dk0, so + 2048); dma16(rs, kt + 3072, dk1, so + 3072); }
    __device__ __forceinline__ void dmaV(int t, LAS unsigned char* vt) const { int row = rw0 + t; row = row > GRID_R - 1 ? GRID_R - 1 : row; const int so = row * (GRID_W * 128) + kcolV;
        dma16(rs, vt, dv0, so); dma16(rs, vt + 1024, dv0, so + 1024); dma16(rs, vt + 2048, dv0, so + 2048); dma16(rs, vt + 3072, dv0, so + 3072); }
    __device__ __forceinline__ void dmaK_n(__amdgpu_buffer_rsrc_t rsn, int rw0n, LAS unsigned char* kt) const { const int so = rw0n * (GRID_W * 128) + kcolK;
        dma16(rsn, kt, dk0, so); dma16(rsn, kt + 1024, dk1, so + 1024); dma16(rsn, kt + 2048, dk0, so + 2048); dma16(rsn, kt + 3072, dk1, so + 3072); }
    __device__ __forceinline__ void dmaV_n(__amdgpu_buffer_rsrc_t rsn, int rw0n, LAS unsigned char* vt) const { const int so = rw0n * (GRID_W * 128) + kcolV;
        dma16(rsn, vt, dv0, so); dma16(rsn, vt + 1024, dv0, so + 1024); dma16(rsn, vt + 2048, dv0, so + 2048); dma16(rsn, vt + 3072, dv0, so + 3072); }
    __device__ __forceinline__ void loadKV(int t, u32x4 (&kr)[4], u32x4 (&vr)[4]) const {
        int row = rw0 + t; row = row > GRID_R - 1 ? GRID_R - 1 : row; const int so = row * (GRID_W * 128);
#pragma unroll
        for (int i = 0; i < 4; ++i) { kr[i] = bload(rs, vo[i], so + kcolK); vr[i] = bload(rs, vo[i], so + kcolV); } }
    __device__ __forceinline__ void bias(int t, f32x16& s) const {
        const int row = rw0 + t; const bool rv = (unsigned)(row - r0q) < 8u;
        const int idx = rv ? bidx + (row - qr + 7) * 31 : NA_NEGIDX;
        float bv[16];
#pragma unroll
        for (int rg = 0; rg < 16; ++rg) bv[rg] = btab[idx + crow0(rg)];
#pragma unroll
        for (int rg = 0; rg < 16; ++rg) asm volatile("" : "+v"(bv[rg]));
#pragma unroll
        for (int i = 0; i < 8; ++i) { f32x2_t v = {s[2 * i], s[2 * i + 1]}; v = v + (f32x2_t){bv[2 * i], bv[2 * i + 1]}; s[2 * i] = v[0]; s[2 * i + 1] = v[1]; }
    }
};
struct SpecDil {
    static constexpr int NT = 5;
    __amdgpu_buffer_rsrc_t rs; int pi[4]; int cb, kcolK, kcolV;
    int pos0, dil, q, h; const LAS float* btab;
    int ck0, ck1, cv0;
    __device__ __forceinline__ int cl(int p) const { return p < 0 ? 0 : (p > SEQ - 1 ? SEQ - 1 : p); }
    __device__ __forceinline__ void dmaK(int t, LAS unsigned char* kt) const { const int d = 32 * dil * t;
        dma16(rs, kt, cl(pi[0] + d) * 128 + ck0, kcolK); dma16(rs, kt + 1024, cl(pi[1] + d) * 128 + ck1, kcolK); dma16(rs, kt + 2048, cl(pi[2] + d) * 128 + ck0, kcolK); dma16(rs, kt + 3072, cl(pi[3] + d) * 128 + ck1, kcolK); }
    __device__ __forceinline__ void dmaV(int t, LAS unsigned char* vt) const { const int d = 32 * dil * t;
        dma16(rs, vt, cl(pi[0] + d) * 128 + cv0, kcolV); dma16(rs, vt + 1024, cl(pi[1] + d) * 128 + cv0, kcolV); dma16(rs, vt + 2048, cl(pi[2] + d) * 128 + cv0, kcolV); dma16(rs, vt + 3072, cl(pi[3] + d) * 128 + cv0, kcolV); }
    __device__ __forceinline__ void loadKV(int t, u32x4 (&kr)[4], u32x4 (&vr)[4]) const {
#pragma unroll
        for (int i = 0; i < 4; ++i) { int p = pi[i] + 32 * dil * t; p = p < 0 ? 0 : (p > SEQ - 1 ? SEQ - 1 : p); const int vo = p * 128 + cb; kr[i] = bload(rs, vo, kcolK); vr[i] = bload(rs, vo, kcolV); } }
    __device__ __forceinline__ void bias(int t, f32x16& s) const {
        const int idx = 32 + 32 * t + 4 * h - q;
        float bv[16];
#pragma unroll
        for (int rg = 0; rg < 16; ++rg) bv[rg] = btab[idx + crow0(rg)];
#pragma unroll
        for (int rg = 0; rg < 16; ++rg) asm volatile("" : "+v"(bv[rg]));
#pragma unroll
        for (int i = 0; i < 8; ++i) { f32x2_t v = {s[2 * i], s[2 * i + 1]}; v = v + (f32x2_t){bv[2 * i], bv[2 * i + 1]}; s[2 * i] = v[0]; s[2 * i + 1] = v[1]; }
        const int lo = pos0 + dil * (-64 + 32 * t);
        if (lo < 0 || lo + 31 * dil >= SEQ) {
            const int pb = lo + dil * 4 * h;
#pragma unroll
            for (int rg = 0; rg < 16; ++rg) { const int pk = pb + dil * crow0(rg); s[rg] = ((unsigned)pk < (unsigned)SEQ) ? s[rg] : NEG_INF; }
        }
    }
};
struct SpecMem {
    static constexpr int NT = 8;
    __amdgpu_buffer_rsrc_t rs; int vo[4];
    __device__ __forceinline__ void loadKV(int t, u32x4 (&kr)[4], u32x4 (&vr)[4]) const {
        const int so = t * 32 * 128;
#pragma unroll
        for (int i = 0; i < 4; ++i) { kr[i] = bload(rs, vo[i], so); vr[i] = bload(rs, vo[i], so + 4 * BATCH * MEM_LEN * 128); } }
    __device__ __forceinline__ void bias(int, f32x16&) const {}
};

__device__ __forceinline__ void phase2(const MArgs& a, LAS unsigned char* lds, int vcu, int G) {
    const int tid = threadIdx.x, lane = tid & 63, wave = __builtin_amdgcn_readfirstlane(tid >> 6);
    const Ctx c = make_ctx(lds, wave, lane);
    const unsigned char* QKV = a.ws + WS_QKV; const unsigned char* KVM = a.ws + WS_KVM; unsigned char* MIX = a.ws + WS_MIX;
    const float* rpb = (const float*)(a.ws + WS_RPB); const float* biasD = (const float*)(a.ws + WS_BIASD);
    LAS float* lb = (LAS float*)(lds + L_BIAS);
    const int key_lo = lane >> 3, chunk16 = (lane & 7) * 16;
    const int parts = (!MK_ONE_LAUNCH && a.ph_lo >= 20) ? 1 << (a.ph_lo - 20) : 7;
    if (parts & 1) { LAS float* nt = (LAS float*)(lds + L_NATAB);
      __syncthreads();
      { float tv[9];
#pragma unroll
        for (int k = 0; k < 9; ++k) { const int i = tid + NTHREADS * k, hd = i / 576, j = i - 576 * hd; const bool in = j >= 32 && j < 32 + 465; tv[k] = rpb[in ? hd * 465 + j - 32 : 0]; }
#pragma unroll
        for (int k = 0; k < 9; ++k) { const int i = tid + NTHREADS * k, hd = i / 576, j = i - 576 * hd; const bool in = j >= 32 && j < 32 + 465; nt[i] = in ? tv[k] : (j >= NA_NEGIDX ? NEG_INF : 0.f); } }
      __syncthreads(); }
    if (parts & 1) {
        constexpr int NU = BATCH * NA_HEADS * (GRID_R / 4);
        const int I_ = wave & 3, cq_ = 16 * I_ + (c.q & 15);
        const int sc_ = 16 * I_ - 8 < 0 ? 0 : (16 * I_ - 8 > 32 ? 32 : 16 * I_ - 8); const int c0_ = cq_ - 8 < 0 ? 0 : (cq_ - 8 > GRID_W - 16 ? GRID_W - 16 : cq_ - 8);
        SpecNA sp;
        { const int chn_ = lane & 7, g16_ = lane >> 4; sp.dk0 = (sc_ + key_lo) * 128 + ((chn_ ^ (g16_ & 7)) << 4); sp.dk1 = (sc_ + key_lo) * 128 + ((chn_ ^ ((g16_ + 4) & 7)) << 4); sp.dv0 = (sc_ + key_lo) * 128 + ((chn_ ^ ((g16_ & 1) << 2)) << 4); }
        sp.kcolK = 0; sp.kcolV = ((C_VA - C_KA) / 64) * NTOK * 128; sp.bidx = 32 + (sc_ - cq_ + 15) + 4 * c.h;
#pragma unroll
        for (int r2 = 0; r2 < 16; ++r2) sp.madd[r2] = ((unsigned)(sc_ + crow0(r2) + 4 * c.h - c0_) < 16u) ? 0.f : NEG_INF;
#define NA_UNIT(u_, RS, RW0, QR, TQ, HEAD) do { const int rg_ = (u_) & 31, head_ = ((u_) >> 5) & 7, b_ = (u_) >> 8; const int rp_ = 2 * rg_ + (wave >> 2); \
            RS = __builtin_amdgcn_make_buffer_rsrc((void*)(QKV + ((size_t)(C_KA / 64 + head_) * NTOK + (size_t)b_ * SEQ) * 128), 0, 0x7fffffff, 0x00020000); \
            RW0 = 2 * rp_ - 4 < 0 ? 0 : (2 * rp_ - 4 > GRID_R - 8 ? GRID_R - 8 : 2 * rp_ - 4); QR = 2 * rp_ + (c.q >> 4); TQ = b_ * SEQ + QR * GRID_W + cq_; HEAD = head_; } while (0)
        int u = vcu; bool have = u < NU, first = true;
        int tq = 0, head = 0, qr = 0, rw0 = 0; __amdgpu_buffer_rsrc_t rs = __builtin_amdgcn_make_buffer_rsrc((void*)QKV, 0, 0x7fffffff, 0x00020000);
        bf16x8 q0, q1, q2, q3;
        if (have) {
            NA_UNIT(u, rs, rw0, qr, tq, head);
            sp.rs = rs; sp.rw0 = rw0;
            asm volatile("s_waitcnt vmcnt(0) lgkmcnt(0)" ::: "memory");
            load_q_asm(QKV + ((size_t)(C_QA / 64 + head) * NTOK + tq) * 128, c.h, q0, q1, q2, q3);
            sp.dmaK(0, c.vl + 4096); sp.dmaV(0, c.vl);
            asm volatile("s_waitcnt vmcnt(8)" : "+v"(q0), "+v"(q1), "+v"(q2), "+v"(q3) :: "memory");
            __builtin_amdgcn_sched_barrier(0);
        }
        while (have) {
            __builtin_amdgcn_s_barrier();
            const int un = u + G; const bool hn = un < NU;
            int tqn = tq, headn = head, qrn = qr, rw0n = rw0; __amdgpu_buffer_rsrc_t rsn = rs;
            if (hn) NA_UNIT(un, rsn, rw0n, qrn, tqn, headn);
            sp.rs = rs; sp.rw0 = rw0; sp.qr = qr; sp.r0q = qr - 4 < 0 ? 0 : (qr - 4 > GRID_R - 8 ? GRID_R - 8 : qr - 4); sp.btab = (const LAS float*)(lds + L_NATAB) + head * 576;
            QState st; st.m = -1e30f; st.l = 0.f;
#pragma unroll
            for (int i = 0; i < 16; ++i) { st.o0[i] = 0.f; st.o1[i] = 0.f; }
            run_dma_x(sp, c, q0, q1, q2, q3, st, first, hn, rsn, rw0n, QKV + ((size_t)(C_QA / 64 + headn) * NTOK + tqn) * 128);
            const float inv = 1.f / pair_sum(st.l);
            store_o8(MIX + (size_t)tq * DM + head * 64, st.o0, st.o1, inv, c.h);
            if (hn) { asm volatile("s_waitcnt vmcnt(10)" : "+v"(q0), "+v"(q1), "+v"(q2), "+v"(q3) :: "memory");
                      __builtin_amdgcn_sched_barrier(0); }
            rs = rsn; rw0 = rw0n; qr = qrn; tq = tqn; head = headn; u = un; have = hn; first = false;
        }
#undef NA_UNIT
        asm volatile("s_waitcnt vmcnt(0)" ::: "memory");
    }
    if (parts & 2) {
        struct NoBias { __device__ __forceinline__ void bias(int, f32x16&) const {} } nb;
        const int nqb = SEQ / 256;
        for (int u = vcu; u < BATCH * MEM_HEADS * 8; u += G) {
            const int pair = u >> 3, head = pair & 3, b = pair >> 2;
            __syncthreads();
            { const unsigned char* kb = KVM + ((size_t)head * BATCH * MEM_LEN + (size_t)b * MEM_LEN) * 128; const unsigned char* vb = kb + (size_t)4 * BATCH * MEM_LEN * 128;
#pragma unroll
              for (int i = 0; i < 4; ++i) { const int idx = tid + NTHREADS * i, key = idx >> 3, ch = idx & 7;
                  const u32x4 kv = *(const u32x4*)(kb + (size_t)key * 128 + ch * 16), vv = *(const u32x4*)(vb + (size_t)key * 128 + ch * 16);
                  *(LAS u32x4*)(lds + key * 128 + ((ch ^ ((key >> 1) & 7)) << 4)) = kv;
                  *(LAS u32x4*)(lds + 32768 + key * 128 + ((ch ^ (((key >> 1) & 1) << 2)) << 4)) = vv; } }
            __syncthreads();
#pragma unroll 1
            for (int qq = 0; qq < 2; ++qq) {
                const int q0 = (4 * (u & 7) + 2 * qq) * 256 + wave * 64; if (q0 >= SEQ) break;
                const int tqa = b * SEQ + q0 + c.q, tqb = tqa + 32;
                bf16x8 qa[4], qbf[4]; load_q(QKV + ((size_t)(C_QM / 64 + head) * NTOK + tqa) * 128, c.h, qa); load_q(QKV + ((size_t)(C_QM / 64 + head) * NTOK + tqb) * 128, c.h, qbf);
                QState A, B; A.m = -1e30f; A.l = 0.f; B.m = -1e30f; B.l = 0.f;
#pragma unroll
                for (int i = 0; i < 16; ++i) { A.o0[i] = 0.f; A.o1[i] = 0.f; B.o0[i] = 0.f; B.o1[i] = 0.f; }
#pragma unroll 1
                for (int t = 0; t < 8; ++t) tile_core2(c, lds + 32768 + t * 4096, lds + t * 4096, qa, qbf, A, B);
                store_o8(MIX + (size_t)tqa * DM + NA_W + 256 + head * 64, A.o0, A.o1, 1.f / pair_sum(A.l), c.h);
                store_o8(MIX + (size_t)tqb * DM + NA_W + 256 + head * 64, B.o0, B.o1, 1.f / pair_sum(B.l), c.h);
            }
        }
        __syncthreads();
    }
    LAS unsigned char* so = lds + L_SO; LAS float* sm = (LAS float*)(lds + L_SM); LAS float* sl = (LAS float*)(lds + L_SL);
    int xit = vcu * NWAVES + wave;
    if (parts & 4) for (int u = vcu; u < BATCH * 4 * (SEQ / 512); u += G) {
        const int blk = u & 15, hh = (u >> 4) & 3, b = u >> 6;
        __syncthreads();
        { float tv[2];
#pragma unroll
          for (int k = 0; k < 2; ++k) { const int i = tid + NTHREADS * k, i2 = i < 3 * 192 ? i : 0, g = i2 / 192, j = i2 - 192 * g - 32; tv[k] = biasD[(g * 4 + hh) * 129 + ((j >= 0 && j <= 128) ? j : 0)]; }
#pragma unroll
          for (int k = 0; k < 2; ++k) { const int i = tid + NTHREADS * k; if (i < 3 * 192) { const int g = i / 192, j = i - 192 * g - 32; lb[i] = (j >= 0 && j <= 128) ? tv[k] : NEG_INF; } } }
        __syncthreads();
#pragma unroll 1
        for (int g = 0; g < 3; ++g) {
            const int dil = g == 0 ? 1 : (g == 1 ? 4 : 16), head = g * 4 + hh;
#pragma unroll 1
            for (int k = 0; k < 2; ++k) {
                const int tl = wave * 2 + k;
                const int base = g == 0 ? 32 * tl : (g == 1 ? (tl & 3) + 128 * (tl >> 2) : tl);
                const int tql = base + dil * c.q;
                const int tq = b * SEQ + blk * 512 + tql;
                SpecDil sp; sp.rs = __builtin_amdgcn_make_buffer_rsrc((void*)(QKV + ((size_t)(C_KD / 64 + head) * NTOK + (size_t)b * SEQ) * 128), 0, 0x7fffffff, 0x00020000); sp.pos0 = blk * 512 + base; sp.dil = dil; sp.q = c.q; sp.h = c.h; sp.btab = lb + g * 192; sp.cb = chunk16;
#pragma unroll
                for (int i = 0; i < 4; ++i) sp.pi[i] = sp.pos0 + dil * (-64 + key_lo + 8 * i);
                sp.kcolK = 0; sp.kcolV = ((C_VD - C_KD) / 64) * NTOK * 128;
                { const int chn = lane & 7, g16 = lane >> 4; sp.ck0 = (chn ^ (g16 & 7)) << 4; sp.ck1 = (chn ^ ((g16 + 4) & 7)) << 4; sp.cv0 = (chn ^ ((g16 & 1) << 2)) << 4; }
                bf16x8 qf[4]; load_q(QKV + ((size_t)(C_QD / 64 + head) * NTOK + tq) * 128, c.h, qf);
                float m, l; f32x16 o0, o1;
                if (g == 0) { m = -1e30f; l = 0.f;
#pragma unroll
                    for (int i = 0; i < 16; ++i) { o0[i] = 0.f; o1[i] = 0.f; } }
                else {
                    m = sm[tql]; const float lt = sl[tql]; l = c.h == 0 ? lt : 0.f;
                    const LAS unsigned char* rowp = so + tql * SO_PITCH;
#pragma unroll
                    for (int g4 = 0; g4 < 4; ++g4) {
                        const u32x2 w0 = *(const LAS u32x2*)(rowp + (8 * g4 + 4 * c.h) * 2), w1 = *(const LAS u32x2*)(rowp + (32 + 8 * g4 + 4 * c.h) * 2);
                        o0[4 * g4] = __uint_as_float(w0.x << 16) * lt; o0[4 * g4 + 1] = __uint_as_float(w0.x & 0xffff0000u) * lt; o0[4 * g4 + 2] = __uint_as_float(w0.y << 16) * lt; o0[4 * g4 + 3] = __uint_as_float(w0.y & 0xffff0000u) * lt;
                        o1[4 * g4] = __uint_as_float(w1.x << 16) * lt; o1[4 * g4 + 1] = __uint_as_float(w1.x & 0xffff0000u) * lt; o1[4 * g4 + 2] = __uint_as_float(w1.y << 16) * lt; o1[4 * g4 + 3] = __uint_as_float(w1.y & 0xffff0000u) * lt;
                    }
                }
                run_dma(sp, c, qf, m, l, o0, o1);
                const float lt = pair_sum(l); const float inv = 1.f / lt;
                if (g < 2) { store_o(so + tql * SO_PITCH, o0, o1, inv, c.h); if (c.h == 0) { sm[tql] = m; sl[tql] = lt; } }
                else store_o8(MIX + (size_t)tq * DM + NA_W + hh * 64, o0, o1, inv, c.h);
                if (xit < N_EXP_ITEMS) { expert_item(a, xit, lane); xit += G * NWAVES; }
            }
            __syncthreads();
        }
    }
    for (; xit < N_EXP_ITEMS; xit += G * NWAVES) expert_item(a, xit, lane);
}
}

__device__ __forceinline__ void memkv_mini(const MArgs& a, LAS unsigned char* lds, int u) {
    const int tid = threadIdx.x, lane = tid & 63, wave = __builtin_amdgcn_readfirstlane(tid >> 6);
    const int hd = u & 7, rb = u >> 3, rh = wave & 1, kq = wave >> 1, r = lane & 31, h = lane >> 5;
    const bf16_t* XNm = (const bf16_t*)(a.ws + WS_XN) + (size_t)NTOK * DM;
    const bf16_t* WT = (const bf16_t*)(a.ws + WS_WINT);
    const bf16_t* arow = XNm + (size_t)(rb * 64 + rh * 32 + r) * DM + kq * 256 + 8 * h;
    const int n0 = 64 * hd + r, n1 = n0 + 32;
    const bf16_t* b0 = WT + (size_t)(4096 + inproj_pos(n0)) * DM + kq * 256 + 8 * h;
    const bf16_t* b1 = WT + (size_t)(4096 + inproj_pos(n1)) * DM + kq * 256 + 8 * h;
    f32x16 c0, c1;
#pragma unroll
    for (int i = 0; i < 16; ++i) { c0[i] = 0.f; c1[i] = 0.f; }
#pragma unroll 8
    for (int s2 = 0; s2 < 16; ++s2) {
        const bf16x8 af = *(const bf16x8*)(arow + 16 * s2), bf0 = *(const bf16x8*)(b0 + 16 * s2), bf1 = *(const bf16x8*)(b1 + 16 * s2);
        c0 = __builtin_amdgcn_mfma_f32_32x32x16_bf16(af, bf0, c0, 0, 0, 0);
        c1 = __builtin_amdgcn_mfma_f32_32x32x16_bf16(af, bf1, c1, 0, 0, 0);
    }
    LAS float* part = (LAS float*)lds + ((kq * 2 + rh) * 32) * 64;
#pragma unroll
    for (int i = 0; i < 16; ++i) { const int row = (i & 3) + 8 * (i >> 2) + 4 * h; part[row * 64 + r] = c0[i]; part[row * 64 + 32 + r] = c1[i]; }
    __syncthreads();
    { const int row = tid >> 3, cg = tid & 7; const int rh2 = row >> 5, rr = row & 31;
      float v[8];
#pragma unroll
      for (int j = 0; j < 8; ++j) { float sacc = 0.f;
#pragma unroll
          for (int q = 0; q < 4; ++q) sacc += ((LAS float*)lds)[(((q * 2 + rh2) * 32) + rr) * 64 + cg * 8 + j];
          v[j] = sacc; }
      float ss = 0.f;
#pragma unroll
      for (int j = 0; j < 8; ++j) ss += v[j] * v[j];
      ss += __shfl_xor(ss, 1); ss += __shfl_xor(ss, 2); ss += __shfl_xor(ss, 4);
      const float rn = hd < 4 ? rsqrtf(ss * (1.f / 64.f) + EPS) : 1.f;
      u32x4 w;
      if (hd < 4) { const float* gq = a.in[4] + 5 * 64 + cg * 8;
          w.x = att::cvtpk(v[0] * rn * gq[0], v[1] * rn * gq[1]); w.y = att::cvtpk(v[2] * rn * gq[2], v[3] * rn * gq[3]); w.z = att::cvtpk(v[4] * rn * gq[4], v[5] * rn * gq[5]); w.w = att::cvtpk(v[6] * rn * gq[6], v[7] * rn * gq[7]); }
      else { w.x = att::cvtpk(v[0], v[1]); w.y = att::cvtpk(v[2], v[3]); w.z = att::cvtpk(v[4], v[5]); w.w = att::cvtpk(v[6], v[7]); }
      bf16_t* KVM = (bf16_t*)(a.ws + WS_KVM);
      *(u32x4*)(KVM + ((size_t)hd * (BATCH * MEM_LEN) + rb * 64 + row) * 64 + cg * 8) = w;
    }
    __syncthreads();
}

__device__ __forceinline__ void phase4(const MArgs& a, LAS unsigned char* lds, int vcu, int G, bool dry) {
    const int tid = threadIdx.x, lane = tid & 63, wave = __builtin_amdgcn_readfirstlane(tid >> 6);
    const int r = lane & 15, kq = lane >> 4;
    LAS float* sR = (LAS float*)(lds + wave * 4096);
    LAS float* sLg = sR + 16;
    const bf16_t* x1 = (const bf16_t*)(a.ws + WS_X1B); const float* g_ffn = a.in[10];
    const bf16_t* WfH = (const bf16_t*)(a.ws + WS_WRF); const bf16_t* WfL = WfH + 32 * 3 * 64 * 8; const float* b48 = (const float*)(a.ws + WS_WRF + 2 * 32 * 3 * 64 * 8 * 2);
    constexpr int P4_MAXSLOT = 512;
    LAS int* hP = (LAS int*)(lds + 32768); LAS int* hE = hP + 128; LAS int* bP = hE + 32; LAS int* bE = bP + 128; LAS int* tinfo = bE + 32;
    for (int i = tid; i < 320 + P4_MAXSLOT * 4; i += NTHREADS) hP[i] = i < 320 ? 0 : -1;
    __syncthreads();
    int slot0 = wave * 16;
    bf16_t* H = (bf16_t*)(a.ws + WS_H); float* tokg = (float*)(a.ws + WS_TOKG); float* trstd = (float*)(a.ws + WS_RSTD); int* lists = (int*)(a.ws + WS_LIST); unsigned* count = (unsigned*)(a.ws + WS_CTL) + CW_COUNT;
    u32x4* erec = (u32x4*)(a.ws + WS_EREC);
    int* elists = (int*)(a.ws + WS_ELIST); int* tokP = (int*)(a.ws + WS_TOKP); unsigned* ecount = (unsigned*)(a.ws + WS_CTL) + CW_ECOUNT;
    for (int tile = vcu * NWAVES + wave; tile < NTOK / 16; tile += 2 * G * NWAVES) {
        const bool has2 = tile + G * NWAVES < NTOK / 16;
        const int tokA = tile * 16, tokB = has2 ? (tile + G * NWAVES) * 16 : tokA;
        const bf16_t* xrA = x1 + (size_t)(tokA + r) * DM + 8 * kq; const bf16_t* xrB = x1 + (size_t)(tokB + r) * DM + 8 * kq;
        f32x4 acc2[2][3]; float ss2[2] = {0.f, 0.f};
#pragma unroll
        for (int h = 0; h < 2; ++h)
#pragma unroll
            for (int ct = 0; ct < 3; ++ct) acc2[h][ct] = (f32x4){0.f, 0.f, 0.f, 0.f};
#pragma unroll 2
        for (int s = 0; s < 32; ++s) {
            const u32x4 xw0 = __builtin_nontemporal_load((const u32x4*)(xrA + 32 * s)), xw1 = __builtin_nontemporal_load((const u32x4*)(xrB + 32 * s));
#pragma unroll
            for (int h = 0; h < 2; ++h) { const u32x4 xw = h ? xw1 : xw0;
                const f32x4 xa = (f32x4){__uint_as_float(xw.x << 16), __uint_as_float(xw.x & 0xffff0000u), __uint_as_float(xw.y << 16), __uint_as_float(xw.y & 0xffff0000u)};
                const f32x4 xb = (f32x4){__uint_as_float(xw.z << 16), __uint_as_float(xw.z & 0xffff0000u), __uint_as_float(xw.w << 16), __uint_as_float(xw.w & 0xffff0000u)};
                ss2[h] += (xa[0] * xa[0] + xa[1] * xa[1]) + (xa[2] * xa[2] + xa[3] * xa[3]) + (xb[0] * xb[0] + xb[1] * xb[1]) + (xb[2] * xb[2] + xb[3] * xb[3]); }
            const bf16x8 ah0 = __builtin_bit_cast(bf16x8, xw0), ah1 = __builtin_bit_cast(bf16x8, xw1);
#pragma unroll
            for (int ct = 0; ct < 3; ++ct) {
                const bf16x8 wh = *(const bf16x8*)(WfH + ((size_t)(s * 3 + ct) * 64 + lane) * 8), wl = *(const bf16x8*)(WfL + ((size_t)(s * 3 + ct) * 64 + lane) * 8);
                acc2[0][ct] = __builtin_amdgcn_mfma_f32_16x16x32_bf16(ah0, wh, acc2[0][ct], 0, 0, 0); acc2[1][ct] = __builtin_amdgcn_mfma_f32_16x16x32_bf16(ah1, wh, acc2[1][ct], 0, 0, 0);
                acc2[0][ct] = __builtin_amdgcn_mfma_f32_16x16x32_bf16(ah0, wl, acc2[0][ct], 0, 0, 0); acc2[1][ct] = __builtin_amdgcn_mfma_f32_16x16x32_bf16(ah1, wl, acc2[1][ct], 0, 0, 0);
            }
        }
#pragma unroll
        for (int h = 0; h < 2; ++h) {
        if (h == 1 && !has2) break;
        const int tok0 = h ? tokB : tokA; float ss = ss2[h]; f32x4 acc[3] = {acc2[h][0], acc2[h][1], acc2[h][2]};
        ss += __shfl_xor(ss, 16); ss += __shfl_xor(ss, 32);
        const float rstd = rsqrtf(ss * (1.f / DM) + EPS);
        if (kq == 0) { sR[r] = rstd; trstd[tok0 + r] = rstd; }
#pragma unroll
        for (int ct = 0; ct < 3; ++ct) { const float bb = b48[16 * ct + r];
#pragma unroll
            for (int i = 0; i < 4; ++i) { const int tk = 4 * kq + i; sLg[tk * 48 + 16 * ct + r] = acc[ct][i] * sR[tk] + bb; } }
        if (lane < 16) {
            const int tok = tok0 + lane; const LAS float* lg = sLg + lane * 48;
            int gi = 0; float gm = lg[0];
            for (int i = 1; i < 4; ++i) if (lg[i] > gm) { gm = lg[i]; gi = i; }
            float den = 0.f; for (int i = 0; i < 4; ++i) den += __expf(lg[i] - gm);
            const float grp_gate = 1.f / den;
            const LAS float* fl = lg + 4 + gi * 8;
            int i0 = 0; float v0 = fl[0];
            for (int i = 1; i < 8; ++i) if (fl[i] > v0) { v0 = fl[i]; i0 = i; }
            int i1 = -1; float v1 = -3.0e38f;
            for (int i = 0; i < 8; ++i) if (i != i0 && fl[i] > v1) { v1 = fl[i]; i1 = i; }
            const float e1 = __expf(v1 - v0); const float g0 = grp_gate / (1.f + e1), g1 = grp_gate * e1 / (1.f + e1);
            int pa, pb; float ga, gb;
            if (i0 < i1) { pa = i0; pb = i1; ga = g0; gb = g1; } else { pa = i1; pb = i0; ga = g1; gb = g0; }
            const int L = gi * 28 + pa * 8 - pa * (pa + 1) / 2 + (pb - pa - 1);
            tokg[tok * 2] = ga; tokg[tok * 2 + 1] = gb;
            if (!dry) {
                const int ea = gi * 8 + pa, eb = gi * 8 + pb;
                if (slot0 + 16 <= P4_MAXSLOT) {
                    const int rp = __hip_atomic_fetch_add(&hP[L], 1, __ATOMIC_RELAXED, __HIP_MEMORY_SCOPE_WORKGROUP);
                    const int ra = __hip_atomic_fetch_add(&hE[ea], 1, __ATOMIC_RELAXED, __HIP_MEMORY_SCOPE_WORKGROUP);
                    const int rb = __hip_atomic_fetch_add(&hE[eb], 1, __ATOMIC_RELAXED, __HIP_MEMORY_SCOPE_WORKGROUP);
                    LAS int* ti = tinfo + (slot0 + lane) * 4;
                    ti[0] = tok; ti[1] = (L << 16) | rp; ti[2] = (ea << 16) | ra; ti[3] = (eb << 16) | rb;
                } else {
                    const unsigned pos = atomicAdd(&count[L], 1u); lists[(size_t)L * NTOK + pos] = tok; tokP[tok] = (L << 16) | (int)pos;
                    const unsigned qa = atomicAdd(&ecount[ea], 1u); elists[(size_t)ea * NTOK + qa] = tok * 2;
                    const unsigned qb = atomicAdd(&ecount[eb], 1u); elists[(size_t)eb * NTOK + qb] = tok * 2 + 1;
                    const unsigned rsb = __float_as_uint(sR[r]), tpb = (unsigned)((L << 16) | (int)pos);
                    erec[(size_t)ea * NTOK + qa] = (u32x4){__float_as_uint(ga), rsb, tpb, (unsigned)(tok * 2)};
                    erec[(size_t)eb * NTOK + qb] = (u32x4){__float_as_uint(gb), rsb, tpb, (unsigned)(tok * 2 + 1)};
                }
            }
        }
        slot0 += NWAVES * 16;
        }
    }
    if (!dry) {
        __syncthreads();
        const int nslot = slot0 - wave * 16 < P4_MAXSLOT ? slot0 - wave * 16 : P4_MAXSLOT;
        if (tid < NPAIR) { const int h = hP[tid]; bP[tid] = h ? (int)atomicAdd(&count[tid], (unsigned)h) : 0; }
        else if (tid >= 128 && tid < 128 + NEXP) { const int h = hE[tid - 128]; bE[tid - 128] = h ? (int)atomicAdd(&ecount[tid - 128], (unsigned)h) : 0; }
        __syncthreads();
        for (int sidx = tid; sidx < nslot; sidx += NTHREADS) {
            const LAS int* ti = tinfo + sidx * 4; const int tok = ti[0];
            if (tok >= 0) {
                const int L = ti[1] >> 16, pos = bP[L] + (ti[1] & 0xffff); lists[(size_t)L * NTOK + pos] = tok; tokP[tok] = (L << 16) | pos;
                const int ea = ti[2] >> 16, eb = ti[3] >> 16;
                const int qa = bE[ea] + (ti[2] & 0xffff), qb = bE[eb] + (ti[3] & 0xffff);
                elists[(size_t)ea * NTOK + qa] = tok * 2;
                elists[(size_t)eb * NTOK + qb] = tok * 2 + 1;
                const float2 gab = *(const float2*)(tokg + tok * 2); const unsigned rsb = __float_as_uint(trstd[tok]), tpb = (unsigned)((L << 16) | pos);
                erec[(size_t)ea * NTOK + qa] = (u32x4){__float_as_uint(gab.x), rsb, tpb, (unsigned)(tok * 2)};
                erec[(size_t)eb * NTOK + qb] = (u32x4){__float_as_uint(gab.y), rsb, tpb, (unsigned)(tok * 2 + 1)};
            }
        }
    }
}

#define XB_TMO      128
#define XB_XCNT(j)  (256  + 64 * (j))
#define XB_XSUB(j)  (1280 + 64 * (j))
#define XB_XGEN(j)  (2304 + 64 * (j))
#define XB_TOP      3328
#define XB_TOPGEN   3392
#define XCD_BAR_WORDS 3456
#define XB_SPIN_CAP (1u << 18)
__device__ __forceinline__ unsigned xb_ld(unsigned* p)              { return __hip_atomic_load(p, __ATOMIC_RELAXED, __HIP_MEMORY_SCOPE_AGENT); }
__device__ __forceinline__ unsigned xb_add(unsigned* p, unsigned v) { return __hip_atomic_fetch_add(p, v, __ATOMIC_RELAXED, __HIP_MEMORY_SCOPE_AGENT); }
__device__ __forceinline__ unsigned xb_xcc_id() { return (unsigned)__builtin_amdgcn_s_getreg((3 << 11) | 20) & 0xFu; }
#define XB_SPIN(cond, bar) do { unsigned _sp = 0; while (cond) { __builtin_amdgcn_s_sleep(1); \
    if ((++_sp & 255u) == 0u) { if (xb_ld(&(bar)[XB_TMO])) break; if (_sp > XB_SPIN_CAP) { atomicAdd(&(bar)[XB_TMO], 1u); break; } } } } while (0)
struct XcdBarrier { unsigned* bar; unsigned x; volatile LAS unsigned* st; };
__device__ __forceinline__ XcdBarrier xcd_barrier_post(unsigned* bar, volatile LAS unsigned* st) {
    XcdBarrier b; b.bar = bar; b.x = xb_xcc_id(); b.st = st;
    if (threadIdx.x == 0) (void)xb_add(&bar[XB_XCNT(b.x)], 1u);
    return b;
}
__device__ __forceinline__ void xcd_barrier_complete(unsigned* bar, unsigned x, unsigned& nloc, unsigned& nx) {
    const unsigned G = gridDim.x * gridDim.y * gridDim.z;
    unsigned sum, cnt, mine, sp = 0u;
    for (;;) {
        sum = 0u; cnt = 0u; mine = 0u;
#pragma unroll
        for (unsigned j = 0; j < 16; ++j) { const unsigned c = xb_ld(&bar[XB_XCNT(j)]); sum += c; cnt += (c > 0u) ? 1u : 0u; mine = (j == x) ? c : mine; }
        if (sum == G) break;
        __builtin_amdgcn_s_sleep(1);
        if ((++sp & 255u) == 0u) { if (xb_ld(&bar[XB_TMO])) break; if (sp > XB_SPIN_CAP) { atomicAdd(&bar[XB_TMO], 1u); break; } }
    }
    nloc = mine > 0u ? mine : 1u; nx = cnt > 0u ? cnt : 1u;
}
__device__ __forceinline__ void xcd_barrier(const XcdBarrier& b) {
    asm volatile("s_waitcnt vmcnt(0)" ::: "memory");
    __syncthreads();
    if (threadIdx.x == 0) {
        unsigned* bar = b.bar;
        __builtin_amdgcn_s_waitcnt(0);
        unsigned nloc = b.st[0], nx = b.st[1];
        if (nloc == 0u) { xcd_barrier_complete(bar, b.x, nloc, nx); b.st[0] = nloc; b.st[1] = nx; }
        const unsigned old = xb_add(&bar[XB_XSUB(b.x)], 1u);
        const unsigned gen = old / nloc;
        if (old + 1u == (gen + 1u) * nloc) {
            __builtin_amdgcn_fence(__ATOMIC_RELEASE, "agent");
            asm volatile("s_waitcnt vmcnt(0)" ::: "memory");
            const unsigned og = xb_add(&bar[XB_TOP], 1u);
            const unsigned tg = og / nx;
            if (og + 1u == (tg + 1u) * nx) xb_add(&bar[XB_TOPGEN], 1u);
            else XB_SPIN(xb_ld(&bar[XB_TOPGEN]) == tg, bar);
            __builtin_amdgcn_fence(__ATOMIC_ACQUIRE, "agent");
            xb_add(&bar[XB_XGEN(b.x)], 1u);
            asm volatile("s_waitcnt vmcnt(0)" ::: "memory");
        } else {
            XB_SPIN(xb_ld(&bar[XB_XGEN(b.x)]) == gen, bar);
            __builtin_amdgcn_fence(__ATOMIC_ACQUIRE, "agent");
            asm volatile("s_waitcnt vmcnt(0)" ::: "memory");
        }
    }
    __syncthreads();
}
constexpr int CW_BAR = 4096;
constexpr int MISC_OFF = LDS_BYTES - 256;

__global__ void __launch_bounds__(NTHREADS, 2) mega(MArgs a) {
    extern __shared__ __attribute__((aligned(16))) unsigned char lds_raw[];
    LAS unsigned char* lds = (LAS unsigned char*)lds_raw;
    const int G = gridDim.x; const int bx = blockIdx.x; const int vcu = (G % 8 == 0) ? (bx % 8) * (G / 8) + bx / 8 : bx;
    const int lo = a.ph_lo, hi = a.ph_hi;
#define IN_PH(k) (lo <= (k) && (k) < hi)
    volatile LAS unsigned* misc = (volatile LAS unsigned*)(lds + MISC_OFF);
    if (threadIdx.x < 2) misc[threadIdx.x] = 0u;
    __syncthreads();
    XcdBarrier xbar; xbar.bar = (unsigned*)(a.ws + WS_CTL) + CW_BAR; xbar.x = 0; xbar.st = misc;
    if (hi - lo > 1) xbar = xcd_barrier_post((unsigned*)(a.ws + WS_CTL) + CW_BAR, misc);
#define SEAM(k) do { if (IN_PH(k) && IN_PH((k) + 1)) { if ((k) == 0) cg::this_grid().sync(); else xcd_barrier(xbar); } } while (0)
    if (IN_PH(0)) { phase0(a, lds, vcu, G); }
    SEAM(0);
    if (IN_PH(1)) {
        for (int u = bx; u < 256; u += G) memkv_mini(a, lds, u);
        { SchedInProjT<true> S{(const char*)(a.ws + WS_XQ), (const char*)(a.ws + WS_WINT8), G, bx};
          EpiInProj E{(bf16_t*)(a.ws + WS_QKV), (bf16_t*)(a.ws + WS_KVM), a.in[4], (const float*)(a.ws + WS_RSTDX), 1.f / (SC_XQ * SC_WIN), MK_ONE_LAUNCH ? 0 : a.var, lds + EPI_SCR};
          pg8::gemm_phase<EpiInProj, SchedInProjT<true>, false, true, true>(lds, DM / 128, DM / 2, DM / 2, S, E); }
    }
    SEAM(1);
    if (IN_PH(2) || (!MK_ONE_LAUNCH && a.ph_lo >= 20 && a.ph_lo < 23)) { att::phase2(a, lds, vcu, G); }
    SEAM(2);
    if (IN_PH(3)) {
        SchedOutProj S{(const char*)(a.ws + WS_MIX), (const char*)(a.ws + WS_WOT), G, bx};
        EpiOutProj E{a.in[0], (bf16_t*)(a.ws + WS_X1B), a.ws + WS_X1Q, lds + EPI_SCR};
        pg8::gemm_phase<EpiOutProj, SchedOutProj, false, true, true>(lds, DM / 128, DM / 2, DM / 2, S, E);
    }
    SEAM(3);
    if (IN_PH(4) || lo == 7) { phase4(a, lds, vcu, G, lo == 7); }
    SEAM(4);
    if (IN_PH(5)) {
        const unsigned* count = (const unsigned*)(a.ws + WS_CTL) + CW_COUNT; const unsigned* ecount = (const unsigned*)(a.ws + WS_CTL) + CW_ECOUNT;
        moe_build_tiles(lds, count, ecount);
        const LAS int* tt = (const LAS int*)(lds + TT_OFF);
        SchedMoe1 S{(const char*)(a.ws + WS_X1Q), (const char*)(a.ws + WS_W13T), (const int*)(a.ws + WS_ELIST), ecount, tt, tt[TT_E], G, bx};
        EpiMoe1 E{(bf16_t*)(a.ws + WS_ACT), (const int*)(a.ws + WS_ELIST), ecount, (const float*)(a.ws + WS_TOKG), (const float*)(a.ws + WS_RSTD), (const int*)(a.ws + WS_TOKP), tt, lds + EPI_SCR, (const u32x4*)(a.ws + WS_EREC)};
        pg8::gemm_phase<EpiMoe1, SchedMoe1, true, true, true>(lds, DM / 128, DM / 2, DM / 2, S, E);
    }
    SEAM(5);
    if (IN_PH(6) || lo == 8) {
        const unsigned* count = (const unsigned*)(a.ws + WS_CTL) + CW_COUNT;
        const int ntiles = (MK_ONE_LAUNCH && IN_PH(5)) ? ((const LAS int*)(lds + TT_OFF))[0] : moe_build_tiles(lds, count, (const unsigned*)(a.ws + WS_CTL) + CW_ECOUNT);
        SchedMoe2 S{(const char*)(a.ws + WS_ACT), (const char*)(a.ws + WS_W2T), (const LAS int*)(lds + TT_OFF), ntiles, G, bx};
        EpiMoe2 E{a.out, (const bf16_t*)(a.ws + WS_X1B), (const int*)(a.ws + WS_LIST), count, lo == 8 ? 0.f : 1.f / (SC_ACT * SC_W2), MK_ONE_LAUNCH ? 0 : a.var, lds + EPI_SCR};
        pg8::gemm_phase<EpiMoe2, SchedMoe2, false, true, true>(lds, DM / 128, DM / 2, DEXP / 2, S, E);
    }
#undef IN_PH
#undef SEAM
}

static void launch_mega(const MArgs& base, int lo, int hi, int grid, hipStream_t stream) {
    MArgs a = base; a.ph_lo = lo; a.ph_hi = hi;
    hipLaunchKernelGGL(mega, dim3(grid), dim3(NTHREADS), LDS_BYTES, stream, a);
}
extern "C" void kernel_launch(void* const* d_in, const int* in_sizes, int n_in, void* d_out, int out_size, void* d_ws, size_t ws_size, hipStream_t stream) {
    if (n_in != 18 || ws_size < WS_END || out_size != NTOK * DM) { fprintf(stderr, "kernel_launch: unexpected sizes n_in %d ws %zu out %d\n", n_in, ws_size, out_size); return; }
    static int grid = 0;
    if (grid == 0) {
        int dev = 0, cus = 0, per_cu = 0;
        if (hipGetDevice(&dev) != hipSuccess || hipDeviceGetAttribute(&cus, hipDeviceAttributeMultiprocessorCount, dev) != hipSuccess) { grid = -1; return; }
        if (hipFuncSetAttribute((const void*)mega, hipFuncAttributeMaxDynamicSharedMemorySize, LDS_BYTES) != hipSuccess) { fprintf(stderr, "hipFuncSetAttribute failed\n"); grid = -1; return; }
        if (hipOccupancyMaxActiveBlocksPerMultiprocessor(&per_cu, (const void*)mega, NTHREADS, LDS_BYTES) != hipSuccess || per_cu < 1) { fprintf(stderr, "occupancy query failed (%d)\n", per_cu); grid = -1; return; }
        grid = cus * per_cu;
    }
    if (grid < 0) return;
    MArgs base; memset(&base, 0, sizeof base);
    for (int i = 0; i < 18; ++i) base.in[i] = (const float*)d_in[i];
    base.out = (float*)d_out; base.ws = (unsigned char*)d_ws;
    static_assert((CW_BAR + XCD_BAR_WORDS) * 4 <= 65536 && (CW_ECOUNT + NEXP) * 4 <= 65536, "control words inside the zeroed region");
    (void)hipMemsetAsync((unsigned char*)d_ws + WS_CTL, 0, 65536, stream);
#if MK_ONE_LAUNCH
    base.ph_lo = 0; base.ph_hi = 7;
    void* args[] = {&base};
    hipError_t e = hipLaunchCooperativeKernel((const void*)mega, dim3(grid), dim3(NTHREADS), args, LDS_BYTES, stream);
    if (e != hipSuccess) fprintf(stderr, "cooperative launch failed: %s (grid %d)\n", hipGetErrorString(e), grid);
#else
    for (int p = 0; p < 7; ++p) { launch_mega(base, p, p + 1, grid, stream); if (p == MK_REP_PHASE) launch_mega(base, p, p + 1, grid, stream); if (p == 4 && MK_REP_PHASE == 7) launch_mega(base, 7, 8, grid, stream); if (p == 6 && MK_REP_PHASE == 8) launch_mega(base, 8, 9, grid, stream);
        if (p == 2 && MK_REP_PHASE >= 20 && MK_REP_PHASE < 30) for (int r = 0; r < 4; ++r) launch_mega(base, MK_REP_PHASE, MK_REP_PHASE + 1, grid, stream);
        if (MK_REP_PHASE >= 100 && p == MK_REP_PHASE % 100) { MArgs b2 = base; b2.var = MK_REP_PHASE / 100; for (int r = 0; r < 2; ++r) launch_mega(b2, p, p + 1, grid, stream); } }
#endif
    (void)in_sizes;
}
```
